# Optimizing an MI355X kernel written in HIP

```python
import math
import jax
import jax.numpy as jnp
from jax import lax
import numpy as np

D_MODEL = 1024
BATCH = 4
SEQ = 8192
DEPTH = 2

GRID_W = 64
CTX_LEN = 256
EPS = 1e-6
LRU_WIDTH = D_MODEL // 2
LRU_BLOCKS = 8
LRU_BLOCK_W = LRU_WIDTH // LRU_BLOCKS
LRU_C = 8.0
CONV_W = 4
CONV_LEFT = 2
ATT_HEADS = 4
ATT_DH = 64
ATT_DV = 2 * ATT_DH
ATT_QK_W = ATT_HEADS * 2 * ATT_DH
ATT_WIDTH = ATT_HEADS * ATT_DV
Q_BLOCK = 128
ROPE_BASE = 10000.0
EVEN_IN = 2 * LRU_WIDTH + 2 * ATT_QK_W + ATT_WIDTH
EVEN_MIX = LRU_WIDTH + ATT_WIDTH
S5_GROUP = 16
S5_GROUPS = D_MODEL // S5_GROUP
S5_STATE = 64
S5_CHUNK = 128
N_EXPERTS = 64
TOP_K = 6
D_EXPERT = 256
ROUTED_SCALE = 2.5
MOE_BLOCK = 128

kernel_name = 'hybrid_rglru_diffattn_s5_moe_prefix_dit'


def rms_norm(x, g):
    xf = x.astype(jnp.float32)
    y = xf * lax.rsqrt(jnp.mean(xf * xf, axis=-1, keepdims=True) + EPS)
    return (y * g.astype(jnp.float32)).astype(x.dtype)


def modulate(x, shift, scale):
    return x * (1 + scale) + shift


def swiglu(x, w_gate, w_up, w_down):
    return (jax.nn.silu(x @ w_gate) * (x @ w_up)) @ w_down


def linear_scan(a, b, h0, reverse):
    first = -1 if reverse else 0
    b = b.at[:, first].add(a[:, first] * h0)

    def combine(left, right):
        a_l, b_l = left
        a_r, b_r = right
        return a_l * a_r, a_r * b_l + b_r

    _, h = lax.associative_scan(combine, (a, b), axis=1, reverse=reverse)
    return h, (h[:, 0] if reverse else h[:, -1])


def centred_depthwise_conv(x, w, b):
    n = x.shape[1]
    xp = jnp.pad(x, ((0, 0), (CONV_LEFT, CONV_W - 1 - CONV_LEFT), (0, 0)))
    out = xp[:, 0:n] * w[0]
    for k in range(1, CONV_W):
        out = out + xp[:, k:k + n] * w[k]
    return out + b


def rglru_coeffs(x, lam, r_w, r_b, i_w, i_b):
    xf = x.astype(jnp.float32)
    xb = xf.reshape(xf.shape[:-1] + (LRU_BLOCKS, LRU_BLOCK_W))

    def block_diag(w, bias):
        y = jnp.einsum('blnd,nde->blne', xb, w.astype(jnp.float32))
        return y.reshape(xf.shape) + bias.astype(jnp.float32)

    r = jax.nn.sigmoid(block_diag(r_w, r_b))
    i = jax.nn.sigmoid(block_diag(i_w, i_b))
    log_a = -LRU_C * r * jax.nn.softplus(-lam.astype(jnp.float32))
    a = jnp.exp(log_a)
    b = jnp.sqrt(-jnp.expm1(2.0 * log_a)) * (i * xf)
    return a, b


def bi_rglru(x_lat, x_ctx, lam, r_w, r_b, i_w, i_b):
    y_lat = 0.0
    y_ctx = 0.0
    for d, rev in enumerate((False, True)):
        a_c, b_c = rglru_coeffs(x_ctx, lam[d], r_w[d], r_b[d], i_w[d], i_b[d])
        h0 = jnp.zeros((x_ctx.shape[0], LRU_WIDTH), jnp.float32)
        h_c, h_last = linear_scan(a_c, b_c, h0, rev)
        a_l, b_l = rglru_coeffs(x_lat, lam[d], r_w[d], r_b[d], i_w[d], i_b[d])
        h_l, _ = linear_scan(a_l, b_l, h_last, rev)
        y_lat = y_lat + h_l
        y_ctx = y_ctx + h_c
    return y_lat, y_ctx


def axial_rope_tables(rows):
    r, col = jnp.meshgrid(jnp.arange(rows), jnp.arange(GRID_W), indexing='ij')
    pos = jnp.stack([r.reshape(-1), col.reshape(-1)], axis=-1).astype(jnp.float32)
    n_freq = ATT_DH // 4
    inv_freq = ROPE_BASE ** (-jnp.arange(n_freq, dtype=jnp.float32) / n_freq)
    ang = pos[:, :, None] * inv_freq
    return jnp.cos(ang), jnp.sin(ang)


def apply_axial_rope(x, cos, sin):
    shp = x.shape
    xr = x.reshape(shp[:-1] + (2, 2, ATT_DH // 4))
    x1, x2 = xr[..., 0, :], xr[..., 1, :]
    c = cos[:, None, None].astype(x.dtype)
    s = sin[:, None, None].astype(x.dtype)
    return jnp.stack([x1 * c - x2 * s, x2 * c + x1 * s], axis=-2).reshape(shp)


def diff_attend(q, k, v, lam):
    s = jnp.einsum('bqhmd,bkhmd->bhmqk', q, k).astype(jnp.float32) * (ATT_DH ** -0.5)
    p = jax.nn.softmax(s, axis=-1)
    p = p[:, :, 0] - lam * p[:, :, 1]
    return jnp.einsum('bhqk,bkhd->bqhd', p.astype(v.dtype), v)


def rglru_diffattn_mixer(h, hc, w_in, w_out, conv_w, conv_b, lru_lam, lru_r_w, lru_r_b, lru_i_w, lru_i_b,
                         q_g, k_g, lam_q1, lam_k1, lam_q2, lam_k2, subln_g, lam_init, cos, sin, need_ctx):
    f32 = jnp.float32
    bsz, n, _ = h.shape
    n_c = hc.shape[1]
    cuts = [LRU_WIDTH, 2 * LRU_WIDTH, 2 * LRU_WIDTH + ATT_QK_W, 2 * LRU_WIDTH + 2 * ATT_QK_W]
    gate, xa, q, k, v = jnp.split(h @ w_in, cuts, axis=-1)
    gate_c, xa_c, q_c, k_c, v_c = jnp.split(hc @ w_in, cuts, axis=-1)
    xa = centred_depthwise_conv(xa, conv_w, conv_b)
    xa_c = centred_depthwise_conv(xa_c, conv_w, conv_b)
    r_lat, r_ctx = bi_rglru(xa, xa_c, lru_lam, lru_r_w, lru_r_b, lru_i_w, lru_i_b)
    ya = (r_lat * jax.nn.gelu(gate.astype(f32))).astype(h.dtype)
    split_heads = lambda t: t.reshape(t.shape[:2] + (ATT_HEADS, 2, ATT_DH))
    q = apply_axial_rope(rms_norm(split_heads(q), q_g), cos, sin)
    k = apply_axial_rope(rms_norm(split_heads(k), k_g), cos, sin)
    k_c = rms_norm(split_heads(k_c), k_g)
    v = v.reshape(bsz, n, ATT_HEADS, ATT_DV)
    v_c = v_c.reshape(bsz, n_c, ATT_HEADS, ATT_DV)
    lam = (jnp.exp(jnp.sum(lam_q1.astype(f32) * lam_k1.astype(f32)))
           - jnp.exp(jnp.sum(lam_q2.astype(f32) * lam_k2.astype(f32))) + lam_init)
    k_all = jnp.concatenate([k_c, k], axis=1)
    v_all = jnp.concatenate([v_c, v], axis=1)
    n_blk = n // Q_BLOCK
    q_blocks = q.reshape(bsz, n_blk, Q_BLOCK, ATT_HEADS, 2, ATT_DH).swapaxes(0, 1)
    o = lax.map(lambda qb: diff_attend(qb, k_all, v_all, lam), q_blocks)
    o = o.swapaxes(0, 1).reshape(bsz, n, ATT_HEADS, ATT_DV)
    yb = (rms_norm(o, subln_g) * (1.0 - lam_init)).reshape(bsz, n, ATT_WIDTH)
    y = jnp.concatenate([ya, yb], axis=-1) @ w_out
    if not need_ctx:
        return y, None
    q_c = rms_norm(split_heads(q_c), q_g)
    o_c = diff_attend(q_c, k_c, v_c, lam)
    ya_c = (r_ctx * jax.nn.gelu(gate_c.astype(f32))).astype(h.dtype)
    yb_c = (rms_norm(o_c, subln_g) * (1.0 - lam_init)).reshape(bsz, n_c, ATT_WIDTH)
    y_c = jnp.concatenate([ya_c, yb_c], axis=-1) @ w_out
    return y, y_c


def s5_scan(u, lam_bar, b_bar, c_mat, h0, reverse, with_output):
    bsz, n, g, i = u.shape
    chunks = u.reshape(bsz, n // S5_CHUNK, S5_CHUNK, g, i).swapaxes(0, 1)

    def step(h, u_blk):
        bu = jnp.einsum('blgi,gpi->blgp', u_blk.astype(jnp.complex64), b_bar)
        a = jnp.broadcast_to(lam_bar, bu.shape)
        hs, h_last = linear_scan(a, bu, h, reverse)
        y = jnp.real(jnp.einsum('blgp,gip->blgi', hs, c_mat)) if with_output else None
        return h_last, y

    h_last, ys = lax.scan(step, h0, chunks, reverse=reverse)
    if with_output:
        ys = ys.swapaxes(0, 1).reshape(bsz, n, g, i)
    return ys, h_last


def s5_mixer(h, hc, a_re, a_im, log_step, b_re, b_im, c_re, c_im, d_skip, glu_w, glu_b, need_ctx):
    f32 = jnp.float32
    bsz, n, dm = h.shape
    grp = lambda t: t.astype(f32).reshape(t.shape[:2] + (S5_GROUPS, S5_GROUP))
    u, u_c = grp(h), grp(hc)
    d = d_skip.astype(f32).reshape(S5_GROUPS, S5_GROUP)
    y = u * d
    y_c = u_c * d if need_ctx else None
    for di, rev in enumerate((False, True)):
        lam = lax.complex(jnp.minimum(a_re[di].astype(f32), -1e-4), a_im[di].astype(f32))
        lam_bar = jnp.exp(lam * jnp.exp(log_step[di].astype(f32)))
        b_bar = ((lam_bar - 1.0) / lam)[..., None] * lax.complex(b_re[di].astype(f32), b_im[di].astype(f32))
        c_mat = lax.complex(c_re[di].astype(f32), c_im[di].astype(f32))
        h0 = jnp.zeros((bsz, S5_GROUPS, S5_STATE), jnp.complex64)
        yc_d, h_ctx = s5_scan(u_c, lam_bar, b_bar, c_mat, h0, rev, need_ctx)
        yl_d, _ = s5_scan(u, lam_bar, b_bar, c_mat, h_ctx, rev, True)
        y = y + yl_d
        if need_ctx:
            y_c = y_c + yc_d

    def glu(t):
        z = jax.nn.gelu(t.reshape(t.shape[:2] + (dm,))).astype(h.dtype)
        val, gt = jnp.split(z @ glu_w + glu_b, 2, axis=-1)
        return val * jax.nn.sigmoid(gt)

    return glu(y), (glu(y_c) if need_ctx else None)


def moe_ffn(h, router_w, router_bias, w_gate, w_up, w_down, ws_gate, ws_up, ws_down):
    n_tok, dm = h.shape
    f32 = jnp.float32
    affinity = jax.nn.sigmoid((h @ router_w).astype(f32))
    _, idx = lax.top_k(affinity + router_bias.astype(f32), TOP_K)
    s_sel = jnp.take_along_axis(affinity, idx, axis=-1)
    gates = s_sel / jnp.sum(s_sel, axis=-1, keepdims=True) * ROUTED_SCALE
    n_assign = n_tok * TOP_K
    e_flat = idx.reshape(-1)
    t_flat = jnp.repeat(jnp.arange(n_tok, dtype=jnp.int32), TOP_K)
    g_flat = gates.reshape(-1).astype(h.dtype)
    order = jnp.argsort(e_flat)
    e_s, t_s, g_s = e_flat[order], t_flat[order], g_flat[order]
    counts = jnp.bincount(e_flat, length=N_EXPERTS)
    padded = (counts + MOE_BLOCK - 1) // MOE_BLOCK * MOE_BLOCK
    pad_end = jnp.cumsum(padded)
    pad_start = pad_end - padded
    sort_start = jnp.cumsum(counts) - counts
    dest = pad_start[e_s] + jnp.arange(n_assign, dtype=jnp.int32) - sort_start[e_s]
    n_blocks = -(-(n_assign + N_EXPERTS * (MOE_BLOCK - 1)) // MOE_BLOCK)
    tok_pad = jnp.full((n_blocks * MOE_BLOCK,), n_tok, jnp.int32).at[dest].set(t_s)
    g_pad = jnp.zeros((n_blocks * MOE_BLOCK,), h.dtype).at[dest].set(g_s)
    blk_start = jnp.arange(n_blocks, dtype=jnp.int32) * MOE_BLOCK
    blk_expert = jnp.minimum(jnp.searchsorted(pad_end, blk_start, side='right'), N_EXPERTS - 1)
    h_ext = jnp.concatenate([h, jnp.zeros((1, dm), h.dtype)], axis=0)

    def expert_block(acc, blk):
        tok, g, e = blk
        y = swiglu(h_ext[tok], w_gate[e], w_up[e], w_down[e])
        return acc.at[tok].add(y * g[:, None]), None

    acc, _ = lax.scan(expert_block, jnp.zeros_like(h_ext),
                      (tok_pad.reshape(n_blocks, MOE_BLOCK), g_pad.reshape(n_blocks, MOE_BLOCK), blk_expert))
    return acc[:n_tok] + swiglu(h, ws_gate, ws_up, ws_down)


def setup_inputs(seed: int = 0) -> dict:
    key = jax.random.key(seed)
    keys = iter(jax.random.split(key, 64))
    f32 = jnp.float32
    dm = D_MODEL
    n_even = (DEPTH + 1) // 2
    n_odd = DEPTH // 2

    def normal(shape, scale):
        return jax.random.normal(next(keys), shape, f32) * scale

    def gain(shape):
        return 1.0 + normal(shape, 0.02)

    def uniform(shape, lo, hi):
        return jax.random.uniform(next(keys), shape, f32, lo, hi)

    a8 = uniform((n_even, 2, LRU_WIDTH), 0.9, 0.999)
    a_lru = a8 ** (1.0 / LRU_C)
    s5_n = jnp.arange(S5_STATE, dtype=f32)
    s5_shape = (n_odd, 2, S5_GROUPS, S5_STATE)
    return {
        'x': normal((BATCH, SEQ, dm), 1.0),
        'c': normal((BATCH, dm), 1.0),
        'ctx': normal((BATCH, CTX_LEN, dm), 1.0),
        'c_ctx': normal((dm,), 1.0),
        'mod_w': normal((DEPTH, dm, 6 * dm), 0.5 * dm ** -0.5),
        'mod_b': normal((DEPTH, 6 * dm), 0.02),
        'norm1_g': gain((DEPTH, dm)),
        'norm2_g': gain((DEPTH, dm)),
        'ar_w_in': normal((n_even, dm, EVEN_IN), dm ** -0.5),
        'ar_w_out': normal((n_even, EVEN_MIX, dm), EVEN_MIX ** -0.5),
        'lru_conv_w': normal((n_even, CONV_W, LRU_WIDTH), CONV_W ** -0.5),
        'lru_conv_b': normal((n_even, LRU_WIDTH), 0.02),
        'lru_lam': jnp.log(a_lru) - jnp.log1p(-a_lru),
        'lru_r_w': normal((n_even, 2, LRU_BLOCKS, LRU_BLOCK_W, LRU_BLOCK_W), LRU_BLOCK_W ** -0.5),
        'lru_r_b': normal((n_even, 2, LRU_WIDTH), 0.02),
        'lru_i_w': normal((n_even, 2, LRU_BLOCKS, LRU_BLOCK_W, LRU_BLOCK_W), LRU_BLOCK_W ** -0.5),
        'lru_i_b': normal((n_even, 2, LRU_WIDTH), 0.02),
        'attn_q_g': gain((n_even, ATT_DH)),
        'attn_k_g': gain((n_even, ATT_DH)),
        'attn_lam_q1': normal((n_even, ATT_DH), 0.1),
        'attn_lam_k1': normal((n_even, ATT_DH), 0.1),
        'attn_lam_q2': normal((n_even, ATT_DH), 0.1),
        'attn_lam_k2': normal((n_even, ATT_DH), 0.1),
        'attn_subln_g': gain((n_even, ATT_DV)),
        's5_a_re': -0.5 + normal(s5_shape, 0.01),
        's5_a_im': math.pi * s5_n + normal(s5_shape, 0.01),
        's5_log_step': uniform(s5_shape, math.log(1e-3), math.log(1e-1)),
        's5_b_re': normal(s5_shape + (S5_GROUP,), (2 * S5_GROUP) ** -0.5),
        's5_b_im': normal(s5_shape + (S5_GROUP,), (2 * S5_GROUP) ** -0.5),
        's5_c_re': normal((n_odd, 2, S5_GROUPS, S5_GROUP, S5_STATE), (2 * S5_STATE) ** -0.5),
        's5_c_im': normal((n_odd, 2, S5_GROUPS, S5_GROUP, S5_STATE), (2 * S5_STATE) ** -0.5),
        's5_d': normal((n_odd, dm), 1.0),
        's5_glu_w': normal((n_odd, dm, 2 * dm), dm ** -0.5),
        's5_glu_b': normal((n_odd, 2 * dm), 0.02),
        'router_w': normal((DEPTH, dm, N_EXPERTS), dm ** -0.5),
        'router_bias': normal((DEPTH, N_EXPERTS), 0.01),
        'exp_w_gate': normal((DEPTH, N_EXPERTS, dm, D_EXPERT), dm ** -0.5),
        'exp_w_up': normal((DEPTH, N_EXPERTS, dm, D_EXPERT), dm ** -0.5),
        'exp_w_down': normal((DEPTH, N_EXPERTS, D_EXPERT, dm), D_EXPERT ** -0.5),
        'sh_w_gate': normal((DEPTH, dm, D_EXPERT), dm ** -0.5),
        'sh_w_up': normal((DEPTH, dm, D_EXPERT), dm ** -0.5),
        'sh_w_down': normal((DEPTH, D_EXPERT, dm), D_EXPERT ** -0.5),
    }


def reference(x, c, ctx, c_ctx, mod_w, mod_b, norm1_g, norm2_g,
              ar_w_in, ar_w_out, lru_conv_w, lru_conv_b, lru_lam, lru_r_w, lru_r_b, lru_i_w, lru_i_b,
              attn_q_g, attn_k_g, attn_lam_q1, attn_lam_k1, attn_lam_q2, attn_lam_k2, attn_subln_g,
              s5_a_re, s5_a_im, s5_log_step, s5_b_re, s5_b_im, s5_c_re, s5_c_im, s5_d, s5_glu_w, s5_glu_b,
              router_w, router_bias, exp_w_gate, exp_w_up, exp_w_down, sh_w_gate, sh_w_up, sh_w_down):
    bsz, n, dm = x.shape
    rows = n // GRID_W
    cos, sin = axial_rope_tables(rows)
    mod_in = jax.nn.silu(c)
    mod_in_c = jax.nn.silu(c_ctx)
    for layer in range(DEPTH):
        last = layer == DEPTH - 1
        j = layer // 2
        m = (mod_in @ mod_w[layer] + mod_b[layer])[:, None, :]
        mc = mod_in_c @ mod_w[layer] + mod_b[layer]
        sh1, sc1, g1, sh2, sc2, g2 = jnp.split(m, 6, axis=-1)
        sh1c, sc1c, g1c, sh2c, sc2c, g2c = jnp.split(mc, 6, axis=-1)
        h = modulate(rms_norm(x, norm1_g[layer]), sh1, sc1)
        hc = modulate(rms_norm(ctx, norm1_g[layer]), sh1c, sc1c)
        if layer % 2 == 0:
            lam_init = 0.8 - 0.6 * math.exp(-0.3 * layer)
            y, y_c = rglru_diffattn_mixer(
                h, hc, ar_w_in[j], ar_w_out[j], lru_conv_w[j], lru_conv_b[j], lru_lam[j],
                lru_r_w[j], lru_r_b[j], lru_i_w[j], lru_i_b[j], attn_q_g[j], attn_k_g[j],
                attn_lam_q1[j], attn_lam_k1[j], attn_lam_q2[j], attn_lam_k2[j], attn_subln_g[j],
                lam_init, cos, sin, not last)
        else:
            y, y_c = s5_mixer(
                h, hc, s5_a_re[j], s5_a_im[j], s5_log_step[j], s5_b_re[j], s5_b_im[j],
                s5_c_re[j], s5_c_im[j], s5_d[j], s5_glu_w[j], s5_glu_b[j], not last)
        x = x + g1 * y
        moe_w = (router_w[layer], router_bias[layer], exp_w_gate[layer], exp_w_up[layer], exp_w_down[layer],
                 sh_w_gate[layer], sh_w_up[layer], sh_w_down[layer])
        h2 = modulate(rms_norm(x, norm2_g[layer]), sh2, sc2)
        if last:
            x = x + g2 * moe_ffn(h2.reshape(-1, dm), *moe_w).reshape(x.shape)
        else:
            ctx = ctx + g1c * y_c
            h2c = modulate(rms_norm(ctx, norm2_g[layer]), sh2c, sc2c)
            n_ctx_tok = h2c.shape[0] * h2c.shape[1]
            out = moe_ffn(jnp.concatenate([h2c.reshape(-1, dm), h2.reshape(-1, dm)], axis=0), *moe_w)
            ctx = ctx + g2c * out[:n_ctx_tok].reshape(ctx.shape)
            x = x + g2 * out[n_ctx_tok:].reshape(x.shape)
    return x
```

```cpp
#include <hip/hip_runtime.h>
#include <hip/hip_cooperative_groups.h>
#include <cstdio>
#include <cstdint>
namespace cg = cooperative_groups;

#define LAS __attribute__((address_space(3)))
typedef unsigned short bf16_t;
typedef short bf16x8 __attribute__((ext_vector_type(8)));
typedef short s16x4 __attribute__((ext_vector_type(4)));
typedef float f32x2 __attribute__((ext_vector_type(2)));
typedef float f32x4 __attribute__((ext_vector_type(4)));
typedef float f32x16 __attribute__((ext_vector_type(16)));
typedef unsigned u32x2 __attribute__((ext_vector_type(2)));
typedef int i32x2 __attribute__((ext_vector_type(2)));
typedef unsigned u32x4 __attribute__((ext_vector_type(4)));

constexpr int DM = 1024, NBATCH = 4, SEQ = 8192, CTXL = 256;
constexpr int NCTX = NBATCH * CTXL;
constexpr int NLAT = NBATCH * SEQ;
constexpr int NROW = NCTX + NLAT;
constexpr float EPS = 1e-6f;
constexpr int NTHREADS = 512, NWAVES = 8;
constexpr int LRU_NCH = 264;
constexpr int CAPH = 33792;

constexpr size_t MiB = 1ull << 20;
constexpr size_t WS_CTL = 0;
constexpr size_t WS_MODV = 1 * MiB;
constexpr size_t WS_ROPE = WS_MODV + 256 * 1024;
constexpr size_t WS_LRUW = WS_MODV + 512 * 1024;
constexpr size_t WS_LRUSP = WS_MODV + 768 * 1024;
constexpr size_t WS_WRT = 2 * MiB;
constexpr size_t WS_WIN = 4 * MiB, WS_WIN8 = 6 * MiB, WS_WOUT8 = 15 * MiB / 2, WS_WOUT = 9 * MiB, WS_GLU = 11 * MiB;
constexpr size_t WS_EXP = 15 * MiB;
constexpr size_t WS_ACT = 113 * MiB;
constexpr size_t WS_BIG = 179 * MiB;
constexpr size_t WS_SCR = 410 * MiB;
constexpr size_t WS_LIST = 472 * MiB;
constexpr size_t WS_GATE = 490 * MiB;
constexpr size_t WS_HS5L = 494 * MiB;
constexpr size_t WS_HS5C = 590 * MiB;
constexpr size_t WS_END = 594 * MiB;
constexpr size_t BG_GATE = 0, BG_XA = 33 * MiB, BG_Q = 66 * MiB, BG_K = 99 * MiB, BG_V = 132 * MiB, BG_LSUM = 165 * MiB, BG_LHIN = 175 * MiB;
constexpr size_t BG_MODP = 200 * MiB;
constexpr size_t BG_SSQ = 200 * MiB;
constexpr size_t BG_ZS5 = 0, BG_SLOCL = 64 * MiB, BG_SLOCC = 128 * MiB;
constexpr size_t AC_S5A = 0, AC_S5B = 16 * MiB;
constexpr size_t EXP_STRIDE = 3 * MiB / 2, EXP_WD = 1 * MiB;

constexpr int RING_BYTES = 131072, MISC_OFF = RING_BYTES, LDS_BYTES = 147456;

__device__ __forceinline__ unsigned cvt_pk_bf16(float lo, float hi) { unsigned r; asm("v_cvt_pk_bf16_f32 %0, %1, %2" : "=v"(r) : "v"(lo), "v"(hi)); return r; }
__device__ __forceinline__ bf16_t f2bf(float f) { return (bf16_t)(cvt_pk_bf16(f, 0.f) & 0xffffu); }
__device__ __forceinline__ float bf2f(bf16_t h) { return __uint_as_float(((unsigned)h) << 16); }
__device__ __forceinline__ float bflo(unsigned w) { return __uint_as_float(w << 16); }
__device__ __forceinline__ float bfhi(unsigned w) { return __uint_as_float(w & 0xffff0000u); }
__device__ __forceinline__ float wave_sum(float v) {
#pragma unroll
    for (int o = 1; o < 64; o <<= 1) v += __shfl_xor(v, o);
    return v;
}
__device__ __forceinline__ float sigmoidf_(float x) { return __builtin_amdgcn_rcpf(1.f + __expf(-x)); }
__device__ __forceinline__ float siluf_(float x) { return x * sigmoidf_(x); }
__device__ __forceinline__ float gelu_tanh(float x) { const float u = 0.7978845608028654f * (x + 0.044715f * x * x * x); return x * __builtin_amdgcn_rcpf(1.f + __expf(-2.f * u)); }
__device__ __forceinline__ unsigned pk4_fp8(float a, float b, float c, float d) {
    a = fminf(fmaxf(a, -448.f), 448.f); b = fminf(fmaxf(b, -448.f), 448.f); c = fminf(fmaxf(c, -448.f), 448.f); d = fminf(fmaxf(d, -448.f), 448.f);
    int w = __builtin_amdgcn_cvt_pk_fp8_f32(a, b, 0, false); w = __builtin_amdgcn_cvt_pk_fp8_f32(c, d, w, true); return (unsigned)w; }
typedef int i32x8 __attribute__((ext_vector_type(8)));
typedef int i32x4 __attribute__((ext_vector_type(4)));
__device__ __forceinline__ f32x4 unpk4_fp8(unsigned w) { const f32x2 lo = __builtin_amdgcn_cvt_pk_f32_fp8((int)w, false), hi = __builtin_amdgcn_cvt_pk_f32_fp8((int)w, true); return (f32x4){lo.x, lo.y, hi.x, hi.y}; }
__device__ __forceinline__ int crow(int r, int hi) { return (r & 3) + 8 * (r >> 2) + 4 * hi; }

__device__ __forceinline__ int lane_id() { return (int)__builtin_amdgcn_mbcnt_hi(~0u, __builtin_amdgcn_mbcnt_lo(~0u, 0u)); }

struct Args { const float* in[42]; float* out; unsigned char* ws; int ph_lo, ph_hi; };
struct Frame {
    LAS unsigned char* lds;
    const float* const* in;
    float* out; unsigned char* ws;
    int tid, lane, wave, G, bid;
};
enum { I_X = 0, I_C, I_CTX, I_CCTX, I_MODW, I_MODB, I_N1G, I_N2G, I_WIN, I_WOUT, I_CONVW, I_CONVB, I_LLAM, I_LRW, I_LRB, I_LIW, I_LIB,
       I_QG, I_KG, I_LQ1, I_LK1, I_LQ2, I_LK2, I_SUBG, I_SARE, I_SAIM, I_SLOG, I_SBRE, I_SBIM, I_SCRE, I_SCIM, I_SD, I_GLUW, I_GLUB,
       I_RW, I_RB, I_EWG, I_EWU, I_EWD, I_SWG, I_SWU, I_SWD };

__device__ __forceinline__ int row_mi(int r) { return r < NCTX ? 4 : ((r - NCTX) >> 13); }
__device__ __forceinline__ bf16_t* xb0_ptr(const Frame& F, int r) { return (bf16_t*)F.out + (size_t)r * DM; }
__device__ __forceinline__ bf16_t* xb1_ptr(const Frame& F, int r) { return (bf16_t*)(F.ws + WS_HS5L) + (size_t)r * DM; }
__device__ __forceinline__ f32x4 bf4_to_f32(u32x2 w) { return (f32x4){bflo(w.x), bfhi(w.x), bflo(w.y), bfhi(w.y)}; }
__device__ __forceinline__ u32x2 f32_to_bf4(f32x4 v) { u32x2 w; w.x = cvt_pk_bf16(v.x, v.y); w.y = cvt_pk_bf16(v.z, v.w); return w; }
__device__ __forceinline__ const float* inrow_ptr(const Frame& F, int r) { return r < NCTX ? F.in[I_CTX] + (size_t)r * DM : F.in[I_X] + (size_t)(r - NCTX) * DM; }
__device__ __forceinline__ const float* modv(const Frame& F, int layer, int mi, int chunk) { return (const float*)(F.ws + WS_MODV) + ((size_t)(layer * 5 + mi) * 6 + chunk) * DM; }
namespace ge {
constexpr int BM = 256, BK = 64, HALF = 128, HTB = HALF * BK * 2, STAGE_BYTES = 8 * HTB, NXCD = 8, WGM = 8;
__host__ __device__ __forceinline__ int lds_byte(int r, int c) { const int st = (r >> 4) * 2 + (c >> 5), rr = r & 15, cc = c & 31, ob = rr * 64 + cc * 2; return st * 1024 + (ob ^ (((ob >> 9) & 1) << 5)); }
__host__ __device__ __forceinline__ void stage_rc(int b, int& R, int& C) { const int st = b / 1024, sb = b % 1024, swz = sb ^ (((sb >> 9) & 1) << 5); R = (st >> 1) * 16 + swz / 64; C = (st & 1) * 32 + (swz % 64) / 2; }

struct GUnit { const char* A; const char* B; const i32x2* rows; int pm, pn, aux, nvalid; };

struct StaticOrder {
    __device__ __forceinline__ const i32x2* dummy() const { return nullptr; }
    int nM, nN, nwg, G, c; const char* A0; const char* B0; size_t tstepA, tstepB;
    __device__ void init(int nM_, int nN_, int G_, int c_, const void* A, size_t tsA, const void* B, size_t tsB) { nM = nM_; nN = nN_; nwg = nM * nN; G = G_; c = c_; A0 = (const char*)A; B0 = (const char*)B; tstepA = tsA; tstepB = tsB; }
    __device__ bool next(int i, GUnit& u) const {
        const long L = (long)i * G + c; if (L >= nwg) return false;
        int wgid = (int)L; { const int q = nwg / NXCD, r = nwg % NXCD, xcd = wgid % NXCD, off = wgid / NXCD; wgid = (xcd < r ? xcd * (q + 1) : r * (q + 1) + (xcd - r) * q) + off; }
        const int nig = WGM * nN, gid = wgid / nig, fm = gid * WGM, gsz = (nM - fm) < WGM ? (nM - fm) : WGM;
        u.pm = fm + ((wgid % nig) % gsz); u.pn = (wgid % nig) / gsz; u.aux = 0; u.nvalid = 256; u.rows = nullptr;
        u.A = A0 + (size_t)u.pm * tstepA; u.B = B0 + (size_t)u.pn * tstepB; return true;
    }
};
struct SchedOne { GUnit u; __device__ __forceinline__ const i32x2* dummy() const { return nullptr; } __device__ __forceinline__ bool next(int i, GUnit& o) const { if (i) return false; o = u; return true; } };
__host__ __device__ __forceinline__ int perm32(int rho) { const int n = rho >> 4, i = rho & 15; return 8 * (i >> 2) + 4 * n + (i & 3); }
struct AMapPlain { unsigned lda2; __device__ __forceinline__ unsigned operator()(int R, int C) const { return (unsigned)R * lda2 + (unsigned)C * 2u; } };

template <class Epi, class Sched, class AMap, int GM, bool F8 = false>
__device__ __forceinline__ void gemm_run(LAS unsigned char* lds, const LAS int* rowl, const int nt, const unsigned ldb2, const unsigned hstepA, const size_t kstepA,
                                         const AMap amap, const unsigned lda2g, const Sched& S, const Epi& E, const int sw = 0x7f7f7f7f, const int sa = 0x7f7f7f7f) {
    int tid_ = threadIdx.x; asm volatile("" : "+v"(tid_));
    const int tid = tid_, wid = __builtin_amdgcn_readfirstlane(tid >> 6), lane = tid & 63, wr = wid >> 2, wc = wid & 3, fr = lane & 15, fq = lane >> 4;
    constexpr bool GATHER = GM != 0;
    unsigned voffA = 0, voffB, voffG[2][2] = {{0u, 0u}, {0u, 0u}}, nvoffG[2][2] = {{0u, 0u}, {0u, 0u}};
    int R0, C0; stage_rc(tid * 16, R0, C0);
    voffB = (unsigned)(Epi::PERM ? ((R0 & ~31) + perm32(R0 & 31)) : R0) * ldb2 + (unsigned)C0 * 2u;
    if (GM == 1) {
#pragma unroll
        for (int i = 0; i < 2; ++i) { voffG[0][i] = (unsigned)(rowl[R0 + 64 * i] >> 3) * lda2g + (unsigned)C0 * 2u; voffG[1][i] = (unsigned)(rowl[128 + R0 + 64 * i] >> 3) * lda2g + (unsigned)C0 * 2u; }
    } else if (GM == 0) voffA = amap(R0, C0);
    const unsigned qstepA = hstepA >> 1, qstepB = 64u * ldb2;
#define GE_ROWOFF(dst, U) do { int _t = threadIdx.x; asm volatile("" : "+v"(_t)); int _R, _C; stage_rc((_t & 511) * 16, _R, _C); \
        const bool _id = (U).rows == nullptr; const i32x2* _lp = _id ? (const i32x2*)S.dummy() : (U).rows; const int _nv = _id ? 256 : (U).nvalid; int _e[2][2]; \
        _Pragma("unroll") for (int _h = 0; _h < 2; ++_h) _Pragma("unroll") for (int _i = 0; _i < 2; ++_i) { const int _r = _h * 128 + _R + 64 * _i; _e[_h][_i] = _lp[_r < _nv ? _r : _nv - 1].x; } \
        _Pragma("unroll") for (int _h = 0; _h < 2; ++_h) _Pragma("unroll") for (int _i = 0; _i < 2; ++_i) { const int _r = _h * 128 + _R + 64 * _i; \
            const int _row = _id ? (U).aux + _r : (_e[_h][_i] >> 3); dst[_h][_i] = (unsigned)_row * lda2g + (unsigned)_C * 2u; } } while (0)
    const size_t kstepB = (size_t)(BK * 2);
    const unsigned hstepB = (unsigned)HALF * ldb2;
    const unsigned ldsw = (unsigned)wid * 1024u;
    const int aoff = lds_byte(wr * 64 + fr, F8 ? fq * 16 : fq * 8), boff = lds_byte(wc * 32 + fr, F8 ? fq * 16 : fq * 8);
    constexpr int KOFF = F8 ? 16 : 1024;
#define GE_SA(b, h) (((b) * 2 + (h)) * ge::HTB)
#define GE_SB(b, h) ((4 + (b) * 2 + (h)) * ge::HTB)
#define GE_STAGEB(bufoff, gbase) do { _Pragma("unroll") for (int _i = 0; _i < 2; ++_i) \
        __builtin_amdgcn_global_load_lds((const unsigned*)((const char*)(gbase) + (size_t)(_i * qstepB) + voffB), (LAS unsigned*)(lds + (bufoff) + ldsw + _i * 8192), 16, 0, 0); } while (0)
#define GE_STAGEA(bufoff, gbase, h, NX) do { _Pragma("unroll") for (int _i = 0; _i < 2; ++_i) { \
        const char* _p = GATHER ? (const char*)(gbase) + ((GM == 2 && (NX)) ? nvoffG[h][_i] : voffG[h][_i]) : (const char*)(gbase) + (size_t)((h) * hstepA + _i * qstepA) + voffA; \
        __builtin_amdgcn_global_load_lds((const unsigned*)_p, (LAS unsigned*)(lds + (bufoff) + ldsw + _i * 8192), 16, 0, 0); } } while (0)
#define GE_LDA(dst, b, h) do { _Pragma("unroll") for (int m = 0; m < 4; ++m) _Pragma("unroll") for (int k = 0; k < 2; ++k) dst[m][k] = *(const LAS bf16x8*)(lds + GE_SA(b, h) + aoff + m * 2048 + k * KOFF); } while (0)
#define GE_LDB(dst, b, h) do { _Pragma("unroll") for (int n = 0; n < 2; ++n) _Pragma("unroll") for (int k = 0; k < 2; ++k) dst[n][k] = *(const LAS bf16x8*)(lds + GE_SB(b, h) + boff + n * 2048 + k * KOFF); } while (0)
#define GE_MMA(ai, bj, At, Bt) do { __builtin_amdgcn_s_setprio(1); _Pragma("unroll") for (int m = 0; m < 4; ++m) _Pragma("unroll") for (int n = 0; n < 2; ++n) { \
        if constexpr (F8) { i32x8 _w, _x; { const bf16x8 _w0 = Bt[n][0], _w1 = Bt[n][1], _x0 = At[m][0], _x1 = At[m][1]; \
                const u32x4 _a = *reinterpret_cast<const u32x4*>(&_w0), _b = *reinterpret_cast<const u32x4*>(&_w1), _c = *reinterpret_cast<const u32x4*>(&_x0), _d = *reinterpret_cast<const u32x4*>(&_x1); \
                _w = (i32x8){(int)_a.x, (int)_a.y, (int)_a.z, (int)_a.w, (int)_b.x, (int)_b.y, (int)_b.z, (int)_b.w}; _x = (i32x8){(int)_c.x, (int)_c.y, (int)_c.z, (int)_c.w, (int)_d.x, (int)_d.y, (int)_d.z, (int)_d.w}; } \
              \
            asm volatile("v_mfma_scale_f32_16x16x128_f8f6f4 %0, %1, %2, %0, %3, %4 op_sel_hi:[0,0,0]" : "+v"(acc[ai][bj][m][n]) : "v"(_w), "v"(_x), "v"(sw), "v"(sa)); } \
        else { _Pragma("unroll") for (int k = 0; k < 2; ++k) acc[ai][bj][m][n] = __builtin_amdgcn_mfma_f32_16x16x32_bf16(Bt[n][k], At[m][k], acc[ai][bj][m][n], 0, 0, 0); } } \
        __builtin_amdgcn_s_setprio(0); } while (0)
#define GE_WAIT_V(n) asm volatile("s_waitcnt vmcnt(" #n ")" ::: "memory")
#define GE_WAIT_L(n) asm volatile("s_waitcnt lgkmcnt(" #n ")" ::: "memory")
#define GE_BAR __builtin_amdgcn_s_barrier()
#define GE_SCHED __builtin_amdgcn_sched_barrier(0)
    GUnit cur, nxt; int ui = 0;
    if (!S.next(0, cur)) return;
    f32x4 acc[2][2][4][2];
#pragma unroll
    for (int a = 0; a < 2; ++a)
#pragma unroll
        for (int b = 0; b < 2; ++b)
#pragma unroll
            for (int m = 0; m < 4; ++m)
#pragma unroll
                for (int n = 0; n < 2; ++n) acc[a][b][m][n] = (f32x4){0.f, 0.f, 0.f, 0.f};
    bf16x8 At[4][2], B0[2][2], B1[2][2];
    const char* cA = cur.A; const char* cB = cur.B;
    if (GM == 2) GE_ROWOFF(voffG, cur);
    GE_STAGEB(GE_SB(0, 0), cB); GE_STAGEB(GE_SB(0, 1), cB + hstepB); GE_STAGEA(GE_SA(0, 0), cA, 0, false); GE_STAGEA(GE_SA(0, 1), cA, 1, false);
    if (wr == 1) GE_BAR;
    GE_WAIT_V(2); GE_BAR;
    GE_STAGEB(GE_SB(1, 0), cB + kstepB); GE_STAGEA(GE_SA(1, 0), cA + kstepA, 0, false); GE_STAGEB(GE_SB(1, 1), cB + hstepB + kstepB);
    GE_WAIT_V(6); GE_BAR;
    for (;;) {
        const bool has_next = S.next(ui + 1, nxt);
        typename Epi::Pre pre = E.prefetch(cur, wr, fr);
        const char* nA = has_next ? nxt.A : cA; const char* nB = has_next ? nxt.B : cB;
        if (GM == 2) { if (has_next && nxt.pn == 0) GE_ROWOFF(nvoffG, nxt); else { _Pragma("unroll") for (int _h = 0; _h < 2; ++_h) _Pragma("unroll") for (int _i = 0; _i < 2; ++_i) nvoffG[_h][_i] = voffG[_h][_i]; } }
#pragma unroll 1
        for (int t = 0; t < nt; t += 2) {
            const bool last = (t == nt - 2);
            const char* a1 = cA + (size_t)(t + 1) * kstepA;
            const char* a2 = last ? nA : cA + (size_t)(t + 2) * kstepA; const char* b2 = last ? nB : cB + (size_t)(t + 2) * kstepB;
            const char* a3 = a2 + kstepA; const char* b3 = b2 + kstepB;
            GE_LDB(B0, 0, 0); GE_LDB(B1, 0, 1); GE_SCHED; GE_LDA(At, 0, 0); GE_STAGEA(GE_SA(1, 1), a1, 1, false);
            GE_WAIT_V(8); GE_WAIT_L(0); GE_BAR; GE_MMA(0, 0, At, B0); GE_MMA(0, 1, At, B1); GE_BAR; GE_SCHED;
            GE_LDA(At, 0, 1); GE_STAGEB(GE_SB(0, 0), b2); GE_STAGEB(GE_SB(0, 1), b2 + hstepB); GE_STAGEA(GE_SA(0, 0), a2, 0, last);
            GE_WAIT_V(8); GE_WAIT_L(0); GE_BAR; GE_MMA(1, 0, At, B0); GE_MMA(1, 1, At, B1); GE_BAR; GE_SCHED;
            GE_LDB(B0, 1, 0); GE_LDB(B1, 1, 1); GE_SCHED; GE_LDA(At, 1, 0); GE_STAGEA(GE_SA(0, 1), a2, 1, last);
            GE_WAIT_V(8); GE_WAIT_L(0); GE_BAR; GE_MMA(0, 0, At, B0); GE_MMA(0, 1, At, B1); GE_BAR; GE_SCHED;
            GE_LDA(At, 1, 1); GE_STAGEB(GE_SB(1, 0), b3); GE_STAGEB(GE_SB(1, 1), b3 + hstepB); GE_STAGEA(GE_SA(1, 0), a3, 0, last);
            GE_WAIT_V(8); GE_WAIT_L(0); GE_BAR; GE_MMA(1, 0, At, B0); GE_MMA(1, 1, At, B1); GE_BAR; GE_SCHED;
        }
        if constexpr (F8) asm volatile("s_nop 15\n\ts_nop 15" ::: "memory");
        if (wr == 0) GE_BAR;
        E(acc, cur, wr, wc, fr, fq, pre);
        if (!has_next) break;
#pragma unroll
        for (int a = 0; a < 2; ++a)
#pragma unroll
            for (int b = 0; b < 2; ++b)
#pragma unroll
                for (int m = 0; m < 4; ++m)
#pragma unroll
                    for (int n = 0; n < 2; ++n) acc[a][b][m][n] = (f32x4){0.f, 0.f, 0.f, 0.f};
        cur = nxt; cA = nA; cB = nB; ++ui;
        if (GM == 2) { _Pragma("unroll") for (int _h = 0; _h < 2; ++_h) _Pragma("unroll") for (int _i = 0; _i < 2; ++_i) voffG[_h][_i] = nvoffG[_h][_i]; }
        if (wr == 1) GE_BAR;
    }
    GE_WAIT_V(0);
    GE_BAR;
#undef GE_ROWOFF
#undef GE_SA
#undef GE_SB
#undef GE_STAGEA
#undef GE_STAGEB
#undef GE_LDA
#undef GE_LDB
#undef GE_MMA
#undef GE_WAIT_V
#undef GE_WAIT_L
#undef GE_BAR
#undef GE_SCHED
}
}
__device__ __forceinline__ int tr_dstrow(int n, int kind, int second) {
    if (kind == 1) { if (n < 1024 || n >= 2048) return n; const int tile = n & ~255, wi = n & 255, g = wi >> 6, d = wi & 63; return tile + 128 * (d >> 5) + 32 * g + 8 * ((d >> 2) & 3) + 4 * ((d >> 4) & 1) + (d & 3); }
    if (kind == 2) return (n >> 7) * 256 + (n & 127) + second * 128;
    return n;
}
__device__ __forceinline__ void tr_item(const float* W, int ldw, int K, bf16_t* WT, int kb, int nb, int kind, int second, LAS float* scr, int lane) {
    const int k0 = 64 * kb, n0 = 32 * nb;
#pragma unroll 8
    for (int i = 0; i < 32; ++i) { const int kk = 2 * i + (lane >> 5); scr[kk * 33 + (lane & 31)] = W[(size_t)(k0 + kk) * ldw + n0 + (lane & 31)]; }
    asm volatile("s_waitcnt lgkmcnt(0)" ::: "memory");
    const int c = lane & 7;
#pragma unroll
    for (int j = 0; j < 4; ++j) { const int n = (lane >> 3) + 8 * j; const LAS float* s = scr + (8 * c) * 33 + n;
        u32x4 o; o.x = cvt_pk_bf16(s[0 * 33], s[1 * 33]); o.y = cvt_pk_bf16(s[2 * 33], s[3 * 33]); o.z = cvt_pk_bf16(s[4 * 33], s[5 * 33]); o.w = cvt_pk_bf16(s[6 * 33], s[7 * 33]);
        *(u32x4*)(WT + (size_t)tr_dstrow(n0 + n, kind, second) * K + k0 + 8 * c) = o; }
    asm volatile("s_waitcnt lgkmcnt(0)" ::: "memory");
}
__device__ __forceinline__ void tr_item8(const float* W, int ldw, int K, unsigned char* WT, int kb, int nb, int kind, int second, float scale, LAS float* scr, int lane) {
    const int k0 = 64 * kb, n0 = 32 * nb;
#pragma unroll 8
    for (int i = 0; i < 32; ++i) { const int kk = 2 * i + (lane >> 5); scr[kk * 33 + (lane & 31)] = W[(size_t)(k0 + kk) * ldw + n0 + (lane & 31)] * scale; }
    asm volatile("s_waitcnt lgkmcnt(0)" ::: "memory");
    const int c = lane & 7;
#pragma unroll
    for (int j = 0; j < 4; ++j) { const int n = (lane >> 3) + 8 * j; const LAS float* s = scr + (8 * c) * 33 + n;
        u32x2 o; o.x = pk4_fp8(s[0 * 33], s[1 * 33], s[2 * 33], s[3 * 33]); o.y = pk4_fp8(s[4 * 33], s[5 * 33], s[6 * 33], s[7 * 33]);
        *(u32x2*)(WT + (size_t)tr_dstrow(n0 + n, kind, second) * K + k0 + 8 * c) = o; }
    asm volatile("s_waitcnt lgkmcnt(0)" ::: "memory");
}
__device__ __forceinline__ void conv_expert_item(Frame& F, int layer, int it, LAS float* scr) {
    const int e = it / 384, r = it % 384;
    unsigned char* wgu = F.ws + WS_EXP + (size_t)e * EXP_STRIDE; unsigned char* wd = F.ws + WS_EXP + (size_t)e * EXP_STRIDE + EXP_WD;
    const float *g, *u, *d;
    if (e < 64) { g = F.in[I_EWG] + ((size_t)layer * 64 + e) * 262144; u = F.in[I_EWU] + ((size_t)layer * 64 + e) * 262144; d = F.in[I_EWD] + ((size_t)layer * 64 + e) * 262144; }
    else { g = F.in[I_SWG] + (size_t)layer * 262144; u = F.in[I_SWU] + (size_t)layer * 262144; d = F.in[I_SWD] + (size_t)layer * 262144; }
    if (r < 128) tr_item8(g, 256, 1024, wgu, r / 8, r % 8, 2, 0, 64.f, scr, F.lane);
    else if (r < 256) tr_item8(u, 256, 1024, wgu, (r - 128) / 8, (r - 128) % 8, 2, 1, 64.f, scr, F.lane);
    else tr_item8(d, 1024, 256, wd, (r - 256) / 32, (r - 256) % 32, 0, 0, 32.f, scr, F.lane);
}
__device__ __forceinline__ void p0_prologue(Frame& F) {
    LAS float* sil = (LAS float*)(F.lds);
    for (int i = F.tid; i < 5 * 1024; i += NTHREADS) { const float v = i < 4096 ? F.in[I_C][i] : F.in[I_CCTX][i - 4096]; sil[i] = siluf_(v); }
    __syncthreads();
    LAS float* scr = (LAS float*)(F.lds + 32768 + F.wave * 8704);
    const int gw = F.bid * NWAVES + F.wave, NGW = F.G * NWAVES;
    constexpr int I_MOD = 2 * 96 * 8, I_WINI = 16 * 80, I_WOUTI = 16 * 32, I_GLUI = 16 * 32, I_EXPI = 65 * 384;
    constexpr int NITEMS = I_MOD + I_WINI + 2 * I_WOUTI + 2 * I_GLUI + I_EXPI;
    for (int it = gw; it < NITEMS; it += NGW) {
        int r = it;
        if (r < I_MOD) {
            const int kp = r & 7, rr = r >> 3, l = rr / 96, n = (rr % 96) * 64 + F.lane; const float* W = F.in[I_MODW] + ((size_t)l * 1024 + kp * 128) * 6144 + n;
            const LAS float* sl = sil + kp * 128;
            float a0 = 0.f, a1 = 0.f, a2 = 0.f, a3 = 0.f, a4 = 0.f;
#pragma unroll 16
            for (int k = 0; k < 128; ++k) { const float w = W[(size_t)k * 6144]; a0 += sl[k] * w; a1 += sl[1024 + k] * w; a2 += sl[2048 + k] * w; a3 += sl[3072 + k] * w; a4 += sl[4096 + k] * w; }
            float* mp = (float*)(F.ws + WS_BIG + BG_MODP) + ((size_t)kp * 2 + l) * 5 * 6144 + n;
            mp[0] = a0; mp[6144] = a1; mp[2 * 6144] = a2; mp[3 * 6144] = a3; mp[4 * 6144] = a4;
            continue; }
        r -= I_MOD;
        if (r < I_WINI) {
            if (r % 80 < 32) tr_item(F.in[I_WIN], 2560, 1024, (bf16_t*)(F.ws + WS_WIN), r / 80, r % 80, 1, 0, scr, F.lane);
            else tr_item8(F.in[I_WIN], 2560, 1024, F.ws + WS_WIN8 - (size_t)1024 * 1024, r / 80, r % 80, 1, 0, 64.f, scr, F.lane);
            continue; } r -= I_WINI;
        if (r < I_WOUTI) { tr_item(F.in[I_WOUT], 1024, 1024, (bf16_t*)(F.ws + WS_WOUT), r / 32, r % 32, 0, 0, scr, F.lane); continue; } r -= I_WOUTI;
        if (r < I_WOUTI) { tr_item8(F.in[I_WOUT], 1024, 1024, F.ws + WS_WOUT8, r / 32, r % 32, 0, 0, 64.f, scr, F.lane); continue; } r -= I_WOUTI;
        if (r < I_GLUI) { tr_item8(F.in[I_GLUW], 2048, 1024, F.ws + WS_GLU, r / 32, r % 32, 2, 0, 32.f, scr, F.lane); continue; } r -= I_GLUI;
        if (r < I_GLUI) { tr_item8(F.in[I_GLUW] + 1024, 2048, 1024, F.ws + WS_GLU, r / 32, r % 32, 2, 1, 32.f, scr, F.lane); continue; } r -= I_GLUI;
        conv_expert_item(F, 0, r, scr);
    }
    const int gt = F.bid * NTHREADS + F.tid, NGT = F.G * NTHREADS;
    float* rope = (float*)(F.ws + WS_ROPE);
    for (int i = gt; i < 192 * 16; i += NGT) {
        const int p = i >> 4, f = i & 15; const int pos = p < 128 ? p : p - 128;
        const float inv = powf(10000.0f, -(float)f / 16.0f); const float ang = (float)pos * inv; float s, c; sincosf(ang, &s, &c);
        if (p < 128) { rope[p * 16 + f] = c; rope[2048 + p * 16 + f] = s; } else { rope[4096 + (p - 128) * 16 + f] = c; rope[4096 + 1024 + (p - 128) * 16 + f] = s; }
    }
    bf16_t* lw = (bf16_t*)(F.ws + WS_LRUW);
    for (int i = gt; i < 2 * 2 * 8 * 64 * 64; i += NGT) {
        const int dd = i & 63, e = (i >> 6) & 63, n = (i >> 12) & 7, d = (i >> 15) & 1, type = i >> 16;
        const float* src = type ? F.in[I_LIW] : F.in[I_LRW];
        lw[i] = f2bf(src[((size_t)(d * 8 + n) * 64 + dd) * 64 + e]);
    }
    bf16_t* wrt = (bf16_t*)(F.ws + WS_WRT);
    for (int i = gt; i < 2 * 64 * 1024; i += NGT) {
        const int k = i & 1023, e = (i >> 10) & 63, l = i >> 16; const float w = F.in[I_RW][((size_t)l * 1024 + k) * 64 + e];
        const bf16_t h = f2bf(w); wrt[(size_t)(l * 2 + 0) * 65536 + e * 1024 + k] = h; wrt[(size_t)(l * 2 + 1) * 65536 + e * 1024 + k] = f2bf(w - bf2f(h)); }
    float* sp = (float*)(F.ws + WS_LRUSP);
    for (int i = gt; i < 1024; i += NGT) { const float lam = F.in[I_LLAM][i]; sp[i] = 8.0f * log1pf(expf(-lam)); }
}

__device__ __forceinline__ void p1_norm1(Frame& F) {
    const int gw = F.bid * NWAVES + F.wave, NGW = F.G * NWAVES;
    const float* mp = (const float*)(F.ws + WS_BIG + BG_MODP);
    { float* mv = (float*)(F.ws + WS_MODV);
      for (int i = F.bid * NTHREADS + F.tid; i < 2 * 5 * 6144; i += F.G * NTHREADS) { const int l = i / (5 * 6144), n = i % 6144; float s = F.in[I_MODB][l * 6144 + n];
#pragma unroll
          for (int kp = 0; kp < 8; ++kp) s += mp[(size_t)kp * 2 * 5 * 6144 + i];
          mv[i] = s; } }
    LAS float* lm = (LAS float*)F.lds;
    for (int i = F.tid; i < 5 * 2048; i += NTHREADS) { const int mi = i >> 11, n = i & 2047; float s = F.in[I_MODB][n];
#pragma unroll
        for (int kp = 0; kp < 8; ++kp) s += mp[((size_t)kp * 2 * 5 + mi) * 6144 + n];
        lm[i] = s; }
    __syncthreads();
    bf16_t* H0 = (bf16_t*)(F.ws + WS_ACT);
    const f32x4* gn = (const f32x4*)(F.in[I_N1G]) + F.lane;
    for (int r = gw; r < NROW; r += NGW) {
        const f32x4* xr = (const f32x4*)inrow_ptr(F, r) + F.lane; const int mi = row_mi(r);
        const LAS f32x4* sh = (const LAS f32x4*)(lm + mi * 2048) + F.lane; const LAS f32x4* sc = (const LAS f32x4*)(lm + mi * 2048 + 1024) + F.lane;
        f32x4 v[4]; float s = 0.f;
#pragma unroll
        for (int j = 0; j < 4; ++j) { v[j] = xr[64 * j]; s += (v[j].x * v[j].x + v[j].y * v[j].y) + (v[j].z * v[j].z + v[j].w * v[j].w); }
        const float rstd = rsqrtf(wave_sum(s) * (1.f / DM) + EPS);
        u32x2* o = (u32x2*)(H0 + (size_t)r * DM) + F.lane; unsigned* o8 = (unsigned*)(F.ws + WS_SCR + (size_t)r * DM) + F.lane;
#pragma unroll
        for (int j = 0; j < 4; ++j) { const f32x4 g = gn[64 * j], a = sc[64 * j], b = sh[64 * j];
            const f32x4 y = (v[j] * rstd) * g * (a + 1.0f) + b; u32x2 w; w.x = cvt_pk_bf16(y.x, y.y); w.y = cvt_pk_bf16(y.z, y.w); o[64 * j] = w; o8[64 * j] = pk4_fp8(8.f * y.x, 8.f * y.y, 8.f * y.z, 8.f * y.w); }
    }
}
#define EPI_LOOP_AM _Pragma("unroll") for (int ai = 0; ai < 2; ++ai) _Pragma("unroll") for (int m = 0; m < 4; ++m)
#define EPI_LOOP_BN _Pragma("unroll") for (int bj = 0; bj < 2; ++bj) _Pragma("unroll") for (int n = 0; n < 2; ++n)
typedef f32x4 acc_t[2][2][4][2];
struct NoPre {};
#define EPI_NOPRE using Pre = NoPre; __device__ __forceinline__ NoPre prefetch(const ge::GUnit&, int, int) const { return NoPre{}; }

struct EpiG1 {
    EPI_NOPRE
    static constexpr bool PERM = true;
    unsigned char* ws; const float* qg; const float* kg; int pnoff;
    __device__ __forceinline__ void operator()(const acc_t& acc, const ge::GUnit& u, int wr, int wc, int fr, int fq, const Pre& pre) const {
        const int pn = u.pn + pnoff, row0 = u.pm * 256 + wr * 64 + fr;
        if (pn >= 8) {
            unsigned char* vt = ws + WS_BIG + BG_V + ((size_t)(u.pm * 4 + wr) * 512 + (pn & 1) * 256 + wc * 32 + 8 * fq) * 64 + 4 * fr;
#pragma unroll
            for (int ai = 0; ai < 2; ++ai)
#pragma unroll
                for (int bj = 0; bj < 2; ++bj)
#pragma unroll
                    for (int n = 0; n < 2; ++n)
#pragma unroll
                        for (int i = 0; i < 4; ++i)
                            *(unsigned*)(vt + ((size_t)ai * 1024 + bj * 128 + n * 4 + i) * 64) =
                                pk4_fp8(acc[ai][bj][0][n][i] * 8.f, acc[ai][bj][1][n][i] * 8.f, acc[ai][bj][2][n][i] * 8.f, acc[ai][bj][3][n][i] * 8.f);
            return;
        }
        if (pn < 4) {
            bf16_t* dst = (bf16_t*)(ws + WS_BIG + (pn < 2 ? BG_GATE : BG_XA)); const int colb = (pn & 1) * 256 + wc * 32 + 8 * fq; const bool isg = pn < 2;
            EPI_LOOP_AM { bf16_t* rp = dst + (size_t)(row0 + ai * 128 + m * 16) * 512 + colb;
#pragma unroll
                for (int bj = 0; bj < 2; ++bj) { f32x4 v = acc[ai][bj][m][0], v2 = acc[ai][bj][m][1];
                    if (isg) { v.x = gelu_tanh(v.x); v.y = gelu_tanh(v.y); v.z = gelu_tanh(v.z); v.w = gelu_tanh(v.w); v2.x = gelu_tanh(v2.x); v2.y = gelu_tanh(v2.y); v2.z = gelu_tanh(v2.z); v2.w = gelu_tanh(v2.w); }
                    u32x4 w; w.x = cvt_pk_bf16(v.x, v.y); w.y = cvt_pk_bf16(v.z, v.w); w.z = cvt_pk_bf16(v2.x, v2.y); w.w = cvt_pk_bf16(v2.z, v2.w); *(u32x4*)(rp + bj * 128) = w; } }
            return;
        }
        const bool isk = pn >= 6; const float* gv = isk ? kg : qg;
        unsigned char* dst = ws + WS_BIG + (isk ? BG_K : BG_Q); const int colb = (2 * (pn & 1) + (wc >> 1)) * 128 + (wc & 1) * 64 + 4 * fq;
        const float qs = isk ? 8.0f : 16.f * 0.18033688011112042f;
        f32x4 g4[2][2];
        EPI_LOOP_BN g4[bj][n] = *(const f32x4*)(gv + 32 * bj + 16 * n + 4 * fq);
        const float* rope = (const float*)(ws + WS_ROPE);
        const bool lat = u.pm >= 4;
        EPI_LOOP_AM {
            const int row = row0 + ai * 128 + m * 16;
            float ss = 0.f;
            EPI_LOOP_BN { const f32x4 v = acc[ai][bj][m][n]; ss += (v.x * v.x + v.y * v.y) + (v.z * v.z + v.w * v.w); }
            ss += __shfl_xor(ss, 16); ss += __shfl_xor(ss, 32);
            const float rstd = rsqrtf(ss * (1.f / 64.f) + EPS) * qs;
            f32x4 y[2][2];
            EPI_LOOP_BN y[bj][n] = acc[ai][bj][m][n] * rstd * g4[bj][n];
            if (lat) {
                const int t = (row - NCTX) & (SEQ - 1); const int pr = t >> 6, pc = t & 63;
                const f32x4 c0 = *(const f32x4*)(rope + pr * 16 + 4 * fq), s0 = *(const f32x4*)(rope + 2048 + pr * 16 + 4 * fq);
                const f32x4 c1 = *(const f32x4*)(rope + 4096 + pc * 16 + 4 * fq), s1 = *(const f32x4*)(rope + 5120 + pc * 16 + 4 * fq);
                const f32x4 a0 = y[0][0] * c0 - y[0][1] * s0, b0 = y[0][1] * c0 + y[0][0] * s0;
                const f32x4 a1 = y[1][0] * c1 - y[1][1] * s1, b1 = y[1][1] * c1 + y[1][0] * s1;
                y[0][0] = a0; y[0][1] = b0; y[1][0] = a1; y[1][1] = b1;
            }
            unsigned char* rp = dst + (size_t)row * 512 + colb;
            EPI_LOOP_BN { const f32x4 v = y[bj][n]; *(unsigned*)(rp + 32 * bj + 16 * n) = pk4_fp8(v.x, v.y, v.z, v.w); }
        }
    }
};

struct EpiG2 {
    EPI_NOPRE
    static constexpr bool PERM = false;
    Frame F; int pmoff;
    __device__ __forceinline__ void operator()(const acc_t& acc, const ge::GUnit& u, int wr, int wc, int fr, int fq, const Pre& pre) const {
        const int pm = u.pm + pmoff; const int row0 = pm * 256 + wr * 64 + fr, col0 = u.pn * 256 + wc * 32 + 4 * fq; const int mi = pm < 4 ? 4 : ((pm - 4) >> 5);
        const float* g1 = modv(F, 0, mi, 2) + col0;
        float* ssq = (float*)(F.ws + WS_BIG + BG_SSQ);
        f32x4 gg[2][2];
        EPI_LOOP_BN gg[bj][n] = *(const f32x4*)(g1 + bj * 128 + n * 16);
        EPI_LOOP_AM { const int row = row0 + ai * 128 + m * 16; const float* xi = inrow_ptr(F, row) + col0; bf16_t* xo = xb0_ptr(F, row) + col0; float ss = 0.f;
            EPI_LOOP_BN { const f32x4 xv = *(const f32x4*)(xi + bj * 128 + n * 16); const f32x4 o = xv + gg[bj][n] * acc[ai][bj][m][n]; *(u32x2*)(xo + bj * 128 + n * 16) = f32_to_bf4(o);
                ss += (o.x * o.x + o.y * o.y) + (o.z * o.z + o.w * o.w); }
            ss += __shfl_xor(ss, 16); ss += __shfl_xor(ss, 32);
            if (fq == 0) ssq[(size_t)row * 32 + u.pn * 4 + wc] = ss; }
    }
};

struct EpiUp {
    EPI_NOPRE
    static constexpr bool PERM = true;
    unsigned char* hid;
    __device__ __forceinline__ void operator()(const acc_t& acc, const ge::GUnit& u, int wr, int wc, int fr, int fq, const Pre& pre) const {
        const int row0 = wr * 64 + fr, col0 = u.pn * 128 + wc * 32 + 8 * fq;
        unsigned char* base = hid + (size_t)u.pm * 65536;
        EPI_LOOP_AM { unsigned char* rp = base + (size_t)(row0 + ai * 128 + m * 16) * 256 + col0;
            const f32x4 g = acc[ai][0][m][0], up = acc[ai][1][m][0], g2 = acc[ai][0][m][1], up2 = acc[ai][1][m][1];
            u32x2 w; w.x = pk4_fp8(16.f * siluf_(g.x) * up.x, 16.f * siluf_(g.y) * up.y, 16.f * siluf_(g.z) * up.z, 16.f * siluf_(g.w) * up.w);
            w.y = pk4_fp8(16.f * siluf_(g2.x) * up2.x, 16.f * siluf_(g2.y) * up2.y, 16.f * siluf_(g2.z) * up2.z, 16.f * siluf_(g2.w) * up2.w); *(u32x2*)rp = w; }
    }
};
struct EpiDown {
    static constexpr bool PERM = true;
    struct Pre { i32x2 e[2][4]; };
    unsigned char* Y; int half_base;
    __device__ __forceinline__ Pre prefetch(const ge::GUnit& u, int wr, int fr) const {
        Pre p; const int row0 = wr * 64 + fr;
        EPI_LOOP_AM { const int rt = row0 + ai * 128 + m * 16;
            if (u.rows) p.e[ai][m] = u.rows[rt < u.nvalid ? rt : u.nvalid - 1]; else p.e[ai][m] = (i32x2){((u.aux + rt) << 3) | 6, 0x3f800000}; }
        return p; }
    __device__ __forceinline__ void operator()(const acc_t& acc, const ge::GUnit& u, int wr, int wc, int fr, int fq, const Pre& pre) const {
        const int row0 = wr * 64 + fr, col0 = u.pn * 256 + wc * 32 + 8 * fq;
        EPI_LOOP_AM { const int rt = row0 + ai * 128 + m * 16;
            if (rt < u.nvalid) { const int pk = pre.e[ai][m].x, mrow = pk >> 3, slot = pk & 7; const float gt = 32.f * __int_as_float(pre.e[ai][m].y);
                unsigned char* rp = Y + ((size_t)(mrow - half_base) * 7 + slot) * 1024 + col0;
#pragma unroll
                for (int bj = 0; bj < 2; ++bj) { const f32x4 v = acc[ai][bj][m][0] * gt, v2 = acc[ai][bj][m][1] * gt;
                    u32x2 w; w.x = pk4_fp8(v.x, v.y, v.z, v.w); w.y = pk4_fp8(v2.x, v2.y, v2.z, v2.w); *(u32x2*)(rp + bj * 128) = w; } } }
    }
};

struct EpiS5a {
    EPI_NOPRE
    static constexpr bool PERM = false;
    unsigned char* ws;
    __device__ __forceinline__ void operator()(const acc_t& acc, const ge::GUnit& u, int wr, int wc, int fr, int fq, const Pre& pre) const {
        const int g = u.aux, row0 = wr * 64 + fr, col0 = wc * 32 + 4 * fq; const bool isc = u.pm == 4;
        float* base = isc ? (float*)(ws + WS_BIG + BG_SLOCC) + (size_t)g * 32 * 256 : (float*)(ws + WS_BIG + BG_SLOCL) + ((size_t)g * 1024 + u.pm * 256) * 256;
        EPI_LOOP_AM { const int rt = row0 + ai * 128 + m * 16;
            if (!isc || rt < 32) { float* rp = base + (size_t)rt * 256 + col0;
                EPI_LOOP_BN *(f32x4*)(rp + bj * 128 + n * 16) = acc[ai][bj][m][n]; } }
    }
};
struct EpiS5b {
    EPI_NOPRE
    static constexpr bool PERM = true;
    unsigned char* ws;
    __device__ __forceinline__ void operator()(const acc_t& acc, const ge::GUnit& u, int wr, int wc, int fr, int fq, const Pre& pre) const {
        const int g = u.aux, row0 = u.pm * 256 + wr * 64 + fr, col0 = u.pn * 256 + wc * 32 + 8 * fq;
        unsigned char* base = ws + WS_BIG + BG_ZS5 + (size_t)g * 1024 * 512;
        EPI_LOOP_AM { unsigned char* rp = base + (size_t)(row0 + ai * 128 + m * 16) * 512 + col0;
#pragma unroll
            for (int bj = 0; bj < 2; ++bj) { const f32x4 v = acc[ai][bj][m][0], v2 = acc[ai][bj][m][1];
                u32x2 w; w.x = pk4_fp8(4.f * gelu_tanh(v.x), 4.f * gelu_tanh(v.y), 4.f * gelu_tanh(v.z), 4.f * gelu_tanh(v.w));
                w.y = pk4_fp8(4.f * gelu_tanh(v2.x), 4.f * gelu_tanh(v2.y), 4.f * gelu_tanh(v2.z), 4.f * gelu_tanh(v2.w)); *(u32x2*)(rp + bj * 128) = w; } }
    }
};
struct EpiGlu {
    EPI_NOPRE
    static constexpr bool PERM = false;
    Frame F;
    __device__ __forceinline__ void operator()(const acc_t& acc, const ge::GUnit& u, int wr, int wc, int fr, int fq, const Pre& pre) const {
        const int row0 = u.pm * 256 + wr * 64 + fr, col0 = u.pn * 128 + wc * 32 + 4 * fq; const int mi = u.pm >> 5;
        const float* g1 = modv(F, 1, mi, 2) + col0; const float* gb = F.in[I_GLUB] + col0;
        float* ssq = (float*)(F.ws + WS_BIG + BG_SSQ);
        f32x4 gg[2], bv[2], bg[2];
#pragma unroll
        for (int n = 0; n < 2; ++n) { gg[n] = *(const f32x4*)(g1 + n * 16); bv[n] = *(const f32x4*)(gb + n * 16); bg[n] = *(const f32x4*)(gb + 1024 + n * 16); }
        EPI_LOOP_AM { const int row = row0 + ai * 128 + m * 16; const bf16_t* xi = xb0_ptr(F, NCTX + row) + col0; bf16_t* xo = xb1_ptr(F, row) + col0; float ss = 0.f;
#pragma unroll
            for (int n = 0; n < 2; ++n) { const f32x4 val = acc[ai][0][m][n] + bv[n], gt = acc[ai][1][m][n] + bg[n];
                f32x4 o; o.x = val.x * sigmoidf_(gt.x); o.y = val.y * sigmoidf_(gt.y); o.z = val.z * sigmoidf_(gt.z); o.w = val.w * sigmoidf_(gt.w);
                const f32x4 xn = bf4_to_f32(*(const u32x2*)(xi + n * 16)) + gg[n] * o; *(u32x2*)(xo + n * 16) = f32_to_bf4(xn); ss += (xn.x * xn.x + xn.y * xn.y) + (xn.z * xn.z + xn.w * xn.w); }
            ss += __shfl_xor(ss, 16); ss += __shfl_xor(ss, 32);
            if (fq == 0) ssq[(size_t)row * 32 + u.pn * 4 + wc] = ss; }
    }
};
constexpr int XCS = 520;
__device__ __forceinline__ void lru_consts(Frame& F) {
    LAS float* cst = (LAS float*)(F.lds + MISC_OFF + F.wave * 1536); const float* sp = (const float*)(F.ws + WS_LRUSP);
#pragma unroll
    for (int d = 0; d < 2; ++d) { const int ch = d * 512 + 64 * F.wave + F.lane; cst[(0 * 2 + d) * 64 + F.lane] = F.in[I_LRB][ch]; cst[(1 * 2 + d) * 64 + F.lane] = F.in[I_LIB][ch]; cst[(2 * 2 + d) * 64 + F.lane] = sp[ch]; }
    __syncthreads();
}
template <int CTRL, int RMASK> __device__ __forceinline__ float dpp_f(float old, float src) {
    return __int_as_float(__builtin_amdgcn_update_dpp(__float_as_int(old), __float_as_int(src), CTRL, RMASK, 0xf, false));
}
#define LRU_SCAN_STEP(CTRL, RM) do { _Pragma("unroll") for (int r = 0; r < 16; ++r) { const float a2 = dpp_f<CTRL, RM>(1.0f, av[r]), b2 = dpp_f<CTRL, RM>(0.0f, bv[r]); bv[r] = av[r] * b2 + bv[r]; av[r] = av[r] * a2; } } while (0)
template <bool FINAL>
__device__ __forceinline__ void lru_unit(Frame& F, int b, int cc) {
    const bool isctx = cc < 8;
    const int seg0 = isctx ? b * 256 : NCTX + b * 8192, segn = isctx ? 256 : 8192, t0 = isctx ? cc * 32 : (cc - 8) * 32;
    LAS bf16_t* xcl = (LAS bf16_t*)F.lds;
    {
        int tq = F.tid; asm volatile("" : "+v"(tq));
        const int tg = tq >> 6, c8 = (tq & 63) * 8; const float* cw = F.in[I_CONVW] + c8;
        const bf16_t* xa = (const bf16_t*)(F.ws + WS_BIG + BG_XA) + (size_t)seg0 * 512 + c8;
        u32x4 xin[7];
#pragma unroll
        for (int k = 0; k < 7; ++k) { const int tp = t0 + 4 * tg - 2 + k; xin[k] = (tp >= 0 && tp < segn) ? *(const u32x4*)(xa + (size_t)tp * 512) : (u32x4){0u, 0u, 0u, 0u}; }
        f32x4 w[4][2]; f32x4 cb[2];
#pragma unroll
        for (int k = 0; k < 4; ++k) { w[k][0] = *(const f32x4*)(cw + k * 512); w[k][1] = *(const f32x4*)(cw + k * 512 + 4); }
        cb[0] = *(const f32x4*)(F.in[I_CONVB] + c8); cb[1] = *(const f32x4*)(F.in[I_CONVB] + c8 + 4);
#pragma unroll
        for (int i = 0; i < 4; ++i) {
            f32x4 o0 = cb[0], o1 = cb[1];
#pragma unroll
            for (int k = 0; k < 4; ++k) { const u32x4 x = xin[i + k];
                o0 += w[k][0] * (f32x4){bflo(x.x), bfhi(x.x), bflo(x.y), bfhi(x.y)}; o1 += w[k][1] * (f32x4){bflo(x.z), bfhi(x.z), bflo(x.w), bfhi(x.w)}; }
            u32x4 ov; ov.x = cvt_pk_bf16(o0.x, o0.y); ov.y = cvt_pk_bf16(o0.z, o0.w); ov.z = cvt_pk_bf16(o1.x, o1.y); ov.w = cvt_pk_bf16(o1.z, o1.w);
            *(LAS u32x4*)(xcl + (4 * tg + i) * XCS + c8) = ov;
        }
    }
    __syncthreads();
    const int n = F.wave, r32 = F.lane & 31, hi = F.lane >> 5;
    const bf16_t* lw = (const bf16_t*)(F.ws + WS_LRUW);
    const LAS float* cst = (const LAS float*)(F.lds + MISC_OFF + n * 1536);
    const int row = seg0 + t0 + r32;
    const float* hin = (const float*)(F.ws + WS_BIG + BG_LHIN) + (size_t)(b * LRU_NCH + cc) * 2 * 512;
    f32x2* sm = (f32x2*)(F.ws + WS_BIG + BG_LSUM) + (size_t)(b * LRU_NCH + cc) * 2 * 512;
#pragma unroll
    for (int eb = 0; eb < 2; ++eb) {
        f32x16 ysum = {};
#pragma unroll
        for (int dd = 0; dd < 2; ++dd) {
            const int d = 1 - dd;
            const int tl = d ? 31 - r32 : r32;
            f32x16 av = {}, bv = {};
#pragma unroll
            for (int ks = 0; ks < 4; ++ks) {
                const bf16x8 xb = *(const LAS bf16x8*)(xcl + tl * XCS + 64 * n + 16 * ks + 8 * hi);
                const bf16x8 wr_ = *(const bf16x8*)(lw + ((size_t)((0 * 2 + d) * 8 + n) * 64 + 32 * eb + r32) * 64 + 16 * ks + 8 * hi);
                const bf16x8 wi_ = *(const bf16x8*)(lw + ((size_t)((1 * 2 + d) * 8 + n) * 64 + 32 * eb + r32) * 64 + 16 * ks + 8 * hi);
                av = __builtin_amdgcn_mfma_f32_32x32x16_bf16(wr_, xb, av, 0, 0, 0);
                bv = __builtin_amdgcn_mfma_f32_32x32x16_bf16(wi_, xb, bv, 0, 0, 0);
            }
#pragma unroll
            for (int r = 0; r < 16; ++r) {
                const int cl = 32 * eb + crow(r, hi);
                const float rg = sigmoidf_(av[r] + cst[(0 * 2 + d) * 64 + cl]), ig = sigmoidf_(bv[r] + cst[(1 * 2 + d) * 64 + cl]);
                const float la = -rg * cst[(2 * 2 + d) * 64 + cl]; const float a = __expf(la);
                const float x = bf2f(xcl[tl * XCS + 64 * n + cl]);
                av[r] = a; bv[r] = __builtin_amdgcn_sqrtf(fmaxf(fmaf(-a, a, 1.0f), 0.f)) * ig * x;
            }
            LRU_SCAN_STEP(0x111, 0xf); LRU_SCAN_STEP(0x112, 0xf); LRU_SCAN_STEP(0x114, 0xf); LRU_SCAN_STEP(0x118, 0xf); LRU_SCAN_STEP(0x142, 0xa);
            if constexpr (!FINAL) {
                if (r32 == 31) {
#pragma unroll
                    for (int r = 0; r < 16; ++r) sm[d * 512 + 64 * n + 32 * eb + crow(r, hi)] = (f32x2){av[r], bv[r]};
                }
            } else {
#pragma unroll
                for (int q = 0; q < 4; ++q) { const f32x4 hv = *(const f32x4*)(hin + d * 512 + 64 * n + 32 * eb + 8 * q + 4 * hi);
#pragma unroll
                    for (int i = 0; i < 4; ++i) { const float h = bv[4 * q + i] + av[4 * q + i] * hv[i];
                        if (d) ysum[4 * q + i] = __int_as_float(__builtin_amdgcn_ds_swizzle(__float_as_int(h), 0x7C1F));
                        else ysum[4 * q + i] += h; } }
            }
        }
        if constexpr (FINAL) {
            const bf16_t* gp = (const bf16_t*)(F.ws + WS_BIG + BG_GATE) + (size_t)row * 512; bf16_t* yo = (bf16_t*)(F.ws + WS_ACT) + (size_t)row * DM;
#pragma unroll
            for (int q = 0; q < 4; ++q) { const int ch0 = 64 * n + 32 * eb + 8 * q + 4 * hi; const u32x2 gw = *(const u32x2*)(gp + ch0);
                u32x2 w; w.x = cvt_pk_bf16(ysum[4 * q] * bflo(gw.x), ysum[4 * q + 1] * bfhi(gw.x)); w.y = cvt_pk_bf16(ysum[4 * q + 2] * bflo(gw.y), ysum[4 * q + 3] * bfhi(gw.y)); *(u32x2*)(yo + ch0) = w; }
        }
    }
    __syncthreads();
}
#undef LRU_SCAN_STEP
__device__ __forceinline__ void lru_carry(Frame& F) {
    for (int i = F.bid; i < 8; i += F.G) {
        const int b = i >> 1, d = i & 1, ch = F.tid;
        const f32x2* __restrict__ sm = (const f32x2*)(F.ws + WS_BIG + BG_LSUM) + (size_t)b * LRU_NCH * 1024 + d * 512 + ch;
        float* __restrict__ hin = (float*)(F.ws + WS_BIG + BG_LHIN) + (size_t)b * LRU_NCH * 1024 + d * 512 + ch;
        float h = 0.f;
#pragma unroll 1
        for (int k0 = 0; k0 < LRU_NCH; k0 += 24) {
            f32x2 st[24]; int cidx[24];
#pragma unroll
            for (int j = 0; j < 24; ++j) { const int k = k0 + j; const int cc = d == 0 ? k : (k < 8 ? 7 - k : LRU_NCH + 7 - k); cidx[j] = cc; st[j] = sm[(size_t)cc * 1024]; }
#pragma unroll
            for (int j = 0; j < 24; ++j) { hin[(size_t)cidx[j] * 1024] = h; h = st[j].x * h + st[j].y; }
        }
    }
}
namespace at {

#define AT_SBAR() __builtin_amdgcn_sched_barrier(0)
typedef __fp16 h16x2 __attribute__((ext_vector_type(2)));
__device__ __forceinline__ int pk4raw(float a, float b, float c, float d) {
    const h16x2 lo = __builtin_amdgcn_cvt_pkrtz(a, b), hi = __builtin_amdgcn_cvt_pkrtz(c, d);
    return (int)__builtin_amdgcn_perm(*reinterpret_cast<const unsigned*>(&hi), *reinterpret_cast<const unsigned*>(&lo), 0x07050301u);
}
__device__ __forceinline__ void exp_lo(f32x16& p0) {
#pragma unroll
    for (int r = 0; r < 16; ++r) p0[r] = __builtin_amdgcn_exp2f(p0[r]);
}
template <int ABL> __device__ __forceinline__ void finishSM(f32x16& p0, f32x16& p1, i32x8& pw) {
#pragma unroll
    for (int r = 0; r < 16; ++r) p1[r] = __builtin_amdgcn_exp2f(p1[r]);
#pragma unroll
    for (int a = 0; a < 4; ++a) { if (ABL == 4) { pw[a] = __float_as_int(p0[4 * a]) | __float_as_int(p0[4 * a + 2]); pw[4 + a] = __float_as_int(p1[4 * a + 1]) | __float_as_int(p1[4 * a + 3]); continue; }
        pw[a] = pk4raw(p0[4 * a], p0[4 * a + 1], p0[4 * a + 2], p0[4 * a + 3]); pw[4 + a] = pk4raw(p1[4 * a], p1[4 * a + 1], p1[4 * a + 2], p1[4 * a + 3]); }
}
__device__ __forceinline__ void qkt(f32x16& p0, f32x16& p1, const LAS char* Ks, const i32x8& qf, int o0, int o1) {
    const i32x4 a0 = *(const LAS i32x4*)(Ks + o0), a1 = *(const LAS i32x4*)(Ks + o1), b0 = *(const LAS i32x4*)(Ks + 2048 + o0), b1 = *(const LAS i32x4*)(Ks + 2048 + o1);
    const i32x8 k0 = {a0[0], a0[1], a0[2], a0[3], a1[0], a1[1], a1[2], a1[3]}, k1 = {b0[0], b0[1], b0[2], b0[3], b1[0], b1[1], b1[2], b1[3]};
    const f32x16 c = {};
    p0 = __builtin_amdgcn_mfma_scale_f32_32x32x64_f8f6f4(k0, qf, c, 0, 0, 0, 0x78787878, 0, 0x7f7f7f7f);
    p1 = __builtin_amdgcn_mfma_scale_f32_32x32x64_f8f6f4(k1, qf, c, 0, 0, 0, 0x78787878, 0, 0x7f7f7f7f);
}
__device__ __forceinline__ void pv_d0(f32x16* o, f32x16& la, const LAS char* Vs, const i32x8& pw, const i32x8& ones, int o0, int o1) {
#pragma unroll
    for (int d0 = 0; d0 < 4; ++d0) {
        const i32x4 a0 = *(const LAS i32x4*)(Vs + d0 * 2048 + o0), a1 = *(const LAS i32x4*)(Vs + d0 * 2048 + o1);
        const i32x8 vf = {a0[0], a0[1], a0[2], a0[3], a1[0], a1[1], a1[2], a1[3]};
        o[d0] = __builtin_amdgcn_mfma_scale_f32_32x32x64_f8f6f4(pw, vf, o[d0], 1, 0, 0, 0, 0, 0);
    }
    la = __builtin_amdgcn_mfma_scale_f32_32x32x64_f8f6f4(pw, ones, la, 1, 0, 0, 0, 0, 0);
}
__device__ __forceinline__ int krow(int b, int j) { return j < 4 ? b * 256 + 64 * j : NCTX + b * 8192 + 64 * (j - 4); }

constexpr int TILE_B = 12288, KOFF_B = 8192, NRING = 5, LI_OFF = NRING * TILE_B;
template <int ABL> __device__ __forceinline__ void attn_unit(Frame& F, int b, int h, int qrow0, int NT, float lam) {
    const int tid = F.tid, wid = F.wave, lane = F.lane, r32 = lane & 31, hi = lane >> 5;
    LAS char* lds = (LAS char*)F.lds;
    const char* Q = (const char*)(F.ws + WS_BIG + BG_Q); const char* K = (const char*)(F.ws + WS_BIG + BG_K); const char* V = (const char*)(F.ws + WS_BIG + BG_V);
    const int irow = wid * 16 + (lane >> 2), lch = ((lane & 3) ^ ((irow >> 2) & 3)) << 4;
    const unsigned voff = (unsigned)h * 8192u + (unsigned)irow * 64u + (unsigned)lch;
    unsigned koff;
    { const int rho = irow & 31, t = (irow >> 5) & 1, key = 16 * (rho & 3) + 8 * ((rho >> 2) & 1) + (rho >> 3) + 4 * t; koff = (unsigned)key * 512u + (unsigned)h * 128u + (unsigned)lch; }
    const int xo = (r32 >> 2) & 3, o0 = r32 * 64 + (((2 * hi) ^ xo) << 4), o1 = r32 * 64 + (((2 * hi + 1) ^ xo) << 4);
#define AT_WAITBAR(N) asm volatile("s_waitcnt vmcnt(" #N ")\n\ts_barrier" ::: "memory")
#define AT_ISSUE(j, LEAD) do { const int _k0 = krow(b, (j)); LAS char* _bf = lds + ((j) % NRING) * TILE_B; \
        __builtin_amdgcn_global_load_lds((const unsigned*)(V + (size_t)(_k0 >> 6) * 32768 + voff), (LAS unsigned*)(_bf + wid * 1024), 16, 0, 0); \
        if (LEAD) __builtin_amdgcn_global_load_lds((const unsigned*)(K + (size_t)_k0 * 512 + m * 64 + koff), (LAS unsigned*)(_bf + KOFF_B + wid * 1024), 16, 0, 0); } while (0)
#define AT_KB(j) (lds + ((j) % NRING) * TILE_B + KOFF_B)
#define AT_VB(j) (lds + ((j) % NRING) * TILE_B)
    i32x8 ones;
#pragma unroll
    for (int i = 0; i < 8; ++i) ones[i] = 0x38383838;
#pragma unroll 1
    for (int m = 0; m < 2; ++m) {
        f32x16 la = {}; f32x16 o[4] = {}; i32x8 qf;
        { const char* Qw = Q + (size_t)(qrow0 + wid * 32 + r32) * 512 + h * 128 + m * 64 + hi * 32;
          const i32x4 q0 = *(const i32x4*)Qw, q1 = *(const i32x4*)(Qw + 16); qf = (i32x8){q0[0], q0[1], q0[2], q0[3], q1[0], q1[1], q1[2], q1[3]}; }
        asm volatile("s_waitcnt vmcnt(0)" ::: "memory");
        f32x16 pA0, pA1, pB0, pB1; i32x8 pw;
        __syncthreads();
        if (wid < 4) {
            AT_ISSUE(0, true); AT_ISSUE(1, true);
            AT_WAITBAR(2); AT_ISSUE(2, true);
            qkt(pA0, pA1, AT_KB(0), qf, o0, o1); exp_lo(pA0);
            for (int j = 1; j + 1 < NT; j += 2) {
                AT_WAITBAR(2); AT_ISSUE(j + 2, true);
                AT_SBAR(); qkt(pB0, pB1, AT_KB(j), qf, o0, o1);
                finishSM<ABL>(pA0, pA1, pw); AT_SBAR();
                pv_d0(o, la, AT_VB(j - 1), pw, ones, o0, o1); exp_lo(pB0);
                AT_WAITBAR(2); if (j + 3 < NT) AT_ISSUE(j + 3, true);
                AT_SBAR(); qkt(pA0, pA1, AT_KB(j + 1), qf, o0, o1);
                finishSM<ABL>(pB0, pB1, pw); AT_SBAR();
                pv_d0(o, la, AT_VB(j), pw, ones, o0, o1); exp_lo(pA0);
            }
            AT_WAITBAR(0);
            AT_SBAR(); qkt(pB0, pB1, AT_KB(NT - 1), qf, o0, o1);
            finishSM<ABL>(pA0, pA1, pw); AT_SBAR();
            pv_d0(o, la, AT_VB(NT - 2), pw, ones, o0, o1); exp_lo(pB0);
            finishSM<ABL>(pB0, pB1, pw); AT_SBAR();
            pv_d0(o, la, AT_VB(NT - 1), pw, ones, o0, o1);
        } else {
            AT_ISSUE(0, false); AT_ISSUE(1, false);
            AT_WAITBAR(1); AT_ISSUE(2, false);
            qkt(pA0, pA1, AT_KB(0), qf, o0, o1);
            for (int j = 1; j + 1 < NT; j += 2) {
                AT_WAITBAR(1); AT_ISSUE(j + 2, false);
                AT_SBAR(); if (j >= 2) pv_d0(o, la, AT_VB(j - 2), pw, ones, o0, o1);
                exp_lo(pA0); AT_SBAR();
                qkt(pB0, pB1, AT_KB(j), qf, o0, o1);
                finishSM<ABL>(pA0, pA1, pw);
                AT_WAITBAR(1); if (j + 3 < NT) AT_ISSUE(j + 3, false);
                AT_SBAR(); pv_d0(o, la, AT_VB(j - 1), pw, ones, o0, o1);
                exp_lo(pB0); AT_SBAR();
                qkt(pA0, pA1, AT_KB(j + 1), qf, o0, o1);
                finishSM<ABL>(pB0, pB1, pw);
            }
            AT_WAITBAR(0);
            AT_SBAR(); pv_d0(o, la, AT_VB(NT - 3), pw, ones, o0, o1);
            exp_lo(pA0); AT_SBAR();
            qkt(pB0, pB1, AT_KB(NT - 1), qf, o0, o1);
            finishSM<ABL>(pA0, pA1, pw); AT_SBAR();
            pv_d0(o, la, AT_VB(NT - 2), pw, ones, o0, o1); exp_lo(pB0);
            finishSM<ABL>(pB0, pB1, pw); AT_SBAR();
            pv_d0(o, la, AT_VB(NT - 1), pw, ones, o0, o1);
        }
        int tid2 = tid; asm volatile("" : "+v"(tid2));
        f32x4* stash = (f32x4*)(F.ws + WS_SCR) + ((size_t)F.bid * NTHREADS + tid2) * 16;
        if (m == 0) {
#pragma unroll
            for (int q = 0; q < 4; ++q) {
                const float r0 = 0.125f * __builtin_amdgcn_rcpf(la[4 * q]), r1 = 0.125f * __builtin_amdgcn_rcpf(la[4 * q + 1]), r2 = 0.125f * __builtin_amdgcn_rcpf(la[4 * q + 2]), r3 = 0.125f * __builtin_amdgcn_rcpf(la[4 * q + 3]);
#pragma unroll
                for (int d0 = 0; d0 < 4; ++d0) stash[d0 * 4 + q] = (f32x4){o[d0][4 * q] * r0, o[d0][4 * q + 1] * r1, o[d0][4 * q + 2] * r2, o[d0][4 * q + 3] * r3};
                asm volatile("" ::: "memory");
            }
        } else {
            const float* sg = F.in[I_SUBG];
            float g4[4];
#pragma unroll
            for (int d0 = 0; d0 < 4; ++d0) g4[d0] = sg[d0 * 32 + r32] * 0.8f;
            const int l2 = tid2 & 63;
            bf16_t* rp = (bf16_t*)(F.ws + WS_ACT) + (size_t)(qrow0 + wid * 32 + 4 * (l2 >> 5)) * DM + 512 + h * 128 + (l2 & 31);
#pragma unroll
            for (int q = 0; q < 4; ++q) {
                f32x4 st[4];
#pragma unroll
                for (int d0 = 0; d0 < 4; ++d0) st[d0] = stash[d0 * 4 + q];
#pragma unroll
                for (int i = 0; i < 4; ++i) { const int r = 4 * q + i; const float rl = 0.125f * __builtin_amdgcn_rcpf(la[r]);
                    float v[4], ss = 0.f;
#pragma unroll
                    for (int d0 = 0; d0 < 4; ++d0) { v[d0] = st[d0][i] - lam * (o[d0][r] * rl); ss += v[d0] * v[d0]; }
                    ss += __shfl_xor(ss, 1); ss += __shfl_xor(ss, 2); ss += __shfl_xor(ss, 4); ss += __shfl_xor(ss, 8); ss += __shfl_xor(ss, 16);
                    const float rstd = rsqrtf(ss * (1.f / 128.f) + EPS);
#pragma unroll
                    for (int d0 = 0; d0 < 4; ++d0) rp[(size_t)i * DM + d0 * 32] = f2bf(v[d0] * rstd * g4[d0]); }
                rp += 8 * DM;
                asm volatile("" : "+v"(rp) :: "memory");
            }
        }
    }
#undef AT_WAITBAR
#undef AT_LWAIT
#undef AT_ISSUE
#undef AT_KB
#undef AT_VB
#undef AT_SBAR
}
}
struct MoeGeo { int layer, NR, HR, UR; };
__device__ __forceinline__ MoeGeo moe_geo(int layer) { MoeGeo g; g.layer = layer; g.NR = layer ? NLAT : NROW; g.HR = g.NR; g.UR = g.NR / 256; return g; }
__device__ __forceinline__ bf16_t* moe_xrow(const Frame& F, int layer, int mrow) { return layer ? xb1_ptr(F, mrow) : xb0_ptr(F, mrow); }
__device__ __forceinline__ int moe_mi(int layer, int mrow) { return layer ? (mrow >> 13) : row_mi(mrow); }

__device__ __forceinline__ void router_phase(Frame& F, int layer) {
    const MoeGeo G = moe_geo(layer);
    LAS float* rs = (LAS float*)F.lds;
    LAS float* lgt = (LAS float*)(F.lds + 1024) + F.wave * 1024;
    LAS int* selE = (LAS int*)(F.lds + 65536);
    LAS float* selG = (LAS float*)(F.lds + 65536 + 4096);
    LAS int* selP = (LAS int*)(F.lds + 65536 + 8192);
    LAS int* hist = (LAS int*)(F.lds + 65536 + 12288);
    LAS int* basev = hist + 64;
    unsigned char* H2 = F.ws + WS_ACT;
    const bf16_t* wh = (const bf16_t*)(F.ws + WS_WRT) + (size_t)(layer * 2) * 65536; const bf16_t* wl = wh + 65536;
    const float* rb = F.in[I_RB] + layer * 64;
    const float* gn = F.in[I_N2G] + layer * DM;
    int* cnt = (int*)(F.ws + WS_CTL) + layer * 128;
    i32x2* list = (i32x2*)(F.ws + WS_LIST);
    const int w = F.wave, e = F.lane, fr = F.lane & 15, kq = F.lane >> 4;
    for (int unit = F.bid; unit < 256; unit += F.G) {
        const int half = 0, mrow0 = unit * G.UR;
        if (F.tid < 64) hist[F.tid] = 0;
        { const float* ssq = (const float*)(F.ws + WS_BIG + BG_SSQ); const int np = layer ? 32 : 16;
          for (int lr = w; lr < G.UR; lr += NWAVES) { const int mrow = mrow0 + lr; float s = F.lane < np ? ssq[(size_t)mrow * 32 + F.lane] : 0.f;
              s = wave_sum(s); if (F.lane == 0) rs[lr] = rsqrtf(s * (1.f / DM) + EPS); } }
        __syncthreads();
        for (int g0 = 16 * w; g0 < G.UR; g0 += 16 * NWAVES) {
            const int nrow = (G.UR - g0) < 16 ? (G.UR - g0) : 16; const bool rok = fr < nrow;
            const int lrow = g0 + (rok ? fr : nrow - 1), mrow = mrow0 + lrow, mi = moe_mi(layer, mrow);
            const bf16_t* xp = moe_xrow(F, layer, mrow) + 8 * kq; const float rstd = rs[lrow];
            const float* shp = modv(F, layer, mi, 3) + 8 * kq; const float* scp = modv(F, layer, mi, 4) + 8 * kq; const float* gp = gn + 8 * kq;
            unsigned char* hp = H2 + (size_t)mrow * DM + 8 * kq;
            const bf16_t* whp = wh + (size_t)fr * 1024 + 8 * kq; const bf16_t* wlp = wl + (size_t)fr * 1024 + 8 * kq;
            f32x4 acc[4];
#pragma unroll
            for (int i = 0; i < 4; ++i) acc[i] = (f32x4){0.f, 0.f, 0.f, 0.f};
#pragma unroll 2
            for (int ks = 0; ks < 32; ++ks) {
                const int k0 = 32 * ks;
                const u32x4 xw = *(const u32x4*)(xp + k0); const f32x4 x0 = bf4_to_f32((u32x2){xw.x, xw.y}), x1 = bf4_to_f32((u32x2){xw.z, xw.w});
                const f32x4 g0v = *(const f32x4*)(gp + k0), g1v = *(const f32x4*)(gp + k0 + 4), c0 = *(const f32x4*)(scp + k0), c1 = *(const f32x4*)(scp + k0 + 4), s0 = *(const f32x4*)(shp + k0), s1 = *(const f32x4*)(shp + k0 + 4);
                const f32x4 y0 = (x0 * rstd) * g0v * (c0 + 1.0f) + s0, y1 = (x1 * rstd) * g1v * (c1 + 1.0f) + s1;
                u32x4 hv; hv.x = cvt_pk_bf16(y0.x, y0.y); hv.y = cvt_pk_bf16(y0.z, y0.w); hv.z = cvt_pk_bf16(y1.x, y1.y); hv.w = cvt_pk_bf16(y1.z, y1.w);
                if (rok) { u32x2 h8; h8.x = pk4_fp8(y0.x, y0.y, y0.z, y0.w); h8.y = pk4_fp8(y1.x, y1.y, y1.z, y1.w); *(u32x2*)(hp + k0) = h8; }
                u32x4 lv; lv.x = cvt_pk_bf16(y0.x - bflo(hv.x), y0.y - bfhi(hv.x)); lv.y = cvt_pk_bf16(y0.z - bflo(hv.y), y0.w - bfhi(hv.y));
                lv.z = cvt_pk_bf16(y1.x - bflo(hv.z), y1.y - bfhi(hv.z)); lv.w = cvt_pk_bf16(y1.z - bflo(hv.w), y1.w - bfhi(hv.w));
                const bf16x8 ah = *reinterpret_cast<const bf16x8*>(&hv), al = *reinterpret_cast<const bf16x8*>(&lv);
#pragma unroll
                for (int blk = 0; blk < 4; ++blk) {
                    const bf16x8 bh = *(const bf16x8*)(whp + (size_t)blk * 16 * 1024 + k0), bl = *(const bf16x8*)(wlp + (size_t)blk * 16 * 1024 + k0);
                    acc[blk] = __builtin_amdgcn_mfma_f32_16x16x32_bf16(ah, bh, acc[blk], 0, 0, 0);
                    acc[blk] = __builtin_amdgcn_mfma_f32_16x16x32_bf16(al, bh, acc[blk], 0, 0, 0);
                    acc[blk] = __builtin_amdgcn_mfma_f32_16x16x32_bf16(ah, bl, acc[blk], 0, 0, 0);
                }
            }
#pragma unroll
            for (int blk = 0; blk < 4; ++blk)
#pragma unroll
                for (int r = 0; r < 4; ++r) lgt[(4 * kq + r) * 64 + 16 * blk + fr] = acc[blk][r];
            asm volatile("s_waitcnt lgkmcnt(0)" ::: "memory");
            const float bias = rb[e];
            for (int rr = 0; rr < nrow; ++rr) {
                const float lg = lgt[rr * 64 + e];
                const float aff = 1.0f / (1.0f + expf(-lg)); const float scv = aff + bias;
                int rank = 0;
#pragma unroll 8
                for (int j = 0; j < 64; ++j) { const float sj = __shfl(scv, j); rank += (sj > scv || (sj == scv && j < e)) ? 1 : 0; }
                const bool sel = rank < 6; const float ssum = wave_sum(sel ? aff : 0.f);
                if (sel) { const int idx = (g0 + rr) * 6 + rank; selE[idx] = e; selG[idx] = aff / ssum * 2.5f; selP[idx] = atomicAdd((int*)&hist[e], 1); }
            }
            asm volatile("s_waitcnt lgkmcnt(0)" ::: "memory");
        }
        __syncthreads();
        if (F.tid < 64) basev[F.tid] = atomicAdd(&cnt[half * 64 + F.tid], hist[F.tid]);
        __syncthreads();
        for (int idx = F.tid; idx < G.UR * 6; idx += NTHREADS) { const int ee = selE[idx], lrow = idx / 6, slot = idx - lrow * 6, mrow = mrow0 + lrow;
            list[(size_t)(half * 64 + ee) * CAPH + basev[ee] + selP[idx]] = (i32x2){mrow * 8 + slot, __float_as_int(selG[idx])};
            ((float*)(F.ws + WS_GATE))[(size_t)mrow * 8 + slot] = selG[idx]; }
        __syncthreads();
    }
}

__device__ __forceinline__ void moe_table(Frame& F, const int* cnt) {
    LAS int* tstart = (LAS int*)(F.lds + MISC_OFF); LAS int* tcnt = tstart + 64;
    if (F.wave == 0) { const int c = cnt[F.lane]; const int nt = (c + 255) >> 8; int incl = nt;
#pragma unroll
        for (int o = 1; o < 64; o <<= 1) { const int v = __shfl_up(incl, o); if (F.lane >= o) incl += v; }
        tstart[F.lane] = incl - nt; tcnt[F.lane] = c; }
    __syncthreads();
}
struct SchedMoe { int G, c, nsh, npn, half_base; const LAS int* tstart; const i32x2* list; const char* A0; const char* W0; size_t wofs, tstepB, astep;
    __device__ __forceinline__ const i32x2* dummy() const { return list; }
    __device__ __forceinline__ bool next(int k, ge::GUnit& u) const {
        const int T = (k / npn) * G + c, pn = k % npn;
        int e = 64, j = T, nv = 256;
        if (T >= nsh) { const int rem = T - nsh, l = lane_id() & 63; const int st = tstart[l], cn_l = tstart[64 + l];
            const unsigned long long m = __ballot(rem >= st && rem < st + ((cn_l + 255) >> 8));
            if (m == 0ull) return false;
            e = __builtin_ctzll(m); j = rem - tstart[e]; const int cn = tstart[64 + e]; nv = (cn - j * 256) < 256 ? (cn - j * 256) : 256; }
        u.pm = T; u.pn = pn; u.nvalid = nv; u.rows = e == 64 ? nullptr : list + (size_t)e * CAPH + j * 256; u.aux = e == 64 ? half_base + j * 256 : 0;
        u.A = A0 + (size_t)T * astep; u.B = W0 + (size_t)e * EXP_STRIDE + wofs + (size_t)pn * tstepB; return true; }
};
__device__ __forceinline__ void moe_up(Frame& F, int layer, int half) {
    const MoeGeo G = moe_geo(layer);
    moe_table(F, (const int*)(F.ws + WS_CTL) + layer * 128 + half * 64);
    const int cs = (F.G % 8 == 0) ? (F.bid % 8) * (F.G / 8) + F.bid / 8 : F.bid;
    SchedMoe S{F.G, cs, G.HR / 256, 2, half * G.HR, (const LAS int*)(F.lds + MISC_OFF), (const i32x2*)(F.ws + WS_LIST) + (size_t)half * 64 * CAPH,
               (const char*)(F.ws + WS_ACT), (const char*)(F.ws + WS_EXP), (size_t)0, (size_t)256 * 1024, (size_t)0};
    EpiUp E{F.ws + WS_SCR};
    ge::gemm_run<EpiUp, SchedMoe, ge::AMapPlain, 2, true>(F.lds, nullptr, 8, 1024u, 0u, (size_t)128, ge::AMapPlain{1024u}, 1024u, S, E, 0x79797979, 0x7f7f7f7f);
}
__device__ __forceinline__ void moe_down(Frame& F, int layer, int half) {
    const MoeGeo G = moe_geo(layer);
    moe_table(F, (const int*)(F.ws + WS_CTL) + layer * 128 + half * 64);
    const int cs = (F.G % 8 == 0) ? (F.bid % 8) * (F.G / 8) + F.bid / 8 : F.bid;
    SchedMoe S{F.G, cs, G.HR / 256, 4, half * G.HR, (const LAS int*)(F.lds + MISC_OFF), (const i32x2*)(F.ws + WS_LIST) + (size_t)half * 64 * CAPH,
               (const char*)(F.ws + WS_SCR), (const char*)(F.ws + WS_EXP), (size_t)EXP_WD, (size_t)256 * 256, (size_t)256 * 256};
    EpiDown E{F.ws + WS_BIG, half * G.HR};
    ge::gemm_run<EpiDown, SchedMoe, ge::AMapPlain, 0, true>(F.lds, nullptr, 2, 256u, 128u * 256u, (size_t)128, ge::AMapPlain{256u}, 0u, S, E, 0x7a7a7a7a, 0x7b7b7b7b);
}

struct DTile { int e, nv, valid, aux, j; };
__device__ __forceinline__ DTile down_tile(int T, int nsh, const LAS int* tstart) {
    DTile t; t.e = 64; t.nv = 256; t.valid = 1; t.j = T;
    if (T >= nsh) { const int rem = T - nsh, l = lane_id() & 63; const int st = tstart[l], cn_l = tstart[64 + l];
        const unsigned long long m = __ballot(rem >= st && rem < st + ((cn_l + 255) >> 8));
        if (m == 0ull) { t.valid = 0; t.aux = 0; return t; }
        t.e = __builtin_ctzll(m); t.j = __builtin_amdgcn_readfirstlane(rem - tstart[t.e]); const int cn = __builtin_amdgcn_readfirstlane(tstart[64 + t.e]); t.nv = (cn - t.j * 256) < 256 ? (cn - t.j * 256) : 256; }
    t.aux = t.e == 64 ? t.j * 256 : 0;
    return t;
}
#ifndef D2_LOCKSTEP
#define D2_LOCKSTEP 0
#endif
template <int ABL> __device__ __forceinline__ void moe_down2(Frame& F, int layer) {
    const MoeGeo G = moe_geo(layer);
    moe_table(F, (const int*)(F.ws + WS_CTL) + layer * 128);
    const int cs = (F.G % 8 == 0) ? (F.bid % 8) * (F.G / 8) + F.bid / 8 : F.bid;
    const LAS int* tstart = (const LAS int*)(F.lds + MISC_OFF);
    const i32x2* list = (const i32x2*)(F.ws + WS_LIST);
    const int nsh = G.HR / 256;
    int tid_ = threadIdx.x; asm volatile("" : "+v"(tid_));
    const int tid = tid_, wid = __builtin_amdgcn_readfirstlane(tid >> 6), lane = tid & 63, grp = wid >> 2, w4 = wid & 3, fr = lane & 15, fq = lane >> 4;
    int ntl = 0; while (down_tile(ntl * F.G + cs, nsh, tstart).valid) ++ntl;
    const int Q = 8 * ntl;
    if (Q == 0) return;
    LAS char* hbuf = (LAS char*)F.lds; LAS char* bbuf = (LAS char*)F.lds + 65536 + grp * 32768; LAS char* ebuf = (LAS char*)F.lds + MISC_OFF + 1024 + wid * 512;
    const unsigned char* HID = F.ws + WS_SCR; const unsigned char* W0 = F.ws + WS_EXP + EXP_WD; unsigned char* Y = F.ws + WS_BIG;
    unsigned xsrc[4];
#pragma unroll
    for (int i = 0; i < 4; ++i) xsrc[i] = (unsigned)fq * 256u + 16u * (unsigned)((lane & 15) ^ (4 * i + fq));
    int wof[2][2];
#pragma unroll
    for (int ks = 0; ks < 2; ++ks)
#pragma unroll
        for (int j = 0; j < 2; ++j) wof[ks][j] = fr * 256 + 16 * ((8 * ks + 2 * fq + j) ^ fr);
    const int sw = 0x7d7d7d7d, sa = 0x7b7b7b7b;
    f32x4 acc[4][4];
    i32x8 hf[4][2];
    i32x2 ent[4];
    DTile cur = down_tile(cs, nsh, tstart), nx = cur;
    u32x4 pw[4]; int ph = -1;
#define D2_DMAH(TI, K) do { const unsigned char* _hp = HID + (size_t)((K) * F.G + cs) * 65536 + (size_t)(32 * wid) * 256; \
        _Pragma("unroll") for (int _i = 0; _i < 8; ++_i) \
            __builtin_amdgcn_global_load_lds((const unsigned*)(_hp + _i * 1024 + xsrc[_i & 3]), (LAS unsigned*)(hbuf + wid * 8192 + _i * 1024), 16, 0, 0); \
        if ((TI).e != 64 && lane < 32) __builtin_amdgcn_global_load_lds((const unsigned*)((const char*)(list + (size_t)(TI).e * CAPH + (TI).j * 256 + 64 * w4) + lane * 16), (LAS unsigned*)ebuf, 16, 0, 0); } while (0)
#define D2_DMA(QQ, TI) do { const unsigned char* _wb = W0 + (size_t)(TI).e * EXP_STRIDE + (size_t)((((QQ) & 7) * 2 + grp) * 64 + 4 * w4) * 256; LAS char* _lb = bbuf + ((QQ) & 1) * 16384 + w4 * 4096; \
        _Pragma("unroll") for (int _i = 0; _i < 4; ++_i) \
            __builtin_amdgcn_global_load_lds((const unsigned*)(_wb + _i * 4096 + xsrc[_i]), (LAS unsigned*)(_lb + _i * 1024), 16, 0, 0); } while (0)
    D2_DMAH(cur, 0);
    D2_DMA(0, cur); D2_DMA(1, cur);
#pragma unroll 1
    for (int s = 0; s <= 2 * Q; ++s) {
        const int u = D2_LOCKSTEP ? s : s - grp; const bool act = u >= 0 && u < 2 * Q; const int q = u >> 1; const bool mf = act && !(u & 1), ep = act && (u & 1);
        if (ABL == 5) asm volatile("s_waitcnt vmcnt(30)" ::: "memory"); else
        if (act && q + 1 < Q) asm volatile("s_waitcnt vmcnt(4)" ::: "memory"); else asm volatile("s_waitcnt vmcnt(0)" ::: "memory");
        if (ABL != 6) __builtin_amdgcn_s_barrier();
#define D2_FLUSH() do { if (ABL == 4) { _Pragma("unroll") for (int _m = 0; _m < 4; ++_m) asm volatile("" :: "v"(pw[_m])); ph = -1; } if (ph >= 0 && ABL != 1) { _Pragma("unroll") for (int _m = 0; _m < 4; ++_m) { const int _rt = 64 * w4 + 16 * _m + fr; \
            if (_rt < cur.nv) { const int _pk = ent[_m].x; *(u32x4*)(Y + ((size_t)(_pk >> 3) * 7 + (_pk & 7)) * 1024 + ph * 64 + 16 * fq) = pw[_m]; } } ph = -1; } } while (0)
        if (mf) {
            D2_FLUSH();
            if ((q & 7) == 0) {
                if (q) cur = nx;
                nx = down_tile(((q >> 3) + 1) * F.G + cs, nsh, tstart);
#pragma unroll
                for (int m = 0; m < 4; ++m) {
#pragma unroll
                    for (int ks = 0; ks < 2; ++ks) { const LAS char* hp = hbuf + (64 * w4 + 16 * m) * 256; const i32x4 a0 = *(const LAS i32x4*)(hp + wof[ks][0]), a1 = *(const LAS i32x4*)(hp + wof[ks][1]);
                        hf[m][ks] = (i32x8){a0[0], a0[1], a0[2], a0[3], a1[0], a1[1], a1[2], a1[3]}; }
                    const int rt = 64 * w4 + 16 * m + fr;
                    if (cur.e != 64) ent[m] = *(const LAS i32x2*)(ebuf + (16 * m + fr) * 8); else ent[m] = (i32x2){((cur.aux + rt) << 3) | 6, 0x3f800000};
                }
            }
            const LAS char* wb = bbuf + (q & 1) * 16384;
            i32x8 wf[2];
#define D2_RD(IDX, DST) do { const i32x4 _a = *(const LAS i32x4*)(wb + ((IDX) & 3) * 4096 + wof[(IDX) >> 2][0]), _b = *(const LAS i32x4*)(wb + ((IDX) & 3) * 4096 + wof[(IDX) >> 2][1]); \
                DST = (i32x8){_a[0], _a[1], _a[2], _a[3], _b[0], _b[1], _b[2], _b[3]}; } while (0)
            D2_RD(0, wf[0]);
#pragma unroll
            for (int idx = 0; idx < 8; ++idx) {
                if (idx + 1 < 8) D2_RD(idx + 1, wf[(idx + 1) & 1]);
                const int nt = idx & 3, ks = idx >> 2;
#pragma unroll
                for (int m = 0; m < 4; ++m) {
                    if (ABL == 2) { if (ks == 0) acc[m][nt] = (f32x4){(float)wf[idx & 1][0], (float)wf[idx & 1][3], 0.f, 0.f}; } else
                    if (ks == 0) asm volatile("v_mfma_scale_f32_16x16x128_f8f6f4 %0, %1, %2, 0, %3, %4 op_sel_hi:[0,0,0]" : "=&v"(acc[m][nt]) : "v"(wf[idx & 1]), "v"(hf[m][0]), "v"(sw), "v"(sa));
                    else asm volatile("v_mfma_scale_f32_16x16x128_f8f6f4 %0, %1, %2, %0, %3, %4 op_sel_hi:[0,0,0]" : "+v"(acc[m][nt]) : "v"(wf[idx & 1]), "v"(hf[m][1]), "v"(sw), "v"(sa));
                }
            }
#undef D2_RD
            asm volatile("s_nop 15\n\ts_nop 15" ::: "memory");
        } else if (ep) {
            ph = (q & 7) * 2 + grp;
            if (ABL != 1)
#pragma unroll
            for (int m = 0; m < 4; ++m) {
                int lo[4];
#pragma unroll
                for (int nt = 0; nt < 4; ++nt) { const float cx = __builtin_amdgcn_fmed3f(acc[m][nt].x, -448.f, 448.f); lo[nt] = __builtin_amdgcn_cvt_pk_fp8_f32(cx, __builtin_amdgcn_fmed3f(acc[m][nt].y, -448.f, 448.f), __float_as_int(cx), false); }
#pragma unroll
                for (int nt = 0; nt < 4; ++nt) lo[nt] = __builtin_amdgcn_cvt_pk_fp8_f32(__builtin_amdgcn_fmed3f(acc[m][nt].z, -448.f, 448.f), __builtin_amdgcn_fmed3f(acc[m][nt].w, -448.f, 448.f), lo[nt], true);
                pw[m] = (u32x4){(unsigned)lo[0], (unsigned)lo[1], (unsigned)lo[2], (unsigned)lo[3]};
            }
            if ((q & 7) == 2 && nx.valid) D2_DMAH(nx, (q >> 3) + 1);
            if (q + 2 < Q && ABL != 3) { if (((q + 2) >> 3) == (q >> 3)) D2_DMA(q + 2, cur); else D2_DMA(q + 2, nx); }
        }
    }
    D2_FLUSH();
#undef D2_FLUSH
#undef D2_DMAH
#undef D2_DMA
    asm volatile("s_waitcnt vmcnt(0)" ::: "memory");
    __syncthreads();
}

__device__ __forceinline__ void combine_phase(Frame& F, int layer, int half) {
    const MoeGeo G = moe_geo(layer);
    const int gw = F.bid * NWAVES + F.wave, NGW = F.G * NWAVES;
    const unsigned char* Y = F.ws + WS_BIG;
    const float* gts = (const float*)(F.ws + WS_GATE);
    const f32x4* gn1 = (const f32x4*)(F.in[I_N1G] + DM) + F.lane;
    for (int lr = gw; lr < G.HR; lr += NGW) {
        const int mrow = half * G.HR + lr, mi = moe_mi(layer, mrow);
        f32x4 a[4];
#pragma unroll
        for (int j = 0; j < 4; ++j) a[j] = (f32x4){0.f, 0.f, 0.f, 0.f};
#pragma unroll
        for (int k = 0; k < 7; ++k) { const unsigned* yp = (const unsigned*)(Y + ((size_t)lr * 7 + k) * 1024) + F.lane;
            const float gk = k < 6 ? gts[(size_t)mrow * 8 + k] : 1.0f;
#pragma unroll
            for (int j = 0; j < 4; ++j) a[j] += unpk4_fp8(yp[64 * j]) * gk; }
#pragma unroll
        for (int j = 0; j < 4; ++j) a[j] = a[j] * (1.0f / 8.0f);
        u32x2* xr = (u32x2*)moe_xrow(F, layer, mrow) + F.lane; const f32x4* g2 = (const f32x4*)modv(F, layer, mi, 5) + F.lane;
        f32x4 v[4]; float s = 0.f;
#pragma unroll
        for (int j = 0; j < 4; ++j) { v[j] = bf4_to_f32(xr[64 * j]) + g2[64 * j] * a[j]; s += (v[j].x * v[j].x + v[j].y * v[j].y) + (v[j].z * v[j].z + v[j].w * v[j].w); }
        if (layer) { f32x4* xo = (f32x4*)(F.out + (size_t)mrow * DM) + F.lane;
#pragma unroll
            for (int j = 0; j < 4; ++j) xo[64 * j] = v[j]; }
        else {
#pragma unroll
            for (int j = 0; j < 4; ++j) xr[64 * j] = f32_to_bf4(v[j]); }
        if (layer == 0) {
            const float rstd = rsqrtf(wave_sum(s) * (1.f / DM) + EPS);
            const f32x4* sh = (const f32x4*)modv(F, 1, mi, 0) + F.lane; const f32x4* sc = (const f32x4*)modv(F, 1, mi, 1) + F.lane;
            bf16_t* base; int tau;
            if (mrow < NCTX) { const int bb = mrow >> 8, t = mrow & 255; tau = t & 31; base = (bf16_t*)(F.ws + WS_HS5C) + (size_t)(bb * 8 + (t >> 5)) * 768; }
            else { const int q = mrow - NCTX, bb = q >> 13, t = q & 8191; tau = t & 31; base = (bf16_t*)(F.ws + WS_HS5L) + (size_t)(bb * 256 + (t >> 5)) * 768; }
            const size_t gstride = mrow < NCTX ? (size_t)32 * 768 : (size_t)1024 * 768;
#pragma unroll
            for (int j = 0; j < 4; ++j) { const f32x4 y = (v[j] * rstd) * gn1[64 * j] * (sc[64 * j] + 1.0f) + sh[64 * j];
                const int c = 4 * F.lane + 256 * j; u32x2 wv; wv.x = cvt_pk_bf16(y.x, y.y); wv.y = cvt_pk_bf16(y.z, y.w);
                *(u32x2*)(base + (size_t)(c >> 4) * gstride + tau * 16 + (c & 15)) = wv; }
        }
    }
}
struct S5P { float dre, dim, cre, cim; };
__device__ __forceinline__ S5P s5_param(const Frame& F, int di, int g, int p) {
    const int idx = (di * 64 + g) * 64 + p;
    const float are = fminf(F.in[I_SARE][idx], -1e-4f), aim = F.in[I_SAIM][idx], dl = expf(F.in[I_SLOG][idx]);
    S5P r; r.dre = are * dl; r.dim = aim * dl;
    float s, c; sincosf(r.dim, &s, &c); const float m = expf(r.dre); const float lr = m * c - 1.0f, li = m * s;
    const float den = 1.0f / (are * are + aim * aim);
    r.cre = (lr * are + li * aim) * den; r.cim = (li * are - lr * aim) * den; return r;
}
__device__ __forceinline__ void cpow(const S5P& q, float k, float& wr, float& wi) { float s, c; sincosf(k * q.dim, &s, &c); const float m = expf(k * q.dre); wr = m * c; wi = m * s; }

__device__ __forceinline__ void s5_tables(Frame& F) {
    bf16_t* TA = (bf16_t*)(F.ws + WS_ACT + AC_S5A);
    bf16_t* TB = (bf16_t*)(F.ws + WS_ACT + AC_S5B);
    LAS float* wl = (LAS float*)(F.lds + MISC_OFF) + F.wave * 256;
    const int gw = F.bid * NWAVES + F.wave, NGW = F.G * NWAVES, p = F.lane;
    constexpr int NA = 64 * 63, NB_ = 64 * 32, NC = 64 * 32;
    const float* bre = F.in[I_SBRE]; const float* bim = F.in[I_SBIM]; const float* cre = F.in[I_SCRE]; const float* cim = F.in[I_SCIM];
    for (int it = gw; it < NA + NB_ + NC; it += NGW) {
        if (it < NA) {
            const int g = it / 63, dlt = it % 63 - 31, ad = dlt < 0 ? -dlt : dlt;
            { const S5P qf = s5_param(F, 0, g, p), qb = s5_param(F, 1, g, p); float wr, wi;
              cpow(qf, (float)ad, wr, wi); wl[p] = wr * qf.cre - wi * qf.cim; wl[64 + p] = wr * qf.cim + wi * qf.cre;
              cpow(qb, (float)ad, wr, wi); wl[128 + p] = wr * qb.cre - wi * qb.cim; wl[192 + p] = wr * qb.cim + wi * qb.cre; }
            asm volatile("s_waitcnt lgkmcnt(0)" ::: "memory");
            const int i = F.lane >> 2, j0 = 4 * (F.lane & 3);
            float acc[4] = {0.f, 0.f, 0.f, 0.f};
#pragma unroll 1
            for (int di = 0; di < 2; ++di) {
                if ((di == 0 && dlt < 0) || (di == 1 && dlt > 0)) continue;
                const float* cr = cre + ((size_t)(di * 64 + g) * 16 + i) * 64; const float* ci = cim + ((size_t)(di * 64 + g) * 16 + i) * 64;
                const float* br = bre + ((size_t)(di * 64 + g) * 64) * 16 + j0; const float* bi = bim + ((size_t)(di * 64 + g) * 64) * 16 + j0;
#pragma unroll 4
                for (int pp = 0; pp < 64; ++pp) { const float wr = wl[di * 128 + pp], wi = wl[di * 128 + 64 + pp]; const float c_r = cr[pp], c_i = ci[pp];
                    const float xr = c_r * wr - c_i * wi, xi = c_r * wi + c_i * wr; const f32x4 b_r = *(const f32x4*)(br + pp * 16), b_i = *(const f32x4*)(bi + pp * 16);
                    acc[0] += xr * b_r.x - xi * b_i.x; acc[1] += xr * b_r.y - xi * b_i.y; acc[2] += xr * b_r.z - xi * b_i.z; acc[3] += xr * b_r.w - xi * b_i.w; }
            }
            if (dlt == 0) { const int jj = i - j0; if (jj >= 0 && jj < 4) { const float dv = F.in[I_SD][g * 16 + i]; if (jj == 0) acc[0] += dv; else if (jj == 1) acc[1] += dv; else if (jj == 2) acc[2] += dv; else acc[3] += dv; } }
            u32x2 wv; wv.x = cvt_pk_bf16(acc[0], acc[1]); wv.y = cvt_pk_bf16(acc[2], acc[3]);
            for (int sg = 0; sg < 32; ++sg) { const int tau = sg + dlt; if (tau >= 0 && tau < 32) *(u32x2*)(TB + ((size_t)g * 512 + tau * 16 + i) * 768 + sg * 16 + j0) = wv; }
            asm volatile("s_waitcnt lgkmcnt(0)" ::: "memory");
        } else if (it < NA + NB_) {
            const int r = it - NA, g = r >> 5, tau = r & 31;
            const S5P qf = s5_param(F, 0, g, p), qb = s5_param(F, 1, g, p); float fr_, fi_, br_, bi_;
            cpow(qf, (float)(tau + 1), fr_, fi_); cpow(qb, (float)(32 - tau), br_, bi_);
            for (int i = 0; i < 16; ++i) {
                const float c0r = cre[((size_t)(0 * 64 + g) * 16 + i) * 64 + p], c0i = cim[((size_t)(0 * 64 + g) * 16 + i) * 64 + p];
                const float c1r = cre[((size_t)(1 * 64 + g) * 16 + i) * 64 + p], c1i = cim[((size_t)(1 * 64 + g) * 16 + i) * 64 + p];
                bf16_t* row = TB + ((size_t)g * 512 + tau * 16 + i) * 768 + 512;
                row[p] = f2bf(c0r * fr_ - c0i * fi_); row[64 + p] = f2bf(-(c0r * fi_ + c0i * fr_));
                row[128 + p] = f2bf(c1r * br_ - c1i * bi_); row[192 + p] = f2bf(-(c1r * bi_ + c1i * br_)); }
        } else {
            const int r = it - NA - NB_, g = r >> 5, sg = r & 31;
            const S5P qf = s5_param(F, 0, g, p), qb = s5_param(F, 1, g, p); float wr, wi;
            cpow(qf, (float)(31 - sg), wr, wi); const float fr_ = wr * qf.cre - wi * qf.cim, fi_ = wr * qf.cim + wi * qf.cre;
            cpow(qb, (float)sg, wr, wi); const float br_ = wr * qb.cre - wi * qb.cim, bi_ = wr * qb.cim + wi * qb.cre;
            const float* b0r = bre + ((size_t)(0 * 64 + g) * 64 + p) * 16; const float* b0i = bim + ((size_t)(0 * 64 + g) * 64 + p) * 16;
            const float* b1r = bre + ((size_t)(1 * 64 + g) * 64 + p) * 16; const float* b1i = bim + ((size_t)(1 * 64 + g) * 64 + p) * 16;
            bf16_t* r0 = TA + ((size_t)g * 256 + p) * 512 + sg * 16;
#pragma unroll
            for (int q4 = 0; q4 < 4; ++q4) { const f32x4 xr = *(const f32x4*)(b0r + 4 * q4), xi = *(const f32x4*)(b0i + 4 * q4), yr = *(const f32x4*)(b1r + 4 * q4), yi = *(const f32x4*)(b1i + 4 * q4);
                const f32x4 are_ = xr * fr_ - xi * fi_, aim_ = xr * fi_ + xi * fr_, bre_ = yr * br_ - yi * bi_, bim_ = yr * bi_ + yi * br_;
                u32x2 w0, w1, w2, w3; w0.x = cvt_pk_bf16(are_.x, are_.y); w0.y = cvt_pk_bf16(are_.z, are_.w); w1.x = cvt_pk_bf16(aim_.x, aim_.y); w1.y = cvt_pk_bf16(aim_.z, aim_.w);
                w2.x = cvt_pk_bf16(bre_.x, bre_.y); w2.y = cvt_pk_bf16(bre_.z, bre_.w); w3.x = cvt_pk_bf16(bim_.x, bim_.y); w3.y = cvt_pk_bf16(bim_.z, bim_.w);
                *(u32x2*)(r0 + 4 * q4) = w0; *(u32x2*)(r0 + (size_t)64 * 512 + 4 * q4) = w1; *(u32x2*)(r0 + (size_t)128 * 512 + 4 * q4) = w2; *(u32x2*)(r0 + (size_t)192 * 512 + 4 * q4) = w3; }
        }
    }
}

struct SchedS5a { __device__ __forceinline__ const i32x2* dummy() const { return nullptr; } int G, c; const char* HL; const char* HC; const char* TA;
    __device__ __forceinline__ bool next(int i, ge::GUnit& u) const { const int L = i * G + c; if (L >= 320) return false; const int g = L / 5, k = L % 5;
        u.aux = g; u.pm = k; u.pn = 0; u.nvalid = 256; u.A = k < 4 ? HL + ((size_t)g * 1024 + k * 256) * 1536 : HC + (size_t)g * 32 * 1536; u.B = TA + (size_t)g * 256 * 1024; return true; } };
struct SchedS5b { __device__ __forceinline__ const i32x2* dummy() const { return nullptr; } int G, c; const char* HL; const char* TB;
    __device__ __forceinline__ bool next(int i, ge::GUnit& u) const { const int L = i * G + c; if (L >= 512) return false; const int g = L >> 3, k = (L >> 1) & 3, pn = L & 1;
        u.aux = g; u.pm = k; u.pn = pn; u.nvalid = 256; u.A = HL + ((size_t)g * 1024 + k * 256) * 1536; u.B = TB + ((size_t)g * 512 + pn * 256) * 1536; return true; } };

__device__ __forceinline__ void s5_carry(Frame& F) {
    LAS float* ex = (LAS float*)F.lds;
    for (int u = F.bid; u < 512; u += F.G) {
        const int di = u & 1, b = (u >> 1) & 3, g = u >> 3, p = F.lane, w = F.wave;
        const S5P q = s5_param(F, di, g, p); float lr, li, gr, gi; cpow(q, 32.0f, lr, li); cpow(q, 1024.0f, gr, gi);
        const float* __restrict__ sl = (const float*)(F.ws + WS_BIG + BG_SLOCL) + ((size_t)g * 1024 + b * 256) * 256 + di * 128 + p;
        const float* __restrict__ sc = (const float*)(F.ws + WS_BIG + BG_SLOCC) + ((size_t)g * 32 + b * 8) * 256 + di * 128 + p;
        bf16_t* __restrict__ ho = (bf16_t*)(F.ws + WS_HS5L) + ((size_t)g * 1024 + b * 256) * 768 + 512 + di * 128 + p;
        float sr[32], si[32];
#pragma unroll
        for (int k = 0; k < 32; ++k) { const int c = di == 0 ? 32 * w + k : 255 - 32 * w - k; sr[k] = sl[(size_t)c * 256]; si[k] = sl[(size_t)c * 256 + 64]; }
        float hr = 0.f, hi_ = 0.f;
        { float cr[8], ci[8];
#pragma unroll
          for (int k = 0; k < 8; ++k) { const int cc = di == 0 ? k : 7 - k; cr[k] = sc[cc * 256]; ci[k] = sc[cc * 256 + 64]; }
#pragma unroll
          for (int k = 0; k < 8; ++k) { const float nr = lr * hr - li * hi_ + cr[k], ni = lr * hi_ + li * hr + ci[k]; hr = nr; hi_ = ni; } }
        float qr = 0.f, qi = 0.f;
#pragma unroll
        for (int k = 0; k < 32; ++k) { const float nr = lr * qr - li * qi + sr[k], ni = lr * qi + li * qr + si[k]; qr = nr; qi = ni; }
        ex[(w * 2 + 0) * 64 + p] = qr; ex[(w * 2 + 1) * 64 + p] = qi;
        __syncthreads();
        for (int v = 0; v < w; ++v) { const float tr = ex[(v * 2 + 0) * 64 + p], ti = ex[(v * 2 + 1) * 64 + p]; const float nr = gr * hr - gi * hi_ + tr, ni = gr * hi_ + gi * hr + ti; hr = nr; hi_ = ni; }
#pragma unroll
        for (int k = 0; k < 32; ++k) { const int c = di == 0 ? 32 * w + k : 255 - 32 * w - k; ho[(size_t)c * 768] = f2bf(hr); ho[(size_t)c * 768 + 64] = f2bf(hi_);
            const float nr = lr * hr - li * hi_ + sr[k], ni = lr * hi_ + li * hr + si[k]; hr = nr; hi_ = ni; }
        __syncthreads();
    }
}

struct AMapGlu { __device__ __forceinline__ unsigned operator()(int R, int C) const { const int c = 2 * C; return (unsigned)((R >> 5) * 512 + (R & 31) * 16) + (unsigned)(c >> 4) * (1024u * 512u) + (unsigned)(c & 15); } };
#ifndef MK_PER_PHASE
#define MK_PER_PHASE 0
#endif
constexpr int NPH = 17;

constexpr size_t CTL_BAR_BYTE = 16384;
#define XB_TMO      128
#define XB_XCNT(j)  (256  + 64 * (j))
#define XB_XSUB(j)  (1280 + 64 * (j))
#define XB_XGEN(j)  (2304 + 64 * (j))
#define XB_TOP      3328
#define XB_TOPGEN   3392
#define XCD_BAR_WORDS 3456
#define XB_SPIN_CAP (1u << 22)
__device__ __forceinline__ unsigned xb_ld(unsigned* p)              { return __hip_atomic_load(p, __ATOMIC_RELAXED, __HIP_MEMORY_SCOPE_AGENT); }
__device__ __forceinline__ unsigned xb_add(unsigned* p, unsigned v) { return __hip_atomic_fetch_add(p, v, __ATOMIC_RELAXED, __HIP_MEMORY_SCOPE_AGENT); }
__device__ __forceinline__ unsigned xb_xcc_id() { return (unsigned)__builtin_amdgcn_s_getreg((3 << 11) | 20) & 0xFu; }
#define XB_SPIN(cond, bar) do { unsigned _sp = 0; while (cond) { __builtin_amdgcn_s_sleep(1); \
    if ((++_sp & 255u) == 0u) { if (xb_ld(&(bar)[XB_TMO])) break; if (_sp > XB_SPIN_CAP) { atomicAdd(&(bar)[XB_TMO], 1u); break; } } } } while (0)
struct XcdBarrier { unsigned* bar; unsigned x; volatile LAS unsigned* st; };
__device__ __forceinline__ XcdBarrier xcd_barrier_post(unsigned* bar, volatile LAS unsigned* st) {
    XcdBarrier b; b.bar = bar; b.x = xb_xcc_id(); b.st = st;
    if (threadIdx.x == 0) (void)xb_add(&bar[XB_XCNT(b.x)], 1u);
    return b;
}
__device__ __forceinline__ void xcd_barrier_complete(unsigned* bar, unsigned x, unsigned& nloc, unsigned& nx) {
    const unsigned G = gridDim.x;
    unsigned sum, cnt, mine, sp = 0u;
    for (;;) {
        sum = 0u; cnt = 0u; mine = 0u;
#pragma unroll
        for (unsigned j = 0; j < 16; ++j) { const unsigned c = xb_ld(&bar[XB_XCNT(j)]); sum += c; cnt += (c > 0u) ? 1u : 0u; mine = (j == x) ? c : mine; }
        if (sum == G) break;
        __builtin_amdgcn_s_sleep(1);
        if ((++sp & 255u) == 0u) { if (xb_ld(&bar[XB_TMO])) break; if (sp > XB_SPIN_CAP) { atomicAdd(&bar[XB_TMO], 1u); break; } }
    }
    nloc = mine > 0u ? mine : 1u; nx = cnt > 0u ? cnt : 1u;
}
__device__ __forceinline__ void xcd_barrier(const XcdBarrier& b) {
    asm volatile("s_waitcnt vmcnt(0)" ::: "memory");
    __syncthreads();
    if (threadIdx.x == 0) {
        unsigned* bar = b.bar;
        __builtin_amdgcn_s_waitcnt(0);
        unsigned nloc = b.st[0], nx = b.st[1];
        if (nloc == 0u) { xcd_barrier_complete(bar, b.x, nloc, nx); b.st[0] = nloc; b.st[1] = nx; }
        const unsigned old = xb_add(&bar[XB_XSUB(b.x)], 1u);
        const unsigned gen = old / nloc;
        if (old + 1u == (gen + 1u) * nloc) {
            __builtin_amdgcn_fence(__ATOMIC_RELEASE, "agent");
            asm volatile("s_waitcnt vmcnt(0)" ::: "memory");
            const unsigned og = xb_add(&bar[XB_TOP], 1u);
            const unsigned tg = og / nx;
            if (og + 1u == (tg + 1u) * nx) xb_add(&bar[XB_TOPGEN], 1u);
            else XB_SPIN(xb_ld(&bar[XB_TOPGEN]) == tg, bar);
            __builtin_amdgcn_fence(__ATOMIC_ACQUIRE, "agent");
            xb_add(&bar[XB_XGEN(b.x)], 1u);
            asm volatile("s_waitcnt vmcnt(0)" ::: "memory");
        } else {
            XB_SPIN(xb_ld(&bar[XB_XGEN(b.x)]) == gen, bar);
            __builtin_amdgcn_fence(__ATOMIC_ACQUIRE, "agent");
            asm volatile("s_waitcnt vmcnt(0)" ::: "memory");
        }
    }
    __syncthreads();
}

__global__ void __launch_bounds__(NTHREADS, 2) mega_fwd(Args args) {
    extern __shared__ __attribute__((aligned(16))) unsigned char lds_raw[];
    Frame F;
    F.lds = (LAS unsigned char*)lds_raw; F.in = args.in; F.out = args.out; F.ws = args.ws;
    F.tid = threadIdx.x; F.lane = F.tid & 63; F.wave = __builtin_amdgcn_readfirstlane(F.tid >> 6); F.G = gridDim.x; F.bid = blockIdx.x;
    const int lo = args.ph_lo, hi = args.ph_hi;
    volatile LAS unsigned* bst = (volatile LAS unsigned*)(F.lds + LDS_BYTES - 16);
    XcdBarrier bar; bar.bar = (unsigned*)(F.ws + WS_CTL + CTL_BAR_BYTE); bar.x = 0; bar.st = bst;
    if (hi - lo > 1) { if (F.tid == 0) { bst[0] = 0u; bst[1] = 0u; } __syncthreads(); bar = xcd_barrier_post((unsigned*)(F.ws + WS_CTL + CTL_BAR_BYTE), bst); }
#ifdef PH_ONLY
#define IN(k) ((k) == PH_ONLY && lo <= (k) && (k) < hi)
#else
#define IN(k) (lo <= (k) && (k) < hi)
#endif
#define SEAM(k) do { if (IN(k) && IN((k) + 1)) { if ((k) == 0) cg::this_grid().sync(); else xcd_barrier(bar); } } while (0)

#ifndef PROBE_REP
#define PROBE_REP -1
#endif
#ifndef DOWN_ABL
#define DOWN_ABL 0
#endif
#define NREP(k) ((PROBE_REP == (k)) ? 2 : 1)
#define REPSYNC(k, rep) do { if ((rep) + 1 < NREP(k)) xcd_barrier(bar); } while (0)
    if (IN(0)) { for (int rep = 0; rep < NREP(0); ++rep) { p0_prologue(F); __syncthreads(); REPSYNC(0, rep); } } SEAM(0);
    if (IN(1)) for (int rep = 0; rep < NREP(1); ++rep) { p1_norm1(F); REPSYNC(1, rep); } SEAM(1);
    if (IN(2)) {
        { ge::StaticOrder S; S.init(NROW / 256, 4, F.G, F.bid, F.ws + WS_ACT, (size_t)256 * 2048, F.ws + WS_WIN, (size_t)256 * 2048);
          EpiG1 E{F.ws, F.in[I_QG], F.in[I_KG], 0};
          ge::gemm_run<EpiG1, ge::StaticOrder, ge::AMapPlain, 0>(F.lds, nullptr, 16, 2048u, 128u * 2048u, (size_t)128, ge::AMapPlain{2048u}, 0u, S, E); }
        {
          const int rot = (F.G == 256) ? (F.bid + 256 - 16) % 256 : F.bid;
          ge::StaticOrder S; S.init(NROW / 256, 6, F.G, rot, F.ws + WS_SCR, (size_t)256 * 1024, F.ws + WS_WIN8, (size_t)256 * 1024);
          EpiG1 E{F.ws, F.in[I_QG], F.in[I_KG], 4};
          ge::gemm_run<EpiG1, ge::StaticOrder, ge::AMapPlain, 0, true>(F.lds, nullptr, 8, 1024u, 128u * 1024u, (size_t)128, ge::AMapPlain{1024u}, 0u, S, E, 0x79797979, 0x7c7c7c7c); }
    }
#if PROBE_REP == 2
    xcd_barrier(bar);
    {
        ge::StaticOrder S; S.init(NROW / 256, 10, F.G, F.bid, F.ws + WS_ACT, (size_t)256 * 2048, F.ws + WS_WIN, (size_t)256 * 2048);
        EpiG1 E{F.ws, F.in[I_QG], F.in[I_KG], 0};
        ge::gemm_run<EpiG1, ge::StaticOrder, ge::AMapPlain, 0>(F.lds, nullptr, 16, 2048u, 128u * 2048u, (size_t)128, ge::AMapPlain{2048u}, 0u, S, E);
    }
#endif
    SEAM(2);
    if (IN(3)) { lru_consts(F); for (int u = F.bid; u < NBATCH * LRU_NCH; u += F.G) lru_unit<false>(F, u / LRU_NCH, u % LRU_NCH); }
#if PROBE_REP == 3
    xcd_barrier(bar);
    { lru_consts(F); for (int u = F.bid; u < NBATCH * LRU_NCH; u += F.G) lru_unit<false>(F, u / LRU_NCH, u % LRU_NCH); }
#endif
    SEAM(3);
    if (IN(4)) for (int rep = 0; rep < NREP(4); ++rep) { lru_carry(F); REPSYNC(4, rep); } SEAM(4);
    if (IN(5)) {
        lru_consts(F);
        for (int rep = 0; rep < NREP(51); ++rep) { for (int u = F.bid; u < NBATCH * LRU_NCH; u += F.G) lru_unit<true>(F, u / LRU_NCH, u % LRU_NCH); REPSYNC(51, rep); }
        const float s1 = wave_sum(F.in[I_LQ1][F.lane] * F.in[I_LK1][F.lane]), s2 = wave_sum(F.in[I_LQ2][F.lane] * F.in[I_LK2][F.lane]);
        const float lam = expf(s1) - expf(s2) + 0.2f;
        const int ca = (F.G % 8 == 0) ? (F.bid % 8) * (F.G / 8) + F.bid / 8 : F.bid;
        for (int rep = 0; rep < NREP(50); ++rep)
        for (int u = ca; u < 528; u += F.G) {
            const bool isl = u < 512; const int b = isl ? (u >> 7) : ((u - 512) >> 2), h = isl ? ((u >> 5) & 3) : ((u - 512) & 3);
#ifdef PROBE_ABL
            if (rep == 0) at::attn_unit<PROBE_ABL>(F, b, h, isl ? NCTX + b * SEQ + (u & 31) * 256 : b * 256, isl ? 132 : 4, lam); else
#endif
            at::attn_unit<0>(F, b, h, isl ? NCTX + b * SEQ + (u & 31) * 256 : b * 256, isl ? 132 : 4, lam);
            __syncthreads();
        }
    } SEAM(5);
    if (IN(6)) {
        { ge::StaticOrder S; S.init(NLAT / 256, 4, F.G, F.bid, F.ws + WS_ACT + (size_t)NCTX * 2048, (size_t)256 * 2048, F.ws + WS_WOUT, (size_t)256 * 2048);
          EpiG2 E{F, 4};
          ge::gemm_run<EpiG2, ge::StaticOrder, ge::AMapPlain, 0>(F.lds, nullptr, 16, 2048u, 128u * 2048u, (size_t)128, ge::AMapPlain{2048u}, 0u, S, E); }
        for (int t = F.bid; t < 16; t += F.G) {
            const int pm = t >> 2, pn = t & 3; unsigned char* a8 = F.ws + WS_SCR + (size_t)F.bid * 262144;
            const bf16_t* ay = (const bf16_t*)(F.ws + WS_ACT) + (size_t)pm * 256 * DM;
            for (int i = F.tid; i < 256 * 128; i += NTHREADS) { const u32x4 w = *(const u32x4*)(ay + (size_t)i * 8);
                u32x2 o; o.x = pk4_fp8(16.f * bflo(w.x), 16.f * bfhi(w.x), 16.f * bflo(w.y), 16.f * bfhi(w.y)); o.y = pk4_fp8(16.f * bflo(w.z), 16.f * bfhi(w.z), 16.f * bflo(w.w), 16.f * bfhi(w.w));
                *(u32x2*)(a8 + (size_t)i * 8) = o; }
            asm volatile("s_waitcnt vmcnt(0)" ::: "memory"); __syncthreads();
            ge::SchedOne S; S.u.pm = pm; S.u.pn = pn; S.u.aux = 0; S.u.nvalid = 256; S.u.rows = nullptr; S.u.A = (const char*)a8; S.u.B = (const char*)(F.ws + WS_WOUT8) + (size_t)pn * 256 * 1024;
            EpiG2 E{F, 0};
            ge::gemm_run<EpiG2, ge::SchedOne, ge::AMapPlain, 0, true>(F.lds, nullptr, 8, 1024u, 128u * 1024u, (size_t)128, ge::AMapPlain{1024u}, 0u, S, E, 0x79797979, 0x7b7b7b7b);
        }
    }
#if PROBE_REP == 6
    xcd_barrier(bar);
    {
        ge::StaticOrder S; S.init(NROW / 256, 4, F.G, F.bid, F.ws + WS_ACT, (size_t)256 * 2048, F.ws + WS_WOUT, (size_t)256 * 2048);
        EpiG2 E{F, 0};
        ge::gemm_run<EpiG2, ge::StaticOrder, ge::AMapPlain, 0>(F.lds, nullptr, 16, 2048u, 128u * 2048u, (size_t)128, ge::AMapPlain{2048u}, 0u, S, E);
    }
#endif
    SEAM(6);
    if (IN(7)) { router_phase(F, 0); } SEAM(7);
#if PROBE_REP == 80
    if (IN(8)) { moe_up(F, 0, 0); xcd_barrier(bar); }
#endif
    if (IN(8)) { moe_up(F, 0, 0); asm volatile("s_waitcnt vmcnt(0)" ::: "memory"); __syncthreads(); moe_down2<DOWN_ABL>(F, 0); }
#if PROBE_REP == 81
    if (IN(8)) { xcd_barrier(bar); moe_down2<0>(F, 0); }
#endif
    SEAM(8);
    if (IN(9)) {
        combine_phase(F, 0, 0);
        s5_tables(F);
        LAS float* scr = (LAS float*)(F.lds + 32768 + F.wave * 8704);
        for (int it = F.bid * NWAVES + F.wave; it < 65 * 384; it += F.G * NWAVES) conv_expert_item(F, 1, it, scr);
    } SEAM(9);
    if (IN(10)) for (int rep = 0; rep < NREP(10); ++rep) {
        const int cs = (F.G % 8 == 0) ? (F.bid % 8) * (F.G / 8) + F.bid / 8 : F.bid;
        SchedS5a S{F.G, cs, (const char*)(F.ws + WS_HS5L), (const char*)(F.ws + WS_HS5C), (const char*)(F.ws + WS_ACT + AC_S5A)};
        EpiS5a E{F.ws};
        ge::gemm_run<EpiS5a, SchedS5a, ge::AMapPlain, 0>(F.lds, nullptr, 8, 1024u, 128u * 1536u, (size_t)128, ge::AMapPlain{1536u}, 0u, S, E);
        REPSYNC(10, rep);
    } SEAM(10);
    if (IN(11)) { s5_carry(F); } SEAM(11);
    if (IN(12)) for (int rep = 0; rep < NREP(12); ++rep) {
        const int cs = (F.G % 8 == 0) ? (F.bid % 8) * (F.G / 8) + F.bid / 8 : F.bid;
        SchedS5b S{F.G, cs, (const char*)(F.ws + WS_HS5L), (const char*)(F.ws + WS_ACT + AC_S5B)};
        EpiS5b E{F.ws};
        ge::gemm_run<EpiS5b, SchedS5b, ge::AMapPlain, 0>(F.lds, nullptr, 12, 1536u, 128u * 1536u, (size_t)128, ge::AMapPlain{1536u}, 0u, S, E);
        REPSYNC(12, rep);
    } SEAM(12);
    if (IN(13)) for (int rep = 0; rep < NREP(13); ++rep) {
#if PROBE_REP == 13 && defined(PROBE_HOT)
        ge::StaticOrder S; S.init(NLAT / 256, 8, F.G, F.bid, F.ws + WS_BIG + BG_ZS5, rep == 0 ? (size_t)0 : (size_t)8 * 512, F.ws + WS_GLU, rep == 0 ? (size_t)0 : (size_t)256 * 1024);
#else
        ge::StaticOrder S; S.init(NLAT / 256, 8, F.G, F.bid, F.ws + WS_BIG + BG_ZS5, (size_t)8 * 512, F.ws + WS_GLU, (size_t)256 * 1024);
#endif
        EpiGlu E{F};
        ge::gemm_run<EpiGlu, ge::StaticOrder, AMapGlu, 0, true>(F.lds, nullptr, 8, 1024u, 2048u, (size_t)8 * 1024 * 512, AMapGlu{}, 0u, S, E, 0x7a7a7a7a, 0x7d7d7d7d);
        REPSYNC(13, rep);
    } SEAM(13);
    if (IN(14)) { router_phase(F, 1); } SEAM(14);
    if (IN(15)) { moe_up(F, 1, 0); asm volatile("s_waitcnt vmcnt(0)" ::: "memory"); __syncthreads(); moe_down2<0>(F, 1); } SEAM(15);
    if (IN(16)) for (int rep = 0; rep < NREP(16); ++rep) { combine_phase(F, 1, 0); REPSYNC(16, rep); }
#undef IN
#undef SEAM
}

extern "C" void kernel_launch(void* const* d_in, const int* in_sizes, int n_in, void* d_out, int out_size, void* d_ws, size_t ws_size, hipStream_t stream) {
    static int grid = 0;
    if (grid == 0) {
        if (n_in != 42 || out_size != NLAT * DM || ws_size < WS_END) { fprintf(stderr, "kernel_launch: unexpected problem: n_in %d out %d ws %zu (need %zu)\n", n_in, out_size, ws_size, (size_t)WS_END); grid = -1; return; }
        int dev = 0, cus = 0, per_cu = 0;
        if (hipGetDevice(&dev) != hipSuccess || hipDeviceGetAttribute(&cus, hipDeviceAttributeMultiprocessorCount, dev) != hipSuccess) { grid = -1; return; }
        if (hipFuncSetAttribute((const void*)mega_fwd, hipFuncAttributeMaxDynamicSharedMemorySize, LDS_BYTES) != hipSuccess) { fprintf(stderr, "kernel_launch: hipFuncSetAttribute failed\n"); grid = -1; return; }
        if (hipOccupancyMaxActiveBlocksPerMultiprocessor(&per_cu, (const void*)mega_fwd, NTHREADS, LDS_BYTES) != hipSuccess || per_cu < 1) { fprintf(stderr, "kernel_launch: occupancy query failed (%d)\n", per_cu); grid = -1; return; }
        grid = cus * per_cu; if (grid > 256) grid = 256;
        fprintf(stderr, "kernel_launch: cus %d per_cu %d grid %d ws %zu\n", cus, per_cu, grid, ws_size);
    }
    if (grid < 0) return;
    (void)hipMemsetAsync((char*)d_ws + WS_CTL, 0, 65536, stream);
    Args a{};
    for (int i = 0; i < 42; ++i) a.in[i] = (const float*)d_in[i];
    a.out = (float*)d_out; a.ws = (unsigned char*)d_ws;
#if MK_PER_PHASE
    for (int p = 0; p < NPH; ++p) { a.ph_lo = p; a.ph_hi = p + 1; hipLaunchKernelGGL(mega_fwd, dim3(grid), dim3(NTHREADS), LDS_BYTES, stream, a); }
#else
    a.ph_lo = 0; a.ph_hi = NPH;
    void* kargs[] = {&a};
    const hipError_t e = hipLaunchCooperativeKernel((const void*)mega_fwd, dim3(grid), dim3(NTHREADS), kargs, LDS_BYTES, stream);
    if (e != hipSuccess) fprintf(stderr, "kernel_launch: cooperative launch failed: %s (grid %d)\n", hipGetErrorString(e), grid);
#endif
}
```

```cpp
#include <hip/hip_runtime.h>
#include <hip/hip_cooperative_groups.h>
#include <cstdio>
#include <cstdint>
namespace cg = cooperative_groups;

#define LAS __attribute__((address_space(3)))
typedef unsigned short bf16_t;
typedef short bf16x8 __attribute__((ext_vector_type(8)));
typedef short s16x4 __attribute__((ext_vector_type(4)));
typedef float f32x2 __attribute__((ext_vector_type(2)));
typedef float f32x4 __attribute__((ext_vector_type(4)));
typedef float f32x16 __attribute__((ext_vector_type(16)));
typedef unsigned u32x2 __attribute__((ext_vector_type(2)));
typedef int i32x2 __attribute__((ext_vector_type(2)));
typedef unsigned u32x4 __attribute__((ext_vector_type(4)));

constexpr int DM = 1024, NBATCH = 4, SEQ = 8192, CTXL = 256;
constexpr int NCTX = NBATCH * CTXL;
constexpr int NLAT = NBATCH * SEQ;
constexpr int NROW = NCTX + NLAT;
constexpr float EPS = 1e-6f;
constexpr int NTHREADS = 512, NWAVES = 8;
constexpr int LRU_NCH = 264;
constexpr int CAPH = 33792;

constexpr size_t MiB = 1ull << 20;
constexpr size_t WS_CTL = 0;
constexpr size_t WS_MODV = 1 * MiB;
constexpr size_t WS_ROPE = WS_MODV + 256 * 1024;
constexpr size_t WS_LRUW = WS_MODV + 512 * 1024;
constexpr size_t WS_LRUSP = WS_MODV + 768 * 1024;
constexpr size_t WS_WRT = 2 * MiB;
constexpr size_t WS_WIN = 4 * MiB, WS_WIN8 = 6 * MiB, WS_WOUT = 9 * MiB, WS_GLU = 11 * MiB;
constexpr size_t WS_EXP = 15 * MiB;
constexpr size_t WS_ACT = 113 * MiB;
constexpr size_t WS_BIG = 179 * MiB;
constexpr size_t WS_SCR = 410 * MiB;
constexpr size_t WS_LIST = 472 * MiB;
constexpr size_t WS_GATE = 490 * MiB;
constexpr size_t WS_HS5L = 494 * MiB;
constexpr size_t WS_HS5C = 590 * MiB;
constexpr size_t WS_END = 594 * MiB;
constexpr size_t BG_GATE = 0, BG_XA = 33 * MiB, BG_Q = 66 * MiB, BG_K = 99 * MiB, BG_V = 132 * MiB, BG_LSUM = 165 * MiB, BG_LHIN = 175 * MiB;
constexpr size_t BG_MODP = 200 * MiB;
constexpr size_t BG_SSQ = 200 * MiB;
constexpr size_t BG_ZS5 = 0, BG_SLOCL = 64 * MiB, BG_SLOCC = 128 * MiB;
constexpr size_t AC_S5A = 0, AC_S5B = 16 * MiB;
constexpr size_t EXP_STRIDE = 3 * MiB / 2, EXP_WD = 1 * MiB;

constexpr int RING_BYTES = 131072, MISC_OFF = RING_BYTES, LDS_BYTES = 147456;

__device__ __forceinline__ unsigned cvt_pk_bf16(float lo, float hi) { unsigned r; asm("v_cvt_pk_bf16_f32 %0, %1, %2" : "=v"(r) : "v"(lo), "v"(hi)); return r; }
__device__ __forceinline__ bf16_t f2bf(float f) { return (bf16_t)(cvt_pk_bf16(f, 0.f) & 0xffffu); }
__device__ __forceinline__ float bf2f(bf16_t h) { return __uint_as_float(((unsigned)h) << 16); }
__device__ __forceinline__ float bflo(unsigned w) { return __uint_as_float(w << 16); }
__device__ __forceinline__ float bfhi(unsigned w) { return __uint_as_float(w & 0xffff0000u); }
__device__ __forceinline__ float wave_sum(float v) {
#pragma unroll
    for (int o = 1; o < 64; o <<= 1) v += __shfl_xor(v, o);
    return v;
}
__device__ __forceinline__ float sigmoidf_(float x) { return __builtin_amdgcn_rcpf(1.f + __expf(-x)); }
__device__ __forceinline__ float siluf_(float x) { return x * sigmoidf_(x); }
__device__ __forceinline__ float gelu_tanh(float x) { const float u = 0.7978845608028654f * (x + 0.044715f * x * x * x); return x * __builtin_amdgcn_rcpf(1.f + __expf(-2.f * u)); }
__device__ __forceinline__ unsigned pk4_fp8(float a, float b, float c, float d) {
    a = fminf(fmaxf(a, -448.f), 448.f); b = fminf(fmaxf(b, -448.f), 448.f); c = fminf(fmaxf(c, -448.f), 448.f); d = fminf(fmaxf(d, -448.f), 448.f);
    int w = __builtin_amdgcn_cvt_pk_fp8_f32(a, b, 0, false); w = __builtin_amdgcn_cvt_pk_fp8_f32(c, d, w, true); return (unsigned)w; }
typedef int i32x8 __attribute__((ext_vector_type(8)));
typedef int i32x4 __attribute__((ext_vector_type(4)));
__device__ __forceinline__ f32x4 unpk4_fp8(unsigned w) { const f32x2 lo = __builtin_amdgcn_cvt_pk_f32_fp8((int)w, false), hi = __builtin_amdgcn_cvt_pk_f32_fp8((int)w, true); return (f32x4){lo.x, lo.y, hi.x, hi.y}; }
__device__ __forceinline__ int crow(int r, int hi) { return (r & 3) + 8 * (r >> 2) + 4 * hi; }

__device__ __forceinline__ int lane_id() { return (int)__builtin_amdgcn_mbcnt_hi(~0u, __builtin_amdgcn_mbcnt_lo(~0u, 0u)); }

struct Args { const float* in[42]; float* out; unsigned char* ws; int ph_lo, ph_hi; };
struct Frame {
    LAS unsigned char* lds;
    const float* const* in;
    float* out; unsigned char* ws;
    int tid, lane, wave, G, bid;
};
enum { I_X = 0, I_C, I_CTX, I_CCTX, I_MODW, I_MODB, I_N1G, I_N2G, I_WIN, I_WOUT, I_CONVW, I_CONVB, I_LLAM, I_LRW, I_LRB, I_LIW, I_LIB,
       I_QG, I_KG, I_LQ1, I_LK1, I_LQ2, I_LK2, I_SUBG, I_SARE, I_SAIM, I_SLOG, I_SBRE, I_SBIM, I_SCRE, I_SCIM, I_SD, I_GLUW, I_GLUB,
       I_RW, I_RB, I_EWG, I_EWU, I_EWD, I_SWG, I_SWU, I_SWD };

__device__ __forceinline__ int row_mi(int r) { return r < NCTX ? 4 : ((r - NCTX) >> 13); }
__device__ __forceinline__ bf16_t* xb0_ptr(const Frame& F, int r) { return (bf16_t*)F.out + (size_t)r * DM; }
__device__ __forceinline__ bf16_t* xb1_ptr(const Frame& F, int r) { return (bf16_t*)(F.ws + WS_HS5L) + (size_t)r * DM; }
__device__ __forceinline__ f32x4 bf4_to_f32(u32x2 w) { return (f32x4){bflo(w.x), bfhi(w.x), bflo(w.y), bfhi(w.y)}; }
__device__ __forceinline__ u32x2 f32_to_bf4(f32x4 v) { u32x2 w; w.x = cvt_pk_bf16(v.x, v.y); w.y = cvt_pk_bf16(v.z, v.w); return w; }
__device__ __forceinline__ const float* inrow_ptr(const Frame& F, int r) { return r < NCTX ? F.in[I_CTX] + (size_t)r * DM : F.in[I_X] + (size_t)(r - NCTX) * DM; }
__device__ __forceinline__ const float* modv(const Frame& F, int layer, int mi, int chunk) { return (const float*)(F.ws + WS_MODV) + ((size_t)(layer * 5 + mi) * 6 + chunk) * DM; }
namespace ge {
constexpr int BM = 256, BK = 64, HALF = 128, HTB = HALF * BK * 2, STAGE_BYTES = 8 * HTB, NXCD = 8, WGM = 8;
__host__ __device__ __forceinline__ int lds_byte(int r, int c) { const int st = (r >> 4) * 2 + (c >> 5), rr = r & 15, cc = c & 31, ob = rr * 64 + cc * 2; return st * 1024 + (ob ^ (((ob >> 9) & 1) << 5)); }
__host__ __device__ __forceinline__ void stage_rc(int b, int& R, int& C) { const int st = b / 1024, sb = b % 1024, swz = sb ^ (((sb >> 9) & 1) << 5); R = (st >> 1) * 16 + swz / 64; C = (st & 1) * 32 + (swz % 64) / 2; }

struct GUnit { const char* A; const char* B; const i32x2* rows; int pm, pn, aux, nvalid; };

struct StaticOrder {
    __device__ __forceinline__ const i32x2* dummy() const { return nullptr; }
    int nM, nN, nwg, G, c, base = 0, lim = 0x7fffffff; const char* A0; const char* B0; size_t tstepA, tstepB;
    __device__ void init(int nM_, int nN_, int G_, int c_, const void* A, size_t tsA, const void* B, size_t tsB) { nM = nM_; nN = nN_; nwg = nM * nN; G = G_; c = c_; A0 = (const char*)A; B0 = (const char*)B; tstepA = tsA; tstepB = tsB; }
    __device__ bool next(int i, GUnit& u) const {
        const long L = (long)base + (long)i * G + c; if (L >= nwg || L >= lim) return false;
        int wgid = (int)L; { const int q = nwg / NXCD, r = nwg % NXCD, xcd = wgid % NXCD, off = wgid / NXCD; wgid = (xcd < r ? xcd * (q + 1) : r * (q + 1) + (xcd - r) * q) + off; }
        const int nig = WGM * nN, gid = wgid / nig, fm = gid * WGM, gsz = (nM - fm) < WGM ? (nM - fm) : WGM;
        u.pm = fm + ((wgid % nig) % gsz); u.pn = (wgid % nig) / gsz; u.aux = 0; u.nvalid = 256; u.rows = nullptr;
        u.A = A0 + (size_t)u.pm * tstepA; u.B = B0 + (size_t)u.pn * tstepB; return true;
    }
};
__host__ __device__ __forceinline__ int perm32(int rho) { const int n = rho >> 4, i = rho & 15; return 8 * (i >> 2) + 4 * n + (i & 3); }
struct AMapPlain { unsigned lda2; __device__ __forceinline__ unsigned operator()(int R, int C) const { return (unsigned)R * lda2 + (unsigned)C * 2u; } };

template <class Epi, class Sched, class AMap, int GM, bool F8 = false>
__device__ __forceinline__ void gemm_run(LAS unsigned char* lds, const LAS int* rowl, const int nt, const unsigned ldb2, const unsigned hstepA, const size_t kstepA,
                                         const AMap amap, const unsigned lda2g, const Sched& S, const Epi& E, const int sw = 0x7f7f7f7f, const int sa = 0x7f7f7f7f) {
    int tid_ = threadIdx.x; asm volatile("" : "+v"(tid_));
    const int tid = tid_, wid = __builtin_amdgcn_readfirstlane(tid >> 6), lane = tid & 63, wr = wid >> 2, wc = wid & 3, fr = lane & 15, fq = lane >> 4;
    constexpr bool GATHER = GM != 0;
    unsigned voffA = 0, voffB, voffG[2][2] = {{0u, 0u}, {0u, 0u}}, nvoffG[2][2] = {{0u, 0u}, {0u, 0u}};
    int R0, C0; stage_rc(tid * 16, R0, C0);
    voffB = (unsigned)(Epi::PERM ? ((R0 & ~31) + perm32(R0 & 31)) : R0) * ldb2 + (unsigned)C0 * 2u;
    if (GM == 1) {
#pragma unroll
        for (int i = 0; i < 2; ++i) { voffG[0][i] = (unsigned)(rowl[R0 + 64 * i] >> 3) * lda2g + (unsigned)C0 * 2u; voffG[1][i] = (unsigned)(rowl[128 + R0 + 64 * i] >> 3) * lda2g + (unsigned)C0 * 2u; }
    } else if (GM == 0) voffA = amap(R0, C0);
    const unsigned qstepA = hstepA >> 1, qstepB = 64u * ldb2;
#define GE_ROWOFF(dst, U) do { int _t = threadIdx.x; asm volatile("" : "+v"(_t)); int _R, _C; stage_rc((_t & 511) * 16, _R, _C); \
        const bool _id = (U).rows == nullptr; const i32x2* _lp = _id ? (const i32x2*)S.dummy() : (U).rows; const int _nv = _id ? 256 : (U).nvalid; int _e[2][2]; \
        _Pragma("unroll") for (int _h = 0; _h < 2; ++_h) _Pragma("unroll") for (int _i = 0; _i < 2; ++_i) { const int _r = _h * 128 + _R + 64 * _i; _e[_h][_i] = _lp[_r < _nv ? _r : _nv - 1].x; } \
        _Pragma("unroll") for (int _h = 0; _h < 2; ++_h) _Pragma("unroll") for (int _i = 0; _i < 2; ++_i) { const int _r = _h * 128 + _R + 64 * _i; \
            const int _row = _id ? (U).aux + _r : (_e[_h][_i] >> 3); dst[_h][_i] = (unsigned)_row * lda2g + (unsigned)_C * 2u; } } while (0)
    const size_t kstepB = (size_t)(BK * 2);
    const unsigned hstepB = (unsigned)HALF * ldb2;
    const unsigned ldsw = (unsigned)wid * 1024u;
    const int aoff = lds_byte(wr * 64 + fr, F8 ? fq * 16 : fq * 8), boff = lds_byte(wc * 32 + fr, F8 ? fq * 16 : fq * 8);
    constexpr int KOFF = F8 ? 16 : 1024;
#define GE_SA(b, h) (((b) * 2 + (h)) * ge::HTB)
#define GE_SB(b, h) ((4 + (b) * 2 + (h)) * ge::HTB)
#define GE_STAGEB(bufoff, gbase) do { _Pragma("unroll") for (int _i = 0; _i < 2; ++_i) \
        __builtin_amdgcn_global_load_lds((const unsigned*)((const char*)(gbase) + (size_t)(_i * qstepB) + voffB), (LAS unsigned*)(lds + (bufoff) + ldsw + _i * 8192), 16, 0, 0); } while (0)
#define GE_STAGEA(bufoff, gbase, h, NX) do { _Pragma("unroll") for (int _i = 0; _i < 2; ++_i) { \
        const char* _p = GATHER ? (const char*)(gbase) + ((GM == 2 && (NX)) ? nvoffG[h][_i] : voffG[h][_i]) : (const char*)(gbase) + (size_t)((h) * hstepA + _i * qstepA) + voffA; \
        __builtin_amdgcn_global_load_lds((const unsigned*)_p, (LAS unsigned*)(lds + (bufoff) + ldsw + _i * 8192), 16, 0, 0); } } while (0)
#define GE_LDA(dst, b, h) do { _Pragma("unroll") for (int m = 0; m < 4; ++m) _Pragma("unroll") for (int k = 0; k < 2; ++k) dst[m][k] = *(const LAS bf16x8*)(lds + GE_SA(b, h) + aoff + m * 2048 + k * KOFF); } while (0)
#define GE_LDB(dst, b, h) do { _Pragma("unroll") for (int n = 0; n < 2; ++n) _Pragma("unroll") for (int k = 0; k < 2; ++k) dst[n][k] = *(const LAS bf16x8*)(lds + GE_SB(b, h) + boff + n * 2048 + k * KOFF); } while (0)
#define GE_MMA(ai, bj, At, Bt) do { __builtin_amdgcn_s_setprio(1); _Pragma("unroll") for (int m = 0; m < 4; ++m) _Pragma("unroll") for (int n = 0; n < 2; ++n) { \
        if constexpr (F8) { i32x8 _w, _x; { const bf16x8 _w0 = Bt[n][0], _w1 = Bt[n][1], _x0 = At[m][0], _x1 = At[m][1]; \
                const u32x4 _a = *reinterpret_cast<const u32x4*>(&_w0), _b = *reinterpret_cast<const u32x4*>(&_w1), _c = *reinterpret_cast<const u32x4*>(&_x0), _d = *reinterpret_cast<const u32x4*>(&_x1); \
                _w = (i32x8){(int)_a.x, (int)_a.y, (int)_a.z, (int)_a.w, (int)_b.x, (int)_b.y, (int)_b.z, (int)_b.w}; _x = (i32x8){(int)_c.x, (int)_c.y, (int)_c.z, (int)_c.w, (int)_d.x, (int)_d.y, (int)_d.z, (int)_d.w}; } \
              \
            asm volatile("v_mfma_scale_f32_16x16x128_f8f6f4 %0, %1, %2, %0, %3, %4 op_sel_hi:[0,0,0]" : "+v"(acc[ai][bj][m][n]) : "v"(_w), "v"(_x), "v"(sw), "v"(sa)); } \
        else { _Pragma("unroll") for (int k = 0; k < 2; ++k) acc[ai][bj][m][n] = __builtin_amdgcn_mfma_f32_16x16x32_bf16(Bt[n][k], At[m][k], acc[ai][bj][m][n], 0, 0, 0); } } \
        __builtin_amdgcn_s_setprio(0); } while (0)
#define GE_WAIT_V(n) asm volatile("s_waitcnt vmcnt(" #n ")" ::: "memory")
#define GE_WAIT_L(n) asm volatile("s_waitcnt lgkmcnt(" #n ")" ::: "memory")
#define GE_BAR __builtin_amdgcn_s_barrier()
#define GE_SCHED __builtin_amdgcn_sched_barrier(0)
    GUnit cur, nxt; int ui = 0;
    if (!S.next(0, cur)) return;
    f32x4 acc[2][2][4][2];
#pragma unroll
    for (int a = 0; a < 2; ++a)
#pragma unroll
        for (int b = 0; b < 2; ++b)
#pragma unroll
            for (int m = 0; m < 4; ++m)
#pragma unroll
                for (int n = 0; n < 2; ++n) acc[a][b][m][n] = (f32x4){0.f, 0.f, 0.f, 0.f};
    bf16x8 At[4][2], B0[2][2], B1[2][2];
    const char* cA = cur.A; const char* cB = cur.B;
    if (GM == 2) GE_ROWOFF(voffG, cur);
    GE_STAGEB(GE_SB(0, 0), cB); GE_STAGEB(GE_SB(0, 1), cB + hstepB); GE_STAGEA(GE_SA(0, 0), cA, 0, false); GE_STAGEA(GE_SA(0, 1), cA, 1, false);
    if (wr == 1) GE_BAR;
    GE_WAIT_V(2); GE_BAR;
    GE_STAGEB(GE_SB(1, 0), cB + kstepB); GE_STAGEA(GE_SA(1, 0), cA + kstepA, 0, false); GE_STAGEB(GE_SB(1, 1), cB + hstepB + kstepB);
    GE_WAIT_V(6); GE_BAR;
    for (;;) {
        const bool has_next = S.next(ui + 1, nxt);
        typename Epi::Pre pre = E.prefetch(cur, wr, fr);
        const char* nA = has_next ? nxt.A : cA; const char* nB = has_next ? nxt.B : cB;
        if (GM == 2) { if (has_next && nxt.pn == 0) GE_ROWOFF(nvoffG, nxt); else { _Pragma("unroll") for (int _h = 0; _h < 2; ++_h) _Pragma("unroll") for (int _i = 0; _i < 2; ++_i) nvoffG[_h][_i] = voffG[_h][_i]; } }
#pragma unroll 1
        for (int t = 0; t < nt; t += 2) {
            const bool last = (t == nt - 2);
            const char* a1 = cA + (size_t)(t + 1) * kstepA;
            const char* a2 = last ? nA : cA + (size_t)(t + 2) * kstepA; const char* b2 = last ? nB : cB + (size_t)(t + 2) * kstepB;
            const char* a3 = a2 + kstepA; const char* b3 = b2 + kstepB;
            GE_LDB(B0, 0, 0); GE_LDB(B1, 0, 1); GE_SCHED; GE_LDA(At, 0, 0); GE_STAGEA(GE_SA(1, 1), a1, 1, false);
            GE_WAIT_V(8); GE_WAIT_L(0); GE_BAR; GE_MMA(0, 0, At, B0); GE_MMA(0, 1, At, B1); GE_BAR; GE_SCHED;
            GE_LDA(At, 0, 1); GE_STAGEB(GE_SB(0, 0), b2); GE_STAGEB(GE_SB(0, 1), b2 + hstepB); GE_STAGEA(GE_SA(0, 0), a2, 0, last);
            GE_WAIT_V(8); GE_WAIT_L(0); GE_BAR; GE_MMA(1, 0, At, B0); GE_MMA(1, 1, At, B1); GE_BAR; GE_SCHED;
            GE_LDB(B0, 1, 0); GE_LDB(B1, 1, 1); GE_SCHED; GE_LDA(At, 1, 0); GE_STAGEA(GE_SA(0, 1), a2, 1, last);
            GE_WAIT_V(8); GE_WAIT_L(0); GE_BAR; GE_MMA(0, 0, At, B0); GE_MMA(0, 1, At, B1); GE_BAR; GE_SCHED;
            GE_LDA(At, 1, 1); GE_STAGEB(GE_SB(1, 0), b3); GE_STAGEB(GE_SB(1, 1), b3 + hstepB); GE_STAGEA(GE_SA(1, 0), a3, 0, last);
            GE_WAIT_V(8); GE_WAIT_L(0); GE_BAR; GE_MMA(1, 0, At, B0); GE_MMA(1, 1, At, B1); GE_BAR; GE_SCHED;
        }
        if constexpr (F8) asm volatile("s_nop 15\n\ts_nop 15" ::: "memory");
        if (wr == 0) GE_BAR;
        E(acc, cur, wr, wc, fr, fq, pre);
        if (!has_next) break;
#pragma unroll
        for (int a = 0; a < 2; ++a)
#pragma unroll
            for (int b = 0; b < 2; ++b)
#pragma unroll
                for (int m = 0; m < 4; ++m)
#pragma unroll
                    for (int n = 0; n < 2; ++n) acc[a][b][m][n] = (f32x4){0.f, 0.f, 0.f, 0.f};
        cur = nxt; cA = nA; cB = nB; ++ui;
        if (GM == 2) { _Pragma("unroll") for (int _h = 0; _h < 2; ++_h) _Pragma("unroll") for (int _i = 0; _i < 2; ++_i) voffG[_h][_i] = nvoffG[_h][_i]; }
        if (wr == 1) GE_BAR;
    }
    GE_WAIT_V(0);
    GE_BAR;
#undef GE_ROWOFF
#undef GE_SA
#undef GE_SB
#undef GE_STAGEA
#undef GE_STAGEB
#undef GE_LDA
#undef GE_LDB
#undef GE_MMA
#undef GE_WAIT_V
#undef GE_WAIT_L
#undef GE_BAR
#undef GE_SCHED
}
}
__device__ __forceinline__ int tr_dstrow(int n, int kind, int second) {
    if (kind == 1) { if (n < 1024 || n >= 2048) return n; const int tile = n & ~255, wi = n & 255, g = wi >> 6, d = wi & 63; return tile + 128 * (d >> 5) + 32 * g + 8 * ((d >> 2) & 3) + 4 * ((d >> 4) & 1) + (d & 3); }
    if (kind == 2) return (n >> 7) * 256 + (n & 127) + second * 128;
    return n;
}
__device__ __forceinline__ void tr_item(const float* W, int ldw, int K, bf16_t* WT, int kb, int nb, int kind, int second, LAS float* scr, int lane) {
    const int k0 = 64 * kb, n0 = 32 * nb;
#pragma unroll 8
    for (int i = 0; i < 32; ++i) { const int kk = 2 * i + (lane >> 5); scr[kk * 33 + (lane & 31)] = W[(size_t)(k0 + kk) * ldw + n0 + (lane & 31)]; }
    asm volatile("s_waitcnt lgkmcnt(0)" ::: "memory");
    const int c = lane & 7;
#pragma unroll
    for (int j = 0; j < 4; ++j) { const int n = (lane >> 3) + 8 * j; const LAS float* s = scr + (8 * c) * 33 + n;
        u32x4 o; o.x = cvt_pk_bf16(s[0 * 33], s[1 * 33]); o.y = cvt_pk_bf16(s[2 * 33], s[3 * 33]); o.z = cvt_pk_bf16(s[4 * 33], s[5 * 33]); o.w = cvt_pk_bf16(s[6 * 33], s[7 * 33]);
        *(u32x4*)(WT + (size_t)tr_dstrow(n0 + n, kind, second) * K + k0 + 8 * c) = o; }
    asm volatile("s_waitcnt lgkmcnt(0)" ::: "memory");
}
__device__ __forceinline__ void tr_item8(const float* W, int ldw, int K, unsigned char* WT, int kb, int nb, int kind, int second, float scale, LAS float* scr, int lane) {
    const int k0 = 64 * kb, n0 = 32 * nb;
#pragma unroll 8
    for (int i = 0; i < 32; ++i) { const int kk = 2 * i + (lane >> 5); scr[kk * 33 + (lane & 31)] = W[(size_t)(k0 + kk) * ldw + n0 + (lane & 31)] * scale; }
    asm volatile("s_waitcnt lgkmcnt(0)" ::: "memory");
    const int c = lane & 7;
#pragma unroll
    for (int j = 0; j < 4; ++j) { const int n = (lane >> 3) + 8 * j; const LAS float* s = scr + (8 * c) * 33 + n;
        u32x2 o; o.x = pk4_fp8(s[0 * 33], s[1 * 33], s[2 * 33], s[3 * 33]); o.y = pk4_fp8(s[4 * 33], s[5 * 33], s[6 * 33], s[7 * 33]);
        *(u32x2*)(WT + (size_t)tr_dstrow(n0 + n, kind, second) * K + k0 + 8 * c) = o; }
    asm volatile("s_waitcnt lgkmcnt(0)" ::: "memory");
}
__device__ __forceinline__ void conv_expert_item(Frame& F, int layer, int it, LAS float* scr) {
    const int e = it / 384, r = it % 384;
    unsigned char* wgu = F.ws + WS_EXP + (size_t)e * EXP_STRIDE; unsigned char* wd = F.ws + WS_EXP + (size_t)e * EXP_STRIDE + EXP_WD;
    const float *g, *u, *d;
    if (e < 64) { g = F.in[I_EWG] + ((size_t)layer * 64 + e) * 262144; u = F.in[I_EWU] + ((size_t)layer * 64 + e) * 262144; d = F.in[I_EWD] + ((size_t)layer * 64 + e) * 262144; }
    else { g = F.in[I_SWG] + (size_t)layer * 262144; u = F.in[I_SWU] + (size_t)layer * 262144; d = F.in[I_SWD] + (size_t)layer * 262144; }
    if (r < 128) tr_item8(g, 256, 1024, wgu, r / 8, r % 8, 2, 0, 64.f, scr, F.lane);
    else if (r < 256) tr_item8(u, 256, 1024, wgu, (r - 128) / 8, (r - 128) % 8, 2, 1, 64.f, scr, F.lane);
    else tr_item8(d, 1024, 256, wd, (r - 256) / 32, (r - 256) % 32, 0, 0, 32.f, scr, F.lane);
}
__device__ __forceinline__ void p0_prologue(Frame& F) {
    LAS float* sil = (LAS float*)(F.lds);
    for (int i = F.tid; i < 5 * 1024; i += NTHREADS) { const float v = i < 4096 ? F.in[I_C][i] : F.in[I_CCTX][i - 4096]; sil[i] = siluf_(v); }
    __syncthreads();
    LAS float* scr = (LAS float*)(F.lds + 32768 + F.wave * 8704);
    const int gw = F.bid * NWAVES + F.wave, NGW = F.G * NWAVES;
    constexpr int I_MOD = 2 * 96 * 8, I_WINI = 16 * 80, I_WOUTI = 16 * 32, I_GLUI = 16 * 32, I_EXPI = 65 * 384;
    constexpr int NITEMS = I_MOD + I_WINI + I_WOUTI + 2 * I_GLUI + I_EXPI;
    for (int it = gw; it < NITEMS; it += NGW) {
        int r = it;
        if (r < I_MOD) {
            const int kp = r & 7, rr = r >> 3, l = rr / 96, n = (rr % 96) * 64 + F.lane; const float* W = F.in[I_MODW] + ((size_t)l * 1024 + kp * 128) * 6144 + n;
            const LAS float* sl = sil + kp * 128;
            float a0 = 0.f, a1 = 0.f, a2 = 0.f, a3 = 0.f, a4 = 0.f;
#pragma unroll 16
            for (int k = 0; k < 128; ++k) { const float w = W[(size_t)k * 6144]; a0 += sl[k] * w; a1 += sl[1024 + k] * w; a2 += sl[2048 + k] * w; a3 += sl[3072 + k] * w; a4 += sl[4096 + k] * w; }
            float* mp = (float*)(F.ws + WS_BIG + BG_MODP) + ((size_t)kp * 2 + l) * 5 * 6144 + n;
            mp[0] = a0; mp[6144] = a1; mp[2 * 6144] = a2; mp[3 * 6144] = a3; mp[4 * 6144] = a4;
            continue; }
        r -= I_MOD;
        if (r < I_WINI) {
            if (r % 80 < 32) tr_item(F.in[I_WIN], 2560, 1024, (bf16_t*)(F.ws + WS_WIN), r / 80, r % 80, 1, 0, scr, F.lane);
            else tr_item8(F.in[I_WIN], 2560, 1024, F.ws + WS_WIN8 - (size_t)1024 * 1024, r / 80, r % 80, 1, 0, 64.f, scr, F.lane);
            continue; } r -= I_WINI;
        if (r < I_WOUTI) { tr_item(F.in[I_WOUT], 1024, 1024, (bf16_t*)(F.ws + WS_WOUT), r / 32, r % 32, 0, 0, scr, F.lane); continue; } r -= I_WOUTI;
        if (r < I_GLUI) { tr_item8(F.in[I_GLUW], 2048, 1024, F.ws + WS_GLU, r / 32, r % 32, 2, 0, 32.f, scr, F.lane); continue; } r -= I_GLUI;
        if (r < I_GLUI) { tr_item8(F.in[I_GLUW] + 1024, 2048, 1024, F.ws + WS_GLU, r / 32, r % 32, 2, 1, 32.f, scr, F.lane); continue; } r -= I_GLUI;
        conv_expert_item(F, 0, r, scr);
    }
    const int gt = F.bid * NTHREADS + F.tid, NGT = F.G * NTHREADS;
    float* rope = (float*)(F.ws + WS_ROPE);
    for (int i = gt; i < 192 * 16; i += NGT) {
        const int p = i >> 4, f = i & 15; const int pos = p < 128 ? p : p - 128;
        const float inv = powf(10000.0f, -(float)f / 16.0f); const float ang = (float)pos * inv; float s, c; sincosf(ang, &s, &c);
        if (p < 128) { rope[p * 16 + f] = c; rope[2048 + p * 16 + f] = s; } else { rope[4096 + (p - 128) * 16 + f] = c; rope[4096 + 1024 + (p - 128) * 16 + f] = s; }
    }
    bf16_t* lw = (bf16_t*)(F.ws + WS_LRUW);
    for (int i = gt; i < 2 * 2 * 8 * 64 * 64; i += NGT) {
        const int dd = i & 63, e = (i >> 6) & 63, n = (i >> 12) & 7, d = (i >> 15) & 1, type = i >> 16;
        const float* src = type ? F.in[I_LIW] : F.in[I_LRW];
        lw[i] = f2bf(src[((size_t)(d * 8 + n) * 64 + dd) * 64 + e]);
    }
    bf16_t* wrt = (bf16_t*)(F.ws + WS_WRT);
    for (int i = gt; i < 2 * 64 * 1024; i += NGT) {
        const int k = i & 1023, e = (i >> 10) & 63, l = i >> 16; const float w = F.in[I_RW][((size_t)l * 1024 + k) * 64 + e];
        const bf16_t h = f2bf(w); wrt[(size_t)(l * 2 + 0) * 65536 + e * 1024 + k] = h; wrt[(size_t)(l * 2 + 1) * 65536 + e * 1024 + k] = f2bf(w - bf2f(h)); }
    float* sp = (float*)(F.ws + WS_LRUSP);
    for (int i = gt; i < 1024; i += NGT) { const float lam = F.in[I_LLAM][i]; sp[i] = 8.0f * log1pf(expf(-lam)); }
}

__device__ __forceinline__ void p1_norm1(Frame& F) {
    const int gw = F.bid * NWAVES + F.wave, NGW = F.G * NWAVES;
    const float* mp = (const float*)(F.ws + WS_BIG + BG_MODP);
    { float* mv = (float*)(F.ws + WS_MODV);
      for (int i = F.bid * NTHREADS + F.tid; i < 2 * 5 * 6144; i += F.G * NTHREADS) { const int l = i / (5 * 6144), n = i % 6144; float s = F.in[I_MODB][l * 6144 + n];
#pragma unroll
          for (int kp = 0; kp < 8; ++kp) s += mp[(size_t)kp * 2 * 5 * 6144 + i];
          mv[i] = s; } }
    LAS float* lm = (LAS float*)F.lds;
    for (int i = F.tid; i < 5 * 2048; i += NTHREADS) { const int mi = i >> 11, n = i & 2047; float s = F.in[I_MODB][n];
#pragma unroll
        for (int kp = 0; kp < 8; ++kp) s += mp[((size_t)kp * 2 * 5 + mi) * 6144 + n];
        lm[i] = s; }
    __syncthreads();
    bf16_t* H0 = (bf16_t*)(F.ws + WS_ACT);
    const f32x4* gn = (const f32x4*)(F.in[I_N1G]) + F.lane;
    for (int r = gw; r < NROW; r += NGW) {
        const f32x4* xr = (const f32x4*)inrow_ptr(F, r) + F.lane; const int mi = row_mi(r);
        const LAS f32x4* sh = (const LAS f32x4*)(lm + mi * 2048) + F.lane; const LAS f32x4* sc = (const LAS f32x4*)(lm + mi * 2048 + 1024) + F.lane;
        f32x4 v[4]; float s = 0.f;
#pragma unroll
        for (int j = 0; j < 4; ++j) { v[j] = xr[64 * j]; s += (v[j].x * v[j].x + v[j].y * v[j].y) + (v[j].z * v[j].z + v[j].w * v[j].w); }
        const float rstd = rsqrtf(wave_sum(s) * (1.f / DM) + EPS);
        u32x2* o = (u32x2*)(H0 + (size_t)r * DM) + F.lane; unsigned* o8 = (unsigned*)(F.ws + WS_SCR + (size_t)r * DM) + F.lane;
#pragma unroll
        for (int j = 0; j < 4; ++j) { const f32x4 g = gn[64 * j], a = sc[64 * j], b = sh[64 * j];
            const f32x4 y = (v[j] * rstd) * g * (a + 1.0f) + b; u32x2 w; w.x = cvt_pk_bf16(y.x, y.y); w.y = cvt_pk_bf16(y.z, y.w); o[64 * j] = w; o8[64 * j] = pk4_fp8(8.f * y.x, 8.f * y.y, 8.f * y.z, 8.f * y.w); }
    }
}
#define EPI_LOOP_AM _Pragma("unroll") for (int ai = 0; ai < 2; ++ai) _Pragma("unroll") for (int m = 0; m < 4; ++m)
#define EPI_LOOP_BN _Pragma("unroll") for (int bj = 0; bj < 2; ++bj) _Pragma("unroll") for (int n = 0; n < 2; ++n)
typedef f32x4 acc_t[2][2][4][2];
struct NoPre {};
#define EPI_NOPRE using Pre = NoPre; __device__ __forceinline__ NoPre prefetch(const ge::GUnit&, int, int) const { return NoPre{}; }

struct EpiG1 {
    EPI_NOPRE
    static constexpr bool PERM = true;
    unsigned char* ws; const float* qg; const float* kg; int pnoff;
    __device__ __forceinline__ void operator()(const acc_t& acc, const ge::GUnit& u, int wr, int wc, int fr, int fq, const Pre& pre) const {
        const int pn = u.pn + pnoff, row0 = u.pm * 256 + wr * 64 + fr;
        if (pn >= 8) {
            unsigned char* vt = ws + WS_BIG + BG_V + ((size_t)(u.pm * 4 + wr) * 512 + (pn & 1) * 256 + wc * 32 + 8 * fq) * 64 + 4 * fr;
#pragma unroll
            for (int ai = 0; ai < 2; ++ai)
#pragma unroll
                for (int bj = 0; bj < 2; ++bj)
#pragma unroll
                    for (int n = 0; n < 2; ++n)
#pragma unroll
                        for (int i = 0; i < 4; ++i)
                            *(unsigned*)(vt + ((size_t)ai * 1024 + bj * 128 + n * 4 + i) * 64) =
                                pk4_fp8(acc[ai][bj][0][n][i] * 8.f, acc[ai][bj][1][n][i] * 8.f, acc[ai][bj][2][n][i] * 8.f, acc[ai][bj][3][n][i] * 8.f);
            return;
        }
        if (pn < 4) {
            bf16_t* dst = (bf16_t*)(ws + WS_BIG + (pn < 2 ? BG_GATE : BG_XA)); const int colb = (pn & 1) * 256 + wc * 32 + 8 * fq; const bool isg = pn < 2;
            EPI_LOOP_AM { bf16_t* rp = dst + (size_t)(row0 + ai * 128 + m * 16) * 512 + colb;
#pragma unroll
                for (int bj = 0; bj < 2; ++bj) { f32x4 v = acc[ai][bj][m][0], v2 = acc[ai][bj][m][1];
                    if (isg) { v.x = gelu_tanh(v.x); v.y = gelu_tanh(v.y); v.z = gelu_tanh(v.z); v.w = gelu_tanh(v.w); v2.x = gelu_tanh(v2.x); v2.y = gelu_tanh(v2.y); v2.z = gelu_tanh(v2.z); v2.w = gelu_tanh(v2.w); }
                    u32x4 w; w.x = cvt_pk_bf16(v.x, v.y); w.y = cvt_pk_bf16(v.z, v.w); w.z = cvt_pk_bf16(v2.x, v2.y); w.w = cvt_pk_bf16(v2.z, v2.w); *(u32x4*)(rp + bj * 128) = w; } }
            return;
        }
        const bool isk = pn >= 6; const float* gv = isk ? kg : qg;
        unsigned char* dst = ws + WS_BIG + (isk ? BG_K : BG_Q); const int colb = (2 * (pn & 1) + (wc >> 1)) * 128 + (wc & 1) * 64 + 4 * fq;
        const float qs = isk ? 8.0f : 16.f * 0.18033688011112042f;
        f32x4 g4[2][2];
        EPI_LOOP_BN g4[bj][n] = *(const f32x4*)(gv + 32 * bj + 16 * n + 4 * fq);
        const float* rope = (const float*)(ws + WS_ROPE);
        const bool lat = u.pm >= 4;
        EPI_LOOP_AM {
            const int row = row0 + ai * 128 + m * 16;
            float ss = 0.f;
            EPI_LOOP_BN { const f32x4 v = acc[ai][bj][m][n]; ss += (v.x * v.x + v.y * v.y) + (v.z * v.z + v.w * v.w); }
            ss += __shfl_xor(ss, 16); ss += __shfl_xor(ss, 32);
            const float rstd = rsqrtf(ss * (1.f / 64.f) + EPS) * qs;
            f32x4 y[2][2];
            EPI_LOOP_BN y[bj][n] = acc[ai][bj][m][n] * rstd * g4[bj][n];
            if (lat) {
                const int t = (row - NCTX) & (SEQ - 1); const int pr = t >> 6, pc = t & 63;
                const f32x4 c0 = *(const f32x4*)(rope + pr * 16 + 4 * fq), s0 = *(const f32x4*)(rope + 2048 + pr * 16 + 4 * fq);
                const f32x4 c1 = *(const f32x4*)(rope + 4096 + pc * 16 + 4 * fq), s1 = *(const f32x4*)(rope + 5120 + pc * 16 + 4 * fq);
                const f32x4 a0 = y[0][0] * c0 - y[0][1] * s0, b0 = y[0][1] * c0 + y[0][0] * s0;
                const f32x4 a1 = y[1][0] * c1 - y[1][1] * s1, b1 = y[1][1] * c1 + y[1][0] * s1;
                y[0][0] = a0; y[0][1] = b0; y[1][0] = a1; y[1][1] = b1;
            }
            unsigned char* rp = dst + (size_t)row * 512 + colb;
            EPI_LOOP_BN { const f32x4 v = y[bj][n]; *(unsigned*)(rp + 32 * bj + 16 * n) = pk4_fp8(v.x, v.y, v.z, v.w); }
        }
    }
};

struct EpiG2 {
    EPI_NOPRE
    static constexpr bool PERM = false;
    Frame F;
    __device__ __forceinline__ void operator()(const acc_t& acc, const ge::GUnit& u, int wr, int wc, int fr, int fq, const Pre& pre) const {
        const int row0 = u.pm * 256 + wr * 64 + fr, col0 = u.pn * 256 + wc * 32 + 4 * fq; const int mi = u.pm < 4 ? 4 : ((u.pm - 4) >> 5);
        const float* g1 = modv(F, 0, mi, 2) + col0;
        float* ssq = (float*)(F.ws + WS_BIG + BG_SSQ);
        f32x4 gg[2][2];
        EPI_LOOP_BN gg[bj][n] = *(const f32x4*)(g1 + bj * 128 + n * 16);
        EPI_LOOP_AM { const int row = row0 + ai * 128 + m * 16; const float* xi = inrow_ptr(F, row) + col0; bf16_t* xo = xb0_ptr(F, row) + col0; float ss = 0.f;
            EPI_LOOP_BN { const f32x4 xv = *(const f32x4*)(xi + bj * 128 + n * 16); const f32x4 o = xv + gg[bj][n] * acc[ai][bj][m][n]; *(u32x2*)(xo + bj * 128 + n * 16) = f32_to_bf4(o);
                ss += (o.x * o.x + o.y * o.y) + (o.z * o.z + o.w * o.w); }
            ss += __shfl_xor(ss, 16); ss += __shfl_xor(ss, 32);
            if (fq == 0) ssq[(size_t)row * 32 + u.pn * 4 + wc] = ss; }
    }
};

struct EpiUp {
    EPI_NOPRE
    static constexpr bool PERM = true;
    unsigned char* hid;
    __device__ __forceinline__ void operator()(const acc_t& acc, const ge::GUnit& u, int wr, int wc, int fr, int fq, const Pre& pre) const {
        const int row0 = wr * 64 + fr, col0 = u.pn * 128 + wc * 32 + 8 * fq;
        unsigned char* base = hid + (size_t)u.pm * 65536;
        EPI_LOOP_AM { unsigned char* rp = base + (size_t)(row0 + ai * 128 + m * 16) * 256 + col0;
            const f32x4 g = acc[ai][0][m][0], up = acc[ai][1][m][0], g2 = acc[ai][0][m][1], up2 = acc[ai][1][m][1];
            u32x2 w; w.x = pk4_fp8(16.f * siluf_(g.x) * up.x, 16.f * siluf_(g.y) * up.y, 16.f * siluf_(g.z) * up.z, 16.f * siluf_(g.w) * up.w);
            w.y = pk4_fp8(16.f * siluf_(g2.x) * up2.x, 16.f * siluf_(g2.y) * up2.y, 16.f * siluf_(g2.z) * up2.z, 16.f * siluf_(g2.w) * up2.w); *(u32x2*)rp = w; }
    }
};
struct EpiDown {
    static constexpr bool PERM = true;
    struct Pre { i32x2 e[2][4]; };
    unsigned char* Y; int half_base;
    __device__ __forceinline__ Pre prefetch(const ge::GUnit& u, int wr, int fr) const {
        Pre p; const int row0 = wr * 64 + fr;
        EPI_LOOP_AM { const int rt = row0 + ai * 128 + m * 16;
            if (u.rows) p.e[ai][m] = u.rows[rt < u.nvalid ? rt : u.nvalid - 1]; else p.e[ai][m] = (i32x2){((u.aux + rt) << 3) | 6, 0x3f800000}; }
        return p; }
    __device__ __forceinline__ void operator()(const acc_t& acc, const ge::GUnit& u, int wr, int wc, int fr, int fq, const Pre& pre) const {
        const int row0 = wr * 64 + fr, col0 = u.pn * 256 + wc * 32 + 8 * fq;
        EPI_LOOP_AM { const int rt = row0 + ai * 128 + m * 16;
            if (rt < u.nvalid) { const int pk = pre.e[ai][m].x, mrow = pk >> 3, slot = pk & 7; const float gt = 32.f * __int_as_float(pre.e[ai][m].y);
                unsigned char* rp = Y + ((size_t)(mrow - half_base) * 7 + slot) * 1024 + col0;
#pragma unroll
                for (int bj = 0; bj < 2; ++bj) { const f32x4 v = acc[ai][bj][m][0] * gt, v2 = acc[ai][bj][m][1] * gt;
                    u32x2 w; w.x = pk4_fp8(v.x, v.y, v.z, v.w); w.y = pk4_fp8(v2.x, v2.y, v2.z, v2.w); *(u32x2*)(rp + bj * 128) = w; } } }
    }
};

struct EpiS5a {
    EPI_NOPRE
    static constexpr bool PERM = false;
    unsigned char* ws;
    __device__ __forceinline__ void operator()(const acc_t& acc, const ge::GUnit& u, int wr, int wc, int fr, int fq, const Pre& pre) const {
        const int g = u.aux, row0 = wr * 64 + fr, col0 = wc * 32 + 4 * fq; const bool isc = u.pm == 4;
        float* base = isc ? (float*)(ws + WS_BIG + BG_SLOCC) + (size_t)g * 32 * 256 : (float*)(ws + WS_BIG + BG_SLOCL) + ((size_t)g * 1024 + u.pm * 256) * 256;
        EPI_LOOP_AM { const int rt = row0 + ai * 128 + m * 16;
            if (!isc || rt < 32) { float* rp = base + (size_t)rt * 256 + col0;
                EPI_LOOP_BN *(f32x4*)(rp + bj * 128 + n * 16) = acc[ai][bj][m][n]; } }
    }
};
struct EpiS5b {
    EPI_NOPRE
    static constexpr bool PERM = true;
    unsigned char* ws;
    __device__ __forceinline__ void operator()(const acc_t& acc, const ge::GUnit& u, int wr, int wc, int fr, int fq, const Pre& pre) const {
        const int g = u.aux, row0 = u.pm * 256 + wr * 64 + fr, col0 = u.pn * 256 + wc * 32 + 8 * fq;
        unsigned char* base = ws + WS_BIG + BG_ZS5 + (size_t)g * 1024 * 512;
        EPI_LOOP_AM { unsigned char* rp = base + (size_t)(row0 + ai * 128 + m * 16) * 512 + col0;
#pragma unroll
            for (int bj = 0; bj < 2; ++bj) { const f32x4 v = acc[ai][bj][m][0], v2 = acc[ai][bj][m][1];
                u32x2 w; w.x = pk4_fp8(4.f * gelu_tanh(v.x), 4.f * gelu_tanh(v.y), 4.f * gelu_tanh(v.z), 4.f * gelu_tanh(v.w));
                w.y = pk4_fp8(4.f * gelu_tanh(v2.x), 4.f * gelu_tanh(v2.y), 4.f * gelu_tanh(v2.z), 4.f * gelu_tanh(v2.w)); *(u32x2*)(rp + bj * 128) = w; } }
    }
};
struct EpiGlu {
    EPI_NOPRE
    static constexpr bool PERM = false;
    Frame F;
    __device__ __forceinline__ void operator()(const acc_t& acc, const ge::GUnit& u, int wr, int wc, int fr, int fq, const Pre& pre) const {
        const int row0 = u.pm * 256 + wr * 64 + fr, col0 = u.pn * 128 + wc * 32 + 4 * fq; const int mi = u.pm >> 5;
        const float* g1 = modv(F, 1, mi, 2) + col0; const float* gb = F.in[I_GLUB] + col0;
        float* ssq = (float*)(F.ws + WS_BIG + BG_SSQ);
        f32x4 gg[2], bv[2], bg[2];
#pragma unroll
        for (int n = 0; n < 2; ++n) { gg[n] = *(const f32x4*)(g1 + n * 16); bv[n] = *(const f32x4*)(gb + n * 16); bg[n] = *(const f32x4*)(gb + 1024 + n * 16); }
        EPI_LOOP_AM { const int row = row0 + ai * 128 + m * 16; const bf16_t* xi = xb0_ptr(F, NCTX + row) + col0; bf16_t* xo = xb1_ptr(F, row) + col0; float ss = 0.f;
#pragma unroll
            for (int n = 0; n < 2; ++n) { const f32x4 val = acc[ai][0][m][n] + bv[n], gt = acc[ai][1][m][n] + bg[n];
                f32x4 o; o.x = val.x * sigmoidf_(gt.x); o.y = val.y * sigmoidf_(gt.y); o.z = val.z * sigmoidf_(gt.z); o.w = val.w * sigmoidf_(gt.w);
                const f32x4 xn = bf4_to_f32(*(const u32x2*)(xi + n * 16)) + gg[n] * o; *(u32x2*)(xo + n * 16) = f32_to_bf4(xn); ss += (xn.x * xn.x + xn.y * xn.y) + (xn.z * xn.z + xn.w * xn.w); }
            ss += __shfl_xor(ss, 16); ss += __shfl_xor(ss, 32);
            if (fq == 0) ssq[(size_t)row * 32 + u.pn * 4 + wc] = ss; }
    }
};
constexpr int XCS = 520;
__device__ __forceinline__ void lru_consts(Frame& F) {
    LAS float* cst = (LAS float*)(F.lds + MISC_OFF + F.wave * 1536); const float* sp = (const float*)(F.ws + WS_LRUSP);
#pragma unroll
    for (int d = 0; d < 2; ++d) { const int ch = d * 512 + 64 * F.wave + F.lane; cst[(0 * 2 + d) * 64 + F.lane] = F.in[I_LRB][ch]; cst[(1 * 2 + d) * 64 + F.lane] = F.in[I_LIB][ch]; cst[(2 * 2 + d) * 64 + F.lane] = sp[ch]; }
    __syncthreads();
}
template <int CTRL, int RMASK> __device__ __forceinline__ float dpp_f(float old, float src) {
    return __int_as_float(__builtin_amdgcn_update_dpp(__float_as_int(old), __float_as_int(src), CTRL, RMASK, 0xf, false));
}
#define LRU_SCAN_STEP(CTRL, RM) do { _Pragma("unroll") for (int r = 0; r < 16; ++r) { const float a2 = dpp_f<CTRL, RM>(1.0f, av[r]), b2 = dpp_f<CTRL, RM>(0.0f, bv[r]); bv[r] = av[r] * b2 + bv[r]; av[r] = av[r] * a2; } } while (0)
template <bool FINAL>
__device__ __forceinline__ void lru_unit(Frame& F, int b, int cc) {
    const bool isctx = cc < 8;
    const int seg0 = isctx ? b * 256 : NCTX + b * 8192, segn = isctx ? 256 : 8192, t0 = isctx ? cc * 32 : (cc - 8) * 32;
    LAS bf16_t* xcl = (LAS bf16_t*)F.lds;
    {
        int tq = F.tid; asm volatile("" : "+v"(tq));
        const int tg = tq >> 6, c8 = (tq & 63) * 8; const float* cw = F.in[I_CONVW] + c8;
        const bf16_t* xa = (const bf16_t*)(F.ws + WS_BIG + BG_XA) + (size_t)seg0 * 512 + c8;
        u32x4 xin[7];
#pragma unroll
        for (int k = 0; k < 7; ++k) { const int tp = t0 + 4 * tg - 2 + k; xin[k] = (tp >= 0 && tp < segn) ? *(const u32x4*)(xa + (size_t)tp * 512) : (u32x4){0u, 0u, 0u, 0u}; }
        f32x4 w[4][2]; f32x4 cb[2];
#pragma unroll
        for (int k = 0; k < 4; ++k) { w[k][0] = *(const f32x4*)(cw + k * 512); w[k][1] = *(const f32x4*)(cw + k * 512 + 4); }
        cb[0] = *(const f32x4*)(F.in[I_CONVB] + c8); cb[1] = *(const f32x4*)(F.in[I_CONVB] + c8 + 4);
#pragma unroll
        for (int i = 0; i < 4; ++i) {
            f32x4 o0 = cb[0], o1 = cb[1];
#pragma unroll
            for (int k = 0; k < 4; ++k) { const u32x4 x = xin[i + k];
                o0 += w[k][0] * (f32x4){bflo(x.x), bfhi(x.x), bflo(x.y), bfhi(x.y)}; o1 += w[k][1] * (f32x4){bflo(x.z), bfhi(x.z), bflo(x.w), bfhi(x.w)}; }
            u32x4 ov; ov.x = cvt_pk_bf16(o0.x, o0.y); ov.y = cvt_pk_bf16(o0.z, o0.w); ov.z = cvt_pk_bf16(o1.x, o1.y); ov.w = cvt_pk_bf16(o1.z, o1.w);
            *(LAS u32x4*)(xcl + (4 * tg + i) * XCS + c8) = ov;
        }
    }
    __syncthreads();
    const int n = F.wave, r32 = F.lane & 31, hi = F.lane >> 5;
    const bf16_t* lw = (const bf16_t*)(F.ws + WS_LRUW);
    const LAS float* cst = (const LAS float*)(F.lds + MISC_OFF + n * 1536);
    const int row = seg0 + t0 + r32;
    const float* hin = (const float*)(F.ws + WS_BIG + BG_LHIN) + (size_t)(b * LRU_NCH + cc) * 2 * 512;
    f32x2* sm = (f32x2*)(F.ws + WS_BIG + BG_LSUM) + (size_t)(b * LRU_NCH + cc) * 2 * 512;
#pragma unroll
    for (int eb = 0; eb < 2; ++eb) {
        f32x16 ysum = {};
#pragma unroll
        for (int dd = 0; dd < 2; ++dd) {
            const int d = 1 - dd;
            const int tl = d ? 31 - r32 : r32;
            f32x16 av = {}, bv = {};
#pragma unroll
            for (int ks = 0; ks < 4; ++ks) {
                const bf16x8 xb = *(const LAS bf16x8*)(xcl + tl * XCS + 64 * n + 16 * ks + 8 * hi);
                const bf16x8 wr_ = *(const bf16x8*)(lw + ((size_t)((0 * 2 + d) * 8 + n) * 64 + 32 * eb + r32) * 64 + 16 * ks + 8 * hi);
                const bf16x8 wi_ = *(const bf16x8*)(lw + ((size_t)((1 * 2 + d) * 8 + n) * 64 + 32 * eb + r32) * 64 + 16 * ks + 8 * hi);
                av = __builtin_amdgcn_mfma_f32_32x32x16_bf16(wr_, xb, av, 0, 0, 0);
                bv = __builtin_amdgcn_mfma_f32_32x32x16_bf16(wi_, xb, bv, 0, 0, 0);
            }
#pragma unroll
            for (int r = 0; r < 16; ++r) {
                const int cl = 32 * eb + crow(r, hi);
                const float rg = sigmoidf_(av[r] + cst[(0 * 2 + d) * 64 + cl]), ig = sigmoidf_(bv[r] + cst[(1 * 2 + d) * 64 + cl]);
                const float la = -rg * cst[(2 * 2 + d) * 64 + cl]; const float a = __expf(la);
                const float x = bf2f(xcl[tl * XCS + 64 * n + cl]);
                av[r] = a; bv[r] = __builtin_amdgcn_sqrtf(fmaxf(fmaf(-a, a, 1.0f), 0.f)) * ig * x;
            }
            LRU_SCAN_STEP(0x111, 0xf); LRU_SCAN_STEP(0x112, 0xf); LRU_SCAN_STEP(0x114, 0xf); LRU_SCAN_STEP(0x118, 0xf); LRU_SCAN_STEP(0x142, 0xa);
            if constexpr (!FINAL) {
                if (r32 == 31) {
#pragma unroll
                    for (int r = 0; r < 16; ++r) sm[d * 512 + 64 * n + 32 * eb + crow(r, hi)] = (f32x2){av[r], bv[r]};
                }
            } else {
#pragma unroll
                for (int q = 0; q < 4; ++q) { const f32x4 hv = *(const f32x4*)(hin + d * 512 + 64 * n + 32 * eb + 8 * q + 4 * hi);
#pragma unroll
                    for (int i = 0; i < 4; ++i) { const float h = bv[4 * q + i] + av[4 * q + i] * hv[i];
                        if (d) ysum[4 * q + i] = __int_as_float(__builtin_amdgcn_ds_swizzle(__float_as_int(h), 0x7C1F));
                        else ysum[4 * q + i] += h; } }
            }
        }
        if constexpr (FINAL) {
            const bf16_t* gp = (const bf16_t*)(F.ws + WS_BIG + BG_GATE) + (size_t)row * 512; bf16_t* yo = (bf16_t*)(F.ws + WS_ACT) + (size_t)row * DM;
#pragma unroll
            for (int q = 0; q < 4; ++q) { const int ch0 = 64 * n + 32 * eb + 8 * q + 4 * hi; const u32x2 gw = *(const u32x2*)(gp + ch0);
                u32x2 w; w.x = cvt_pk_bf16(ysum[4 * q] * bflo(gw.x), ysum[4 * q + 1] * bfhi(gw.x)); w.y = cvt_pk_bf16(ysum[4 * q + 2] * bflo(gw.y), ysum[4 * q + 3] * bfhi(gw.y)); *(u32x2*)(yo + ch0) = w; }
        }
    }
    __syncthreads();
}
#undef LRU_SCAN_STEP
__device__ __forceinline__ void lru_carry(Frame& F) {
    for (int i = F.bid; i < 8; i += F.G) {
        const int b = i >> 1, d = i & 1, ch = F.tid;
        const f32x2* __restrict__ sm = (const f32x2*)(F.ws + WS_BIG + BG_LSUM) + (size_t)b * LRU_NCH * 1024 + d * 512 + ch;
        float* __restrict__ hin = (float*)(F.ws + WS_BIG + BG_LHIN) + (size_t)b * LRU_NCH * 1024 + d * 512 + ch;
        float h = 0.f;
#pragma unroll 1
        for (int k0 = 0; k0 < LRU_NCH; k0 += 24) {
            f32x2 st[24]; int cidx[24];
#pragma unroll
            for (int j = 0; j < 24; ++j) { const int k = k0 + j; const int cc = d == 0 ? k : (k < 8 ? 7 - k : LRU_NCH + 7 - k); cidx[j] = cc; st[j] = sm[(size_t)cc * 1024]; }
#pragma unroll
            for (int j = 0; j < 24; ++j) { hin[(size_t)cidx[j] * 1024] = h; h = st[j].x * h + st[j].y; }
        }
    }
}
namespace at {

#define AT_SBAR() __builtin_amdgcn_sched_barrier(0)
typedef __fp16 h16x2 __attribute__((ext_vector_type(2)));
__device__ __forceinline__ int pk4raw(float a, float b, float c, float d) {
    const h16x2 lo = __builtin_amdgcn_cvt_pkrtz(a, b), hi = __builtin_amdgcn_cvt_pkrtz(c, d);
    return (int)__builtin_amdgcn_perm(*reinterpret_cast<const unsigned*>(&hi), *reinterpret_cast<const unsigned*>(&lo), 0x07050301u);
}
__device__ __forceinline__ void exp_lo(f32x16& p0) {
#pragma unroll
    for (int r = 0; r < 16; ++r) p0[r] = __builtin_amdgcn_exp2f(p0[r]);
}
template <int ABL> __device__ __forceinline__ void finishSM(f32x16& p0, f32x16& p1, i32x8& pw) {
#pragma unroll
    for (int r = 0; r < 16; ++r) p1[r] = __builtin_amdgcn_exp2f(p1[r]);
#pragma unroll
    for (int a = 0; a < 4; ++a) { if (ABL == 4) { pw[a] = __float_as_int(p0[4 * a]) | __float_as_int(p0[4 * a + 2]); pw[4 + a] = __float_as_int(p1[4 * a + 1]) | __float_as_int(p1[4 * a + 3]); continue; }
        pw[a] = pk4raw(p0[4 * a], p0[4 * a + 1], p0[4 * a + 2], p0[4 * a + 3]); pw[4 + a] = pk4raw(p1[4 * a], p1[4 * a + 1], p1[4 * a + 2], p1[4 * a + 3]); }
}
__device__ __forceinline__ void qkt(f32x16& p0, f32x16& p1, const LAS char* Ks, const i32x8& qf, int o0, int o1) {
    const i32x4 a0 = *(const LAS i32x4*)(Ks + o0), a1 = *(const LAS i32x4*)(Ks + o1), b0 = *(const LAS i32x4*)(Ks + 2048 + o0), b1 = *(const LAS i32x4*)(Ks + 2048 + o1);
    const i32x8 k0 = {a0[0], a0[1], a0[2], a0[3], a1[0], a1[1], a1[2], a1[3]}, k1 = {b0[0], b0[1], b0[2], b0[3], b1[0], b1[1], b1[2], b1[3]};
    const f32x16 c = {};
    p0 = __builtin_amdgcn_mfma_scale_f32_32x32x64_f8f6f4(k0, qf, c, 0, 0, 0, 0x78787878, 0, 0x7f7f7f7f);
    p1 = __builtin_amdgcn_mfma_scale_f32_32x32x64_f8f6f4(k1, qf, c, 0, 0, 0, 0x78787878, 0, 0x7f7f7f7f);
}
__device__ __forceinline__ void pv_d0(f32x16* o, f32x16& la, const LAS char* Vs, const i32x8& pw, const i32x8& ones, int o0, int o1) {
#pragma unroll
    for (int d0 = 0; d0 < 4; ++d0) {
        const i32x4 a0 = *(const LAS i32x4*)(Vs + d0 * 2048 + o0), a1 = *(const LAS i32x4*)(Vs + d0 * 2048 + o1);
        const i32x8 vf = {a0[0], a0[1], a0[2], a0[3], a1[0], a1[1], a1[2], a1[3]};
        o[d0] = __builtin_amdgcn_mfma_scale_f32_32x32x64_f8f6f4(pw, vf, o[d0], 1, 0, 0, 0, 0, 0);
    }
    la = __builtin_amdgcn_mfma_scale_f32_32x32x64_f8f6f4(pw, ones, la, 1, 0, 0, 0, 0, 0);
}
__device__ __forceinline__ int krow(int b, int j) { return j < 4 ? b * 256 + 64 * j : NCTX + b * 8192 + 64 * (j - 4); }

constexpr int TILE_B = 12288, KOFF_B = 8192, NRING = 5, LI_OFF = NRING * TILE_B;
template <int ABL> __device__ __forceinline__ void attn_unit(Frame& F, int b, int h, int qrow0, int NT, float lam) {
    const int tid = F.tid, wid = F.wave, lane = F.lane, r32 = lane & 31, hi = lane >> 5;
    LAS char* lds = (LAS char*)F.lds;
    const char* Q = (const char*)(F.ws + WS_BIG + BG_Q); const char* K = (const char*)(F.ws + WS_BIG + BG_K); const char* V = (const char*)(F.ws + WS_BIG + BG_V);
    const int irow = wid * 16 + (lane >> 2), lch = ((lane & 3) ^ ((irow >> 2) & 3)) << 4;
    const unsigned voff = (unsigned)h * 8192u + (unsigned)irow * 64u + (unsigned)lch;
    unsigned koff;
    { const int rho = irow & 31, t = (irow >> 5) & 1, key = 16 * (rho & 3) + 8 * ((rho >> 2) & 1) + (rho >> 3) + 4 * t; koff = (unsigned)key * 512u + (unsigned)h * 128u + (unsigned)lch; }
    const int xo = (r32 >> 2) & 3, o0 = r32 * 64 + (((2 * hi) ^ xo) << 4), o1 = r32 * 64 + (((2 * hi + 1) ^ xo) << 4);
#define AT_WAITBAR(N) asm volatile("s_waitcnt vmcnt(" #N ")\n\ts_barrier" ::: "memory")
#define AT_ISSUE(j, LEAD) do { const int _k0 = krow(b, (j)); LAS char* _bf = lds + ((j) % NRING) * TILE_B; \
        __builtin_amdgcn_global_load_lds((const unsigned*)(V + (size_t)(_k0 >> 6) * 32768 + voff), (LAS unsigned*)(_bf + wid * 1024), 16, 0, 0); \
        if (LEAD) __builtin_amdgcn_global_load_lds((const unsigned*)(K + (size_t)_k0 * 512 + m * 64 + koff), (LAS unsigned*)(_bf + KOFF_B + wid * 1024), 16, 0, 0); } while (0)
#define AT_KB(j) (lds + ((j) % NRING) * TILE_B + KOFF_B)
#define AT_VB(j) (lds + ((j) % NRING) * TILE_B)
    i32x8 ones;
#pragma unroll
    for (int i = 0; i < 8; ++i) ones[i] = 0x38383838;
#pragma unroll 1
    for (int m = 0; m < 2; ++m) {
        f32x16 la = {}; f32x16 o[4] = {}; i32x8 qf;
        { const char* Qw = Q + (size_t)(qrow0 + wid * 32 + r32) * 512 + h * 128 + m * 64 + hi * 32;
          const i32x4 q0 = *(const i32x4*)Qw, q1 = *(const i32x4*)(Qw + 16); qf = (i32x8){q0[0], q0[1], q0[2], q0[3], q1[0], q1[1], q1[2], q1[3]}; }
        asm volatile("s_waitcnt vmcnt(0)" ::: "memory");
        f32x16 pA0, pA1, pB0, pB1; i32x8 pw;
        __syncthreads();
        if (wid < 4) {
            AT_ISSUE(0, true); AT_ISSUE(1, true);
            AT_WAITBAR(2); AT_ISSUE(2, true);
            qkt(pA0, pA1, AT_KB(0), qf, o0, o1); exp_lo(pA0);
            for (int j = 1; j + 1 < NT; j += 2) {
                AT_WAITBAR(2); AT_ISSUE(j + 2, true);
                AT_SBAR(); qkt(pB0, pB1, AT_KB(j), qf, o0, o1);
                finishSM<ABL>(pA0, pA1, pw); AT_SBAR();
                pv_d0(o, la, AT_VB(j - 1), pw, ones, o0, o1); exp_lo(pB0);
                AT_WAITBAR(2); if (j + 3 < NT) AT_ISSUE(j + 3, true);
                AT_SBAR(); qkt(pA0, pA1, AT_KB(j + 1), qf, o0, o1);
                finishSM<ABL>(pB0, pB1, pw); AT_SBAR();
                pv_d0(o, la, AT_VB(j), pw, ones, o0, o1); exp_lo(pA0);
            }
            AT_WAITBAR(0);
            AT_SBAR(); qkt(pB0, pB1, AT_KB(NT - 1), qf, o0, o1);
            finishSM<ABL>(pA0, pA1, pw); AT_SBAR();
            pv_d0(o, la, AT_VB(NT - 2), pw, ones, o0, o1); exp_lo(pB0);
            finishSM<ABL>(pB0, pB1, pw); AT_SBAR();
            pv_d0(o, la, AT_VB(NT - 1), pw, ones, o0, o1);
        } else {
            AT_ISSUE(0, false); AT_ISSUE(1, false);
            AT_WAITBAR(1); AT_ISSUE(2, false);
            qkt(pA0, pA1, AT_KB(0), qf, o0, o1);
            for (int j = 1; j + 1 < NT; j += 2) {
                AT_WAITBAR(1); AT_ISSUE(j + 2, false);
                AT_SBAR(); if (j >= 2) pv_d0(o, la, AT_VB(j - 2), pw, ones, o0, o1);
                exp_lo(pA0); AT_SBAR();
                qkt(pB0, pB1, AT_KB(j), qf, o0, o1);
                finishSM<ABL>(pA0, pA1, pw);
                AT_WAITBAR(1); if (j + 3 < NT) AT_ISSUE(j + 3, false);
                AT_SBAR(); pv_d0(o, la, AT_VB(j - 1), pw, ones, o0, o1);
                exp_lo(pB0); AT_SBAR();
                qkt(pA0, pA1, AT_KB(j + 1), qf, o0, o1);
                finishSM<ABL>(pB0, pB1, pw);
            }
            AT_WAITBAR(0);
            AT_SBAR(); pv_d0(o, la, AT_VB(NT - 3), pw, ones, o0, o1);
            exp_lo(pA0); AT_SBAR();
            qkt(pB0, pB1, AT_KB(NT - 1), qf, o0, o1);
            finishSM<ABL>(pA0, pA1, pw); AT_SBAR();
            pv_d0(o, la, AT_VB(NT - 2), pw, ones, o0, o1); exp_lo(pB0);
            finishSM<ABL>(pB0, pB1, pw); AT_SBAR();
            pv_d0(o, la, AT_VB(NT - 1), pw, ones, o0, o1);
        }
        int tid2 = tid; asm volatile("" : "+v"(tid2));
        f32x4* stash = (f32x4*)(F.ws + WS_SCR) + ((size_t)F.bid * NTHREADS + tid2) * 16;
        if (m == 0) {
#pragma unroll
            for (int q = 0; q < 4; ++q) {
                const float r0 = 0.125f * __builtin_amdgcn_rcpf(la[4 * q]), r1 = 0.125f * __builtin_amdgcn_rcpf(la[4 * q + 1]), r2 = 0.125f * __builtin_amdgcn_rcpf(la[4 * q + 2]), r3 = 0.125f * __builtin_amdgcn_rcpf(la[4 * q + 3]);
#pragma unroll
                for (int d0 = 0; d0 < 4; ++d0) stash[d0 * 4 + q] = (f32x4){o[d0][4 * q] * r0, o[d0][4 * q + 1] * r1, o[d0][4 * q + 2] * r2, o[d0][4 * q + 3] * r3};
                asm volatile("" ::: "memory");
            }
        } else {
            const float* sg = F.in[I_SUBG];
            float g4[4];
#pragma unroll
            for (int d0 = 0; d0 < 4; ++d0) g4[d0] = sg[d0 * 32 + r32] * 0.8f;
            const int l2 = tid2 & 63;
            bf16_t* rp = (bf16_t*)(F.ws + WS_ACT) + (size_t)(qrow0 + wid * 32 + 4 * (l2 >> 5)) * DM + 512 + h * 128 + (l2 & 31);
#pragma unroll
            for (int q = 0; q < 4; ++q) {
                f32x4 st[4];
#pragma unroll
                for (int d0 = 0; d0 < 4; ++d0) st[d0] = stash[d0 * 4 + q];
#pragma unroll
                for (int i = 0; i < 4; ++i) { const int r = 4 * q + i; const float rl = 0.125f * __builtin_amdgcn_rcpf(la[r]);
                    float v[4], ss = 0.f;
#pragma unroll
                    for (int d0 = 0; d0 < 4; ++d0) { v[d0] = st[d0][i] - lam * (o[d0][r] * rl); ss += v[d0] * v[d0]; }
                    ss += __shfl_xor(ss, 1); ss += __shfl_xor(ss, 2); ss += __shfl_xor(ss, 4); ss += __shfl_xor(ss, 8); ss += __shfl_xor(ss, 16);
                    const float rstd = rsqrtf(ss * (1.f / 128.f) + EPS);
#pragma unroll
                    for (int d0 = 0; d0 < 4; ++d0) rp[(size_t)i * DM + d0 * 32] = f2bf(v[d0] * rstd * g4[d0]); }
                rp += 8 * DM;
                asm volatile("" : "+v"(rp) :: "memory");
            }
        }
    }
#undef AT_WAITBAR
#undef AT_LWAIT
#undef AT_ISSUE
#undef AT_KB
#undef AT_VB
#undef AT_SBAR
}
}
struct MoeGeo { int layer, NR, HR, UR; };
__device__ __forceinline__ MoeGeo moe_geo(int layer) { MoeGeo g; g.layer = layer; g.NR = layer ? NLAT : NROW; g.HR = g.NR; g.UR = g.NR / 256; return g; }
__device__ __forceinline__ bf16_t* moe_xrow(const Frame& F, int layer, int mrow) { return layer ? xb1_ptr(F, mrow) : xb0_ptr(F, mrow); }
__device__ __forceinline__ int moe_mi(int layer, int mrow) { return layer ? (mrow >> 13) : row_mi(mrow); }

__device__ __forceinline__ void router_phase(Frame& F, int layer) {
    const MoeGeo G = moe_geo(layer);
    LAS float* rs = (LAS float*)F.lds;
    LAS float* lgt = (LAS float*)(F.lds + 1024) + F.wave * 1024;
    LAS int* selE = (LAS int*)(F.lds + 65536);
    LAS float* selG = (LAS float*)(F.lds + 65536 + 4096);
    LAS int* selP = (LAS int*)(F.lds + 65536 + 8192);
    LAS int* hist = (LAS int*)(F.lds + 65536 + 12288);
    LAS int* basev = hist + 64;
    unsigned char* H2 = F.ws + WS_ACT;
    const bf16_t* wh = (const bf16_t*)(F.ws + WS_WRT) + (size_t)(layer * 2) * 65536; const bf16_t* wl = wh + 65536;
    const float* rb = F.in[I_RB] + layer * 64;
    const float* gn = F.in[I_N2G] + layer * DM;
    int* cnt = (int*)(F.ws + WS_CTL) + layer * 128;
    i32x2* list = (i32x2*)(F.ws + WS_LIST);
    const int w = F.wave, e = F.lane, fr = F.lane & 15, kq = F.lane >> 4;
    for (int unit = F.bid; unit < 256; unit += F.G) {
        const int half = 0, mrow0 = unit * G.UR;
        if (F.tid < 64) hist[F.tid] = 0;
        { const float* ssq = (const float*)(F.ws + WS_BIG + BG_SSQ); const int np = layer ? 32 : 16;
          for (int lr = w; lr < G.UR; lr += NWAVES) { const int mrow = mrow0 + lr; float s = F.lane < np ? ssq[(size_t)mrow * 32 + F.lane] : 0.f;
              s = wave_sum(s); if (F.lane == 0) rs[lr] = rsqrtf(s * (1.f / DM) + EPS); } }
        __syncthreads();
        for (int g0 = 16 * w; g0 < G.UR; g0 += 16 * NWAVES) {
            const int nrow = (G.UR - g0) < 16 ? (G.UR - g0) : 16; const bool rok = fr < nrow;
            const int lrow = g0 + (rok ? fr : nrow - 1), mrow = mrow0 + lrow, mi = moe_mi(layer, mrow);
            const bf16_t* xp = moe_xrow(F, layer, mrow) + 8 * kq; const float rstd = rs[lrow];
            const float* shp = modv(F, layer, mi, 3) + 8 * kq; const float* scp = modv(F, layer, mi, 4) + 8 * kq; const float* gp = gn + 8 * kq;
            unsigned char* hp = H2 + (size_t)mrow * DM + 8 * kq;
            const bf16_t* whp = wh + (size_t)fr * 1024 + 8 * kq; const bf16_t* wlp = wl + (size_t)fr * 1024 + 8 * kq;
            f32x4 acc[4];
#pragma unroll
            for (int i = 0; i < 4; ++i) acc[i] = (f32x4){0.f, 0.f, 0.f, 0.f};
#pragma unroll 2
            for (int ks = 0; ks < 32; ++ks) {
                const int k0 = 32 * ks;
                const u32x4 xw = *(const u32x4*)(xp + k0); const f32x4 x0 = bf4_to_f32((u32x2){xw.x, xw.y}), x1 = bf4_to_f32((u32x2){xw.z, xw.w});
                const f32x4 g0v = *(const f32x4*)(gp + k0), g1v = *(const f32x4*)(gp + k0 + 4), c0 = *(const f32x4*)(scp + k0), c1 = *(const f32x4*)(scp + k0 + 4), s0 = *(const f32x4*)(shp + k0), s1 = *(const f32x4*)(shp + k0 + 4);
                const f32x4 y0 = (x0 * rstd) * g0v * (c0 + 1.0f) + s0, y1 = (x1 * rstd) * g1v * (c1 + 1.0f) + s1;
                u32x4 hv; hv.x = cvt_pk_bf16(y0.x, y0.y); hv.y = cvt_pk_bf16(y0.z, y0.w); hv.z = cvt_pk_bf16(y1.x, y1.y); hv.w = cvt_pk_bf16(y1.z, y1.w);
                if (rok) { u32x2 h8; h8.x = pk4_fp8(y0.x, y0.y, y0.z, y0.w); h8.y = pk4_fp8(y1.x, y1.y, y1.z, y1.w); *(u32x2*)(hp + k0) = h8; }
                u32x4 lv; lv.x = cvt_pk_bf16(y0.x - bflo(hv.x), y0.y - bfhi(hv.x)); lv.y = cvt_pk_bf16(y0.z - bflo(hv.y), y0.w - bfhi(hv.y));
                lv.z = cvt_pk_bf16(y1.x - bflo(hv.z), y1.y - bfhi(hv.z)); lv.w = cvt_pk_bf16(y1.z - bflo(hv.w), y1.w - bfhi(hv.w));
                const bf16x8 ah = *reinterpret_cast<const bf16x8*>(&hv), al = *reinterpret_cast<const bf16x8*>(&lv);
#pragma unroll
                for (int blk = 0; blk < 4; ++blk) {
                    const bf16x8 bh = *(const bf16x8*)(whp + (size_t)blk * 16 * 1024 + k0), bl = *(const bf16x8*)(wlp + (size_t)blk * 16 * 1024 + k0);
                    acc[blk] = __builtin_amdgcn_mfma_f32_16x16x32_bf16(ah, bh, acc[blk], 0, 0, 0);
                    acc[blk] = __builtin_amdgcn_mfma_f32_16x16x32_bf16(al, bh, acc[blk], 0, 0, 0);
                    acc[blk] = __builtin_amdgcn_mfma_f32_16x16x32_bf16(ah, bl, acc[blk], 0, 0, 0);
                }
            }
#pragma unroll
            for (int blk = 0; blk < 4; ++blk)
#pragma unroll
                for (int r = 0; r < 4; ++r) lgt[(4 * kq + r) * 64 + 16 * blk + fr] = acc[blk][r];
            asm volatile("s_waitcnt lgkmcnt(0)" ::: "memory");
            const float bias = rb[e];
            for (int rr = 0; rr < nrow; ++rr) {
                const float lg = lgt[rr * 64 + e];
                const float aff = 1.0f / (1.0f + expf(-lg)); const float scv = aff + bias;
                int rank = 0;
#pragma unroll 8
                for (int j = 0; j < 64; ++j) { const float sj = __shfl(scv, j); rank += (sj > scv || (sj == scv && j < e)) ? 1 : 0; }
                const bool sel = rank < 6; const float ssum = wave_sum(sel ? aff : 0.f);
                if (sel) { const int idx = (g0 + rr) * 6 + rank; selE[idx] = e; selG[idx] = aff / ssum * 2.5f; selP[idx] = atomicAdd((int*)&hist[e], 1); }
            }
            asm volatile("s_waitcnt lgkmcnt(0)" ::: "memory");
        }
        __syncthreads();
        if (F.tid < 64) basev[F.tid] = atomicAdd(&cnt[half * 64 + F.tid], hist[F.tid]);
        __syncthreads();
        for (int idx = F.tid; idx < G.UR * 6; idx += NTHREADS) { const int ee = selE[idx], lrow = idx / 6, slot = idx - lrow * 6, mrow = mrow0 + lrow;
            list[(size_t)(half * 64 + ee) * CAPH + basev[ee] + selP[idx]] = (i32x2){mrow * 8 + slot, __float_as_int(selG[idx])};
            ((float*)(F.ws + WS_GATE))[(size_t)mrow * 8 + slot] = selG[idx]; }
        __syncthreads();
    }
}

__device__ __forceinline__ void moe_table(Frame& F, const int* cnt) {
    LAS int* tstart = (LAS int*)(F.lds + MISC_OFF); LAS int* tcnt = tstart + 64;
    if (F.wave == 0) { const int c = cnt[F.lane]; const int nt = (c + 255) >> 8; int incl = nt;
#pragma unroll
        for (int o = 1; o < 64; o <<= 1) { const int v = __shfl_up(incl, o); if (F.lane >= o) incl += v; }
        tstart[F.lane] = incl - nt; tcnt[F.lane] = c; }
    __syncthreads();
}
struct SchedMoe { int G, c, nsh, npn, half_base; const LAS int* tstart; const i32x2* list; const char* A0; const char* W0; size_t wofs, tstepB, astep;
    __device__ __forceinline__ const i32x2* dummy() const { return list; }
    __device__ __forceinline__ bool next(int k, ge::GUnit& u) const {
        const int T = (k / npn) * G + c, pn = k % npn;
        int e = 64, j = T, nv = 256;
        if (T >= nsh) { const int rem = T - nsh, l = lane_id() & 63; const int st = tstart[l], cn_l = tstart[64 + l];
            const unsigned long long m = __ballot(rem >= st && rem < st + ((cn_l + 255) >> 8));
            if (m == 0ull) return false;
            e = __builtin_ctzll(m); j = rem - tstart[e]; const int cn = tstart[64 + e]; nv = (cn - j * 256) < 256 ? (cn - j * 256) : 256; }
        u.pm = T; u.pn = pn; u.nvalid = nv; u.rows = e == 64 ? nullptr : list + (size_t)e * CAPH + j * 256; u.aux = e == 64 ? half_base + j * 256 : 0;
        u.A = A0 + (size_t)T * astep; u.B = W0 + (size_t)e * EXP_STRIDE + wofs + (size_t)pn * tstepB; return true; }
};
__device__ __forceinline__ void moe_up(Frame& F, int layer, int half) {
    const MoeGeo G = moe_geo(layer);
    moe_table(F, (const int*)(F.ws + WS_CTL) + layer * 128 + half * 64);
    const int cs = (F.G % 8 == 0) ? (F.bid % 8) * (F.G / 8) + F.bid / 8 : F.bid;
    SchedMoe S{F.G, cs, G.HR / 256, 2, half * G.HR, (const LAS int*)(F.lds + MISC_OFF), (const i32x2*)(F.ws + WS_LIST) + (size_t)half * 64 * CAPH,
               (const char*)(F.ws + WS_ACT), (const char*)(F.ws + WS_EXP), (size_t)0, (size_t)256 * 1024, (size_t)0};
    EpiUp E{F.ws + WS_SCR};
    ge::gemm_run<EpiUp, SchedMoe, ge::AMapPlain, 2, true>(F.lds, nullptr, 8, 1024u, 0u, (size_t)128, ge::AMapPlain{1024u}, 1024u, S, E, 0x79797979, 0x7f7f7f7f);
}
__device__ __forceinline__ void moe_down(Frame& F, int layer, int half) {
    const MoeGeo G = moe_geo(layer);
    moe_table(F, (const int*)(F.ws + WS_CTL) + layer * 128 + half * 64);
    const int cs = (F.G % 8 == 0) ? (F.bid % 8) * (F.G / 8) + F.bid / 8 : F.bid;
    SchedMoe S{F.G, cs, G.HR / 256, 4, half * G.HR, (const LAS int*)(F.lds + MISC_OFF), (const i32x2*)(F.ws + WS_LIST) + (size_t)half * 64 * CAPH,
               (const char*)(F.ws + WS_SCR), (const char*)(F.ws + WS_EXP), (size_t)EXP_WD, (size_t)256 * 256, (size_t)256 * 256};
    EpiDown E{F.ws + WS_BIG, half * G.HR};
    ge::gemm_run<EpiDown, SchedMoe, ge::AMapPlain, 0, true>(F.lds, nullptr, 2, 256u, 128u * 256u, (size_t)128, ge::AMapPlain{256u}, 0u, S, E, 0x7a7a7a7a, 0x7b7b7b7b);
}

struct DTile { int e, nv, valid, aux, j; };
__device__ __forceinline__ DTile down_tile(int T, int nsh, const LAS int* tstart) {
    DTile t; t.e = 64; t.nv = 256; t.valid = 1; t.j = T;
    if (T >= nsh) { const int rem = T - nsh, l = lane_id() & 63; const int st = tstart[l], cn_l = tstart[64 + l];
        const unsigned long long m = __ballot(rem >= st && rem < st + ((cn_l + 255) >> 8));
        if (m == 0ull) { t.valid = 0; t.aux = 0; return t; }
        t.e = __builtin_ctzll(m); t.j = __builtin_amdgcn_readfirstlane(rem - tstart[t.e]); const int cn = __builtin_amdgcn_readfirstlane(tstart[64 + t.e]); t.nv = (cn - t.j * 256) < 256 ? (cn - t.j * 256) : 256; }
    t.aux = t.e == 64 ? t.j * 256 : 0;
    return t;
}
#ifndef D2_LOCKSTEP
#define D2_LOCKSTEP 0
#endif
template <int ABL> __device__ __forceinline__ void moe_down2(Frame& F, int layer) {
    const MoeGeo G = moe_geo(layer);
    moe_table(F, (const int*)(F.ws + WS_CTL) + layer * 128);
    const int cs = (F.G % 8 == 0) ? (F.bid % 8) * (F.G / 8) + F.bid / 8 : F.bid;
    const LAS int* tstart = (const LAS int*)(F.lds + MISC_OFF);
    const i32x2* list = (const i32x2*)(F.ws + WS_LIST);
    const int nsh = G.HR / 256;
    int tid_ = threadIdx.x; asm volatile("" : "+v"(tid_));
    const int tid = tid_, wid = __builtin_amdgcn_readfirstlane(tid >> 6), lane = tid & 63, grp = wid >> 2, w4 = wid & 3, fr = lane & 15, fq = lane >> 4;
    int ntl = 0; while (down_tile(ntl * F.G + cs, nsh, tstart).valid) ++ntl;
    const int Q = 8 * ntl;
    if (Q == 0) return;
    LAS char* hbuf = (LAS char*)F.lds; LAS char* bbuf = (LAS char*)F.lds + 65536 + grp * 32768; LAS char* ebuf = (LAS char*)F.lds + MISC_OFF + 1024 + wid * 512;
    const unsigned char* HID = F.ws + WS_SCR; const unsigned char* W0 = F.ws + WS_EXP + EXP_WD; unsigned char* Y = F.ws + WS_BIG;
    unsigned xsrc[4];
#pragma unroll
    for (int i = 0; i < 4; ++i) xsrc[i] = (unsigned)fq * 256u + 16u * (unsigned)((lane & 15) ^ (4 * i + fq));
    int wof[2][2];
#pragma unroll
    for (int ks = 0; ks < 2; ++ks)
#pragma unroll
        for (int j = 0; j < 2; ++j) wof[ks][j] = fr * 256 + 16 * ((8 * ks + 2 * fq + j) ^ fr);
    const int sw = 0x7d7d7d7d, sa = 0x7b7b7b7b;
    f32x4 acc[4][4];
    i32x8 hf[4][2];
    i32x2 ent[4];
    DTile cur = down_tile(cs, nsh, tstart), nx = cur;
    u32x4 pw[4]; int ph = -1;
#define D2_DMAH(TI, K) do { const unsigned char* _hp = HID + (size_t)((K) * F.G + cs) * 65536 + (size_t)(32 * wid) * 256; \
        _Pragma("unroll") for (int _i = 0; _i < 8; ++_i) \
            __builtin_amdgcn_global_load_lds((const unsigned*)(_hp + _i * 1024 + xsrc[_i & 3]), (LAS unsigned*)(hbuf + wid * 8192 + _i * 1024), 16, 0, 0); \
        if ((TI).e != 64 && lane < 32) __builtin_amdgcn_global_load_lds((const unsigned*)((const char*)(list + (size_t)(TI).e * CAPH + (TI).j * 256 + 64 * w4) + lane * 16), (LAS unsigned*)ebuf, 16, 0, 0); } while (0)
#define D2_DMA(QQ, TI) do { const unsigned char* _wb = W0 + (size_t)(TI).e * EXP_STRIDE + (size_t)((((QQ) & 7) * 2 + grp) * 64 + 4 * w4) * 256; LAS char* _lb = bbuf + ((QQ) & 1) * 16384 + w4 * 4096; \
        _Pragma("unroll") for (int _i = 0; _i < 4; ++_i) \
            __builtin_amdgcn_global_load_lds((const unsigned*)(_wb + _i * 4096 + xsrc[_i]), (LAS unsigned*)(_lb + _i * 1024), 16, 0, 0); } while (0)
    D2_DMAH(cur, 0);
    D2_DMA(0, cur); D2_DMA(1, cur);
#pragma unroll 1
    for (int s = 0; s <= 2 * Q; ++s) {
        const int u = D2_LOCKSTEP ? s : s - grp; const bool act = u >= 0 && u < 2 * Q; const int q = u >> 1; const bool mf = act && !(u & 1), ep = act && (u & 1);
        if (ABL == 5) asm volatile("s_waitcnt vmcnt(30)" ::: "memory"); else
        if (act && q + 1 < Q) asm volatile("s_waitcnt vmcnt(4)" ::: "memory"); else asm volatile("s_waitcnt vmcnt(0)" ::: "memory");
        if (ABL != 6) __builtin_amdgcn_s_barrier();
#define D2_FLUSH() do { if (ABL == 4) { _Pragma("unroll") for (int _m = 0; _m < 4; ++_m) asm volatile("" :: "v"(pw[_m])); ph = -1; } if (ph >= 0 && ABL != 1) { _Pragma("unroll") for (int _m = 0; _m < 4; ++_m) { const int _rt = 64 * w4 + 16 * _m + fr; \
            if (_rt < cur.nv) { const int _pk = ent[_m].x; *(u32x4*)(Y + ((size_t)(_pk >> 3) * 7 + (_pk & 7)) * 1024 + ph * 64 + 16 * fq) = pw[_m]; } } ph = -1; } } while (0)
        if (mf) {
            D2_FLUSH();
            if ((q & 7) == 0) {
                if (q) cur = nx;
                nx = down_tile(((q >> 3) + 1) * F.G + cs, nsh, tstart);
#pragma unroll
                for (int m = 0; m < 4; ++m) {
#pragma unroll
                    for (int ks = 0; ks < 2; ++ks) { const LAS char* hp = hbuf + (64 * w4 + 16 * m) * 256; const i32x4 a0 = *(const LAS i32x4*)(hp + wof[ks][0]), a1 = *(const LAS i32x4*)(hp + wof[ks][1]);
                        hf[m][ks] = (i32x8){a0[0], a0[1], a0[2], a0[3], a1[0], a1[1], a1[2], a1[3]}; }
                    const int rt = 64 * w4 + 16 * m + fr;
                    if (cur.e != 64) ent[m] = *(const LAS i32x2*)(ebuf + (16 * m + fr) * 8); else ent[m] = (i32x2){((cur.aux + rt) << 3) | 6, 0x3f800000};
                }
            }
            const LAS char* wb = bbuf + (q & 1) * 16384;
            i32x8 wf[2];
#define D2_RD(IDX, DST) do { const i32x4 _a = *(const LAS i32x4*)(wb + ((IDX) & 3) * 4096 + wof[(IDX) >> 2][0]), _b = *(const LAS i32x4*)(wb + ((IDX) & 3) * 4096 + wof[(IDX) >> 2][1]); \
                DST = (i32x8){_a[0], _a[1], _a[2], _a[3], _b[0], _b[1], _b[2], _b[3]}; } while (0)
            D2_RD(0, wf[0]);
#pragma unroll
            for (int idx = 0; idx < 8; ++idx) {
                if (idx + 1 < 8) D2_RD(idx + 1, wf[(idx + 1) & 1]);
                const int nt = idx & 3, ks = idx >> 2;
#pragma unroll
                for (int m = 0; m < 4; ++m) {
                    if (ABL == 2) { if (ks == 0) acc[m][nt] = (f32x4){(float)wf[idx & 1][0], (float)wf[idx & 1][3], 0.f, 0.f}; } else
                    if (ks == 0) asm volatile("v_mfma_scale_f32_16x16x128_f8f6f4 %0, %1, %2, 0, %3, %4 op_sel_hi:[0,0,0]" : "=&v"(acc[m][nt]) : "v"(wf[idx & 1]), "v"(hf[m][0]), "v"(sw), "v"(sa));
                    else asm volatile("v_mfma_scale_f32_16x16x128_f8f6f4 %0, %1, %2, %0, %3, %4 op_sel_hi:[0,0,0]" : "+v"(acc[m][nt]) : "v"(wf[idx & 1]), "v"(hf[m][1]), "v"(sw), "v"(sa));
                }
            }
#undef D2_RD
            asm volatile("s_nop 15\n\ts_nop 15" ::: "memory");
        } else if (ep) {
            ph = (q & 7) * 2 + grp;
            if (ABL != 1)
#pragma unroll
            for (int m = 0; m < 4; ++m) {
                int lo[4];
#pragma unroll
                for (int nt = 0; nt < 4; ++nt) { const float cx = __builtin_amdgcn_fmed3f(acc[m][nt].x, -448.f, 448.f); lo[nt] = __builtin_amdgcn_cvt_pk_fp8_f32(cx, __builtin_amdgcn_fmed3f(acc[m][nt].y, -448.f, 448.f), __float_as_int(cx), false); }
#pragma unroll
                for (int nt = 0; nt < 4; ++nt) lo[nt] = __builtin_amdgcn_cvt_pk_fp8_f32(__builtin_amdgcn_fmed3f(acc[m][nt].z, -448.f, 448.f), __builtin_amdgcn_fmed3f(acc[m][nt].w, -448.f, 448.f), lo[nt], true);
                pw[m] = (u32x4){(unsigned)lo[0], (unsigned)lo[1], (unsigned)lo[2], (unsigned)lo[3]};
            }
            if ((q & 7) == 2 && nx.valid) D2_DMAH(nx, (q >> 3) + 1);
            if (q + 2 < Q && ABL != 3) { if (((q + 2) >> 3) == (q >> 3)) D2_DMA(q + 2, cur); else D2_DMA(q + 2, nx); }
        }
    }
    D2_FLUSH();
#undef D2_FLUSH
#undef D2_DMAH
#undef D2_DMA
    asm volatile("s_waitcnt vmcnt(0)" ::: "memory");
    __syncthreads();
}

__device__ __forceinline__ void combine_phase(Frame& F, int layer, int half) {
    const MoeGeo G = moe_geo(layer);
    const int gw = F.bid * NWAVES + F.wave, NGW = F.G * NWAVES;
    const unsigned char* Y = F.ws + WS_BIG;
    const float* gts = (const float*)(F.ws + WS_GATE);
    const f32x4* gn1 = (const f32x4*)(F.in[I_N1G] + DM) + F.lane;
    for (int lr = gw; lr < G.HR; lr += NGW) {
        const int mrow = half * G.HR + lr, mi = moe_mi(layer, mrow);
        f32x4 a[4];
#pragma unroll
        for (int j = 0; j < 4; ++j) a[j] = (f32x4){0.f, 0.f, 0.f, 0.f};
#pragma unroll
        for (int k = 0; k < 7; ++k) { const unsigned* yp = (const unsigned*)(Y + ((size_t)lr * 7 + k) * 1024) + F.lane;
            const float gk = k < 6 ? gts[(size_t)mrow * 8 + k] : 1.0f;
#pragma unroll
            for (int j = 0; j < 4; ++j) a[j] += unpk4_fp8(yp[64 * j]) * gk; }
#pragma unroll
        for (int j = 0; j < 4; ++j) a[j] = a[j] * (1.0f / 8.0f);
        u32x2* xr = (u32x2*)moe_xrow(F, layer, mrow) + F.lane; const f32x4* g2 = (const f32x4*)modv(F, layer, mi, 5) + F.lane;
        f32x4 v[4]; float s = 0.f;
#pragma unroll
        for (int j = 0; j < 4; ++j) { v[j] = bf4_to_f32(xr[64 * j]) + g2[64 * j] * a[j]; s += (v[j].x * v[j].x + v[j].y * v[j].y) + (v[j].z * v[j].z + v[j].w * v[j].w); }
        if (layer) { f32x4* xo = (f32x4*)(F.out + (size_t)mrow * DM) + F.lane;
#pragma unroll
            for (int j = 0; j < 4; ++j) xo[64 * j] = v[j]; }
        else {
#pragma unroll
            for (int j = 0; j < 4; ++j) xr[64 * j] = f32_to_bf4(v[j]); }
        if (layer == 0) {
            const float rstd = rsqrtf(wave_sum(s) * (1.f / DM) + EPS);
            const f32x4* sh = (const f32x4*)modv(F, 1, mi, 0) + F.lane; const f32x4* sc = (const f32x4*)modv(F, 1, mi, 1) + F.lane;
            bf16_t* base; int tau;
            if (mrow < NCTX) { const int bb = mrow >> 8, t = mrow & 255; tau = t & 31; base = (bf16_t*)(F.ws + WS_HS5C) + (size_t)(bb * 8 + (t >> 5)) * 768; }
            else { const int q = mrow - NCTX, bb = q >> 13, t = q & 8191; tau = t & 31; base = (bf16_t*)(F.ws + WS_HS5L) + (size_t)(bb * 256 + (t >> 5)) * 768; }
            const size_t gstride = mrow < NCTX ? (size_t)32 * 768 : (size_t)1024 * 768;
#pragma unroll
            for (int j = 0; j < 4; ++j) { const f32x4 y = (v[j] * rstd) * gn1[64 * j] * (sc[64 * j] + 1.0f) + sh[64 * j];
                const int c = 4 * F.lane + 256 * j; u32x2 wv; wv.x = cvt_pk_bf16(y.x, y.y); wv.y = cvt_pk_bf16(y.z, y.w);
                *(u32x2*)(base + (size_t)(c >> 4) * gstride + tau * 16 + (c & 15)) = wv; }
        }
    }
}
struct S5P { float dre, dim, cre, cim; };
__device__ __forceinline__ S5P s5_param(const Frame& F, int di, int g, int p) {
    const int idx = (di * 64 + g) * 64 + p;
    const float are = fminf(F.in[I_SARE][idx], -1e-4f), aim = F.in[I_SAIM][idx], dl = expf(F.in[I_SLOG][idx]);
    S5P r; r.dre = are * dl; r.dim = aim * dl;
    float s, c; sincosf(r.dim, &s, &c); const float m = expf(r.dre); const float lr = m * c - 1.0f, li = m * s;
    const float den = 1.0f / (are * are + aim * aim);
    r.cre = (lr * are + li * aim) * den; r.cim = (li * are - lr * aim) * den; return r;
}
__device__ __forceinline__ void cpow(const S5P& q, float k, float& wr, float& wi) { float s, c; sincosf(k * q.dim, &s, &c); const float m = expf(k * q.dre); wr = m * c; wi = m * s; }

__device__ __forceinline__ void s5_tables(Frame& F) {
    bf16_t* TA = (bf16_t*)(F.ws + WS_ACT + AC_S5A);
    bf16_t* TB = (bf16_t*)(F.ws + WS_ACT + AC_S5B);
    LAS float* wl = (LAS float*)(F.lds + MISC_OFF) + F.wave * 256;
    const int gw = F.bid * NWAVES + F.wave, NGW = F.G * NWAVES, p = F.lane;
    constexpr int NA = 64 * 63, NB_ = 64 * 32, NC = 64 * 32;
    const float* bre = F.in[I_SBRE]; const float* bim = F.in[I_SBIM]; const float* cre = F.in[I_SCRE]; const float* cim = F.in[I_SCIM];
    for (int it = gw; it < NA + NB_ + NC; it += NGW) {
        if (it < NA) {
            const int g = it / 63, dlt = it % 63 - 31, ad = dlt < 0 ? -dlt : dlt;
            { const S5P qf = s5_param(F, 0, g, p), qb = s5_param(F, 1, g, p); float wr, wi;
              cpow(qf, (float)ad, wr, wi); wl[p] = wr * qf.cre - wi * qf.cim; wl[64 + p] = wr * qf.cim + wi * qf.cre;
              cpow(qb, (float)ad, wr, wi); wl[128 + p] = wr * qb.cre - wi * qb.cim; wl[192 + p] = wr * qb.cim + wi * qb.cre; }
            asm volatile("s_waitcnt lgkmcnt(0)" ::: "memory");
            const int i = F.lane >> 2, j0 = 4 * (F.lane & 3);
            float acc[4] = {0.f, 0.f, 0.f, 0.f};
#pragma unroll 1
            for (int di = 0; di < 2; ++di) {
                if ((di == 0 && dlt < 0) || (di == 1 && dlt > 0)) continue;
                const float* cr = cre + ((size_t)(di * 64 + g) * 16 + i) * 64; const float* ci = cim + ((size_t)(di * 64 + g) * 16 + i) * 64;
                const float* br = bre + ((size_t)(di * 64 + g) * 64) * 16 + j0; const float* bi = bim + ((size_t)(di * 64 + g) * 64) * 16 + j0;
#pragma unroll 4
                for (int pp = 0; pp < 64; ++pp) { const float wr = wl[di * 128 + pp], wi = wl[di * 128 + 64 + pp]; const float c_r = cr[pp], c_i = ci[pp];
                    const float xr = c_r * wr - c_i * wi, xi = c_r * wi + c_i * wr; const f32x4 b_r = *(const f32x4*)(br + pp * 16), b_i = *(const f32x4*)(bi + pp * 16);
                    acc[0] += xr * b_r.x - xi * b_i.x; acc[1] += xr * b_r.y - xi * b_i.y; acc[2] += xr * b_r.z - xi * b_i.z; acc[3] += xr * b_r.w - xi * b_i.w; }
            }
            if (dlt == 0) { const int jj = i - j0; if (jj >= 0 && jj < 4) { const float dv = F.in[I_SD][g * 16 + i]; if (jj == 0) acc[0] += dv; else if (jj == 1) acc[1] += dv; else if (jj == 2) acc[2] += dv; else acc[3] += dv; } }
            u32x2 wv; wv.x = cvt_pk_bf16(acc[0], acc[1]); wv.y = cvt_pk_bf16(acc[2], acc[3]);
            for (int sg = 0; sg < 32; ++sg) { const int tau = sg + dlt; if (tau >= 0 && tau < 32) *(u32x2*)(TB + ((size_t)g * 512 + tau * 16 + i) * 768 + sg * 16 + j0) = wv; }
            asm volatile("s_waitcnt lgkmcnt(0)" ::: "memory");
        } else if (it < NA + NB_) {
            const int r = it - NA, g = r >> 5, tau = r & 31;
            const S5P qf = s5_param(F, 0, g, p), qb = s5_param(F, 1, g, p); float fr_, fi_, br_, bi_;
            cpow(qf, (float)(tau + 1), fr_, fi_); cpow(qb, (float)(32 - tau), br_, bi_);
            for (int i = 0; i < 16; ++i) {
                const float c0r = cre[((size_t)(0 * 64 + g) * 16 + i) * 64 + p], c0i = cim[((size_t)(0 * 64 + g) * 16 + i) * 64 + p];
                const float c1r = cre[((size_t)(1 * 64 + g) * 16 + i) * 64 + p], c1i = cim[((size_t)(1 * 64 + g) * 16 + i) * 64 + p];
                bf16_t* row = TB + ((size_t)g * 512 + tau * 16 + i) * 768 + 512;
                row[p] = f2bf(c0r * fr_ - c0i * fi_); row[64 + p] = f2bf(-(c0r * fi_ + c0i * fr_));
                row[128 + p] = f2bf(c1r * br_ - c1i * bi_); row[192 + p] = f2bf(-(c1r * bi_ + c1i * br_)); }
        } else {
            const int r = it - NA - NB_, g = r >> 5, sg = r & 31;
            const S5P qf = s5_param(F, 0, g, p), qb = s5_param(F, 1, g, p); float wr, wi;
            cpow(qf, (float)(31 - sg), wr, wi); const float fr_ = wr * qf.cre - wi * qf.cim, fi_ = wr * qf.cim + wi * qf.cre;
            cpow(qb, (float)sg, wr, wi); const float br_ = wr * qb.cre - wi * qb.cim, bi_ = wr * qb.cim + wi * qb.cre;
            const float* b0r = bre + ((size_t)(0 * 64 + g) * 64 + p) * 16; const float* b0i = bim + ((size_t)(0 * 64 + g) * 64 + p) * 16;
            const float* b1r = bre + ((size_t)(1 * 64 + g) * 64 + p) * 16; const float* b1i = bim + ((size_t)(1 * 64 + g) * 64 + p) * 16;
            bf16_t* r0 = TA + ((size_t)g * 256 + p) * 512 + sg * 16;
#pragma unroll
            for (int q4 = 0; q4 < 4; ++q4) { const f32x4 xr = *(const f32x4*)(b0r + 4 * q4), xi = *(const f32x4*)(b0i + 4 * q4), yr = *(const f32x4*)(b1r + 4 * q4), yi = *(const f32x4*)(b1i + 4 * q4);
                const f32x4 are_ = xr * fr_ - xi * fi_, aim_ = xr * fi_ + xi * fr_, bre_ = yr * br_ - yi * bi_, bim_ = yr * bi_ + yi * br_;
                u32x2 w0, w1, w2, w3; w0.x = cvt_pk_bf16(are_.x, are_.y); w0.y = cvt_pk_bf16(are_.z, are_.w); w1.x = cvt_pk_bf16(aim_.x, aim_.y); w1.y = cvt_pk_bf16(aim_.z, aim_.w);
                w2.x = cvt_pk_bf16(bre_.x, bre_.y); w2.y = cvt_pk_bf16(bre_.z, bre_.w); w3.x = cvt_pk_bf16(bim_.x, bim_.y); w3.y = cvt_pk_bf16(bim_.z, bim_.w);
                *(u32x2*)(r0 + 4 * q4) = w0; *(u32x2*)(r0 + (size_t)64 * 512 + 4 * q4) = w1; *(u32x2*)(r0 + (size_t)128 * 512 + 4 * q4) = w2; *(u32x2*)(r0 + (size_t)192 * 512 + 4 * q4) = w3; }
        }
    }
}

struct SchedS5a { __device__ __forceinline__ const i32x2* dummy() const { return nullptr; } int G, c; const char* HL; const char* HC; const char* TA;
    __device__ __forceinline__ bool next(int i, ge::GUnit& u) const { const int L = i * G + c; if (L >= 320) return false; const int g = L / 5, k = L % 5;
        u.aux = g; u.pm = k; u.pn = 0; u.nvalid = 256; u.A = k < 4 ? HL + ((size_t)g * 1024 + k * 256) * 1536 : HC + (size_t)g * 32 * 1536; u.B = TA + (size_t)g * 256 * 1024; return true; } };
struct SchedS5b { __device__ __forceinline__ const i32x2* dummy() const { return nullptr; } int G, c; const char* HL; const char* TB;
    __device__ __forceinline__ bool next(int i, ge::GUnit& u) const { const int L = i * G + c; if (L >= 512) return false; const int g = L >> 3, k = (L >> 1) & 3, pn = L & 1;
        u.aux = g; u.pm = k; u.pn = pn; u.nvalid = 256; u.A = HL + ((size_t)g * 1024 + k * 256) * 1536; u.B = TB + ((size_t)g * 512 + pn * 256) * 1536; return true; } };

__device__ __forceinline__ void s5_carry(Frame& F) {
    LAS float* ex = (LAS float*)F.lds;
    for (int u = F.bid; u < 512; u += F.G) {
        const int di = u & 1, b = (u >> 1) & 3, g = u >> 3, p = F.lane, w = F.wave;
        const S5P q = s5_param(F, di, g, p); float lr, li, gr, gi; cpow(q, 32.0f, lr, li); cpow(q, 1024.0f, gr, gi);
        const float* __restrict__ sl = (const float*)(F.ws + WS_BIG + BG_SLOCL) + ((size_t)g * 1024 + b * 256) * 256 + di * 128 + p;
        const float* __restrict__ sc = (const float*)(F.ws + WS_BIG + BG_SLOCC) + ((size_t)g * 32 + b * 8) * 256 + di * 128 + p;
        bf16_t* __restrict__ ho = (bf16_t*)(F.ws + WS_HS5L) + ((size_t)g * 1024 + b * 256) * 768 + 512 + di * 128 + p;
        float sr[32], si[32];
#pragma unroll
        for (int k = 0; k < 32; ++k) { const int c = di == 0 ? 32 * w + k : 255 - 32 * w - k; sr[k] = sl[(size_t)c * 256]; si[k] = sl[(size_t)c * 256 + 64]; }
        float hr = 0.f, hi_ = 0.f;
        { float cr[8], ci[8];
#pragma unroll
          for (int k = 0; k < 8; ++k) { const int cc = di == 0 ? k : 7 - k; cr[k] = sc[cc * 256]; ci[k] = sc[cc * 256 + 64]; }
#pragma unroll
          for (int k = 0; k < 8; ++k) { const float nr = lr * hr - li * hi_ + cr[k], ni = lr * hi_ + li * hr + ci[k]; hr = nr; hi_ = ni; } }
        float qr = 0.f, qi = 0.f;
#pragma unroll
        for (int k = 0; k < 32; ++k) { const float nr = lr * qr - li * qi + sr[k], ni = lr * qi + li * qr + si[k]; qr = nr; qi = ni; }
        ex[(w * 2 + 0) * 64 + p] = qr; ex[(w * 2 + 1) * 64 + p] = qi;
        __syncthreads();
        for (int v = 0; v < w; ++v) { const float tr = ex[(v * 2 + 0) * 64 + p], ti = ex[(v * 2 + 1) * 64 + p]; const float nr = gr * hr - gi * hi_ + tr, ni = gr * hi_ + gi * hr + ti; hr = nr; hi_ = ni; }
#pragma unroll
        for (int k = 0; k < 32; ++k) { const int c = di == 0 ? 32 * w + k : 255 - 32 * w - k; ho[(size_t)c * 768] = f2bf(hr); ho[(size_t)c * 768 + 64] = f2bf(hi_);
            const float nr = lr * hr - li * hi_ + sr[k], ni = lr * hi_ + li * hr + si[k]; hr = nr; hi_ = ni; }
        __syncthreads();
    }
}

struct AMapGlu { __device__ __forceinline__ unsigned operator()(int R, int C) const { const int c = 2 * C; return (unsigned)((R >> 5) * 512 + (R & 31) * 16) + (unsigned)(c >> 4) * (1024u * 512u) + (unsigned)(c & 15); } };
#ifndef MK_PER_PHASE
#define MK_PER_PHASE 0
#endif
constexpr int NPH = 17;

constexpr size_t CTL_BAR_BYTE = 16384;
#define XB_TMO      128
#define XB_XCNT(j)  (256  + 64 * (j))
#define XB_XSUB(j)  (1280 + 64 * (j))
#define XB_XGEN(j)  (2304 + 64 * (j))
#define XB_TOP      3328
#define XB_TOPGEN   3392
#define XCD_BAR_WORDS 3456
#define XB_SPIN_CAP (1u << 22)
__device__ __forceinline__ unsigned xb_ld(unsigned* p)              { return __hip_atomic_load(p, __ATOMIC_RELAXED, __HIP_MEMORY_SCOPE_AGENT); }
__device__ __forceinline__ unsigned xb_add(unsigned* p, unsigned v) { return __hip_atomic_fetch_add(p, v, __ATOMIC_RELAXED, __HIP_MEMORY_SCOPE_AGENT); }
__device__ __forceinline__ unsigned xb_xcc_id() { return (unsigned)__builtin_amdgcn_s_getreg((3 << 11) | 20) & 0xFu; }
#define XB_SPIN(cond, bar) do { unsigned _sp = 0; while (cond) { __builtin_amdgcn_s_sleep(1); \
    if ((++_sp & 255u) == 0u) { if (xb_ld(&(bar)[XB_TMO])) break; if (_sp > XB_SPIN_CAP) { atomicAdd(&(bar)[XB_TMO], 1u); break; } } } } while (0)
struct XcdBarrier { unsigned* bar; unsigned x; volatile LAS unsigned* st; };
__device__ __forceinline__ XcdBarrier xcd_barrier_post(unsigned* bar, volatile LAS unsigned* st) {
    XcdBarrier b; b.bar = bar; b.x = xb_xcc_id(); b.st = st;
    if (threadIdx.x == 0) (void)xb_add(&bar[XB_XCNT(b.x)], 1u);
    return b;
}
__device__ __forceinline__ void xcd_barrier_complete(unsigned* bar, unsigned x, unsigned& nloc, unsigned& nx) {
    const unsigned G = gridDim.x;
    unsigned sum, cnt, mine, sp = 0u;
    for (;;) {
        sum = 0u; cnt = 0u; mine = 0u;
#pragma unroll
        for (unsigned j = 0; j < 16; ++j) { const unsigned c = xb_ld(&bar[XB_XCNT(j)]); sum += c; cnt += (c > 0u) ? 1u : 0u; mine = (j == x) ? c : mine; }
        if (sum == G) break;
        __builtin_amdgcn_s_sleep(1);
        if ((++sp & 255u) == 0u) { if (xb_ld(&bar[XB_TMO])) break; if (sp > XB_SPIN_CAP) { atomicAdd(&bar[XB_TMO], 1u); break; } }
    }
    nloc = mine > 0u ? mine : 1u; nx = cnt > 0u ? cnt : 1u;
}
__device__ __forceinline__ void xcd_barrier(const XcdBarrier& b) {
    asm volatile("s_waitcnt vmcnt(0)" ::: "memory");
    __syncthreads();
    if (threadIdx.x == 0) {
        unsigned* bar = b.bar;
        __builtin_amdgcn_s_waitcnt(0);
        unsigned nloc = b.st[0], nx = b.st[1];
        if (nloc == 0u) { xcd_barrier_complete(bar, b.x, nloc, nx); b.st[0] = nloc; b.st[1] = nx; }
        const unsigned old = xb_add(&bar[XB_XSUB(b.x)], 1u);
        const unsigned gen = old / nloc;
        if (old + 1u == (gen + 1u) * nloc) {
            __builtin_amdgcn_fence(__ATOMIC_RELEASE, "agent");
            asm volatile("s_waitcnt vmcnt(0)" ::: "memory");
            const unsigned og = xb_add(&bar[XB_TOP], 1u);
            const unsigned tg = og / nx;
            if (og + 1u == (tg + 1u) * nx) xb_add(&bar[XB_TOPGEN], 1u);
            else XB_SPIN(xb_ld(&bar[XB_TOPGEN]) == tg, bar);
            __builtin_amdgcn_fence(__ATOMIC_ACQUIRE, "agent");
            xb_add(&bar[XB_XGEN(b.x)], 1u);
            asm volatile("s_waitcnt vmcnt(0)" ::: "memory");
        } else {
            XB_SPIN(xb_ld(&bar[XB_XGEN(b.x)]) == gen, bar);
            __builtin_amdgcn_fence(__ATOMIC_ACQUIRE, "agent");
            asm volatile("s_waitcnt vmcnt(0)" ::: "memory");
        }
    }
    __syncthreads();
}

__global__ void __launch_bounds__(NTHREADS, 2) mega_fwd(Args args) {
    extern __shared__ __attribute__((aligned(16))) unsigned char lds_raw[];
    Frame F;
    F.lds = (LAS unsigned char*)lds_raw; F.in = args.in; F.out = args.out; F.ws = args.ws;
    F.tid = threadIdx.x; F.lane = F.tid & 63; F.wave = __builtin_amdgcn_readfirstlane(F.tid >> 6); F.G = gridDim.x; F.bid = blockIdx.x;
    const int lo = args.ph_lo, hi = args.ph_hi;
    volatile LAS unsigned* bst = (volatile LAS unsigned*)(F.lds + LDS_BYTES - 16);
    XcdBarrier bar; bar.bar = (unsigned*)(F.ws + WS_CTL + CTL_BAR_BYTE); bar.x = 0; bar.st = bst;
    if (hi - lo > 1) { if (F.tid == 0) { bst[0] = 0u; bst[1] = 0u; } __syncthreads(); bar = xcd_barrier_post((unsigned*)(F.ws + WS_CTL + CTL_BAR_BYTE), bst); }
#ifdef PH_ONLY
#define IN(k) ((k) == PH_ONLY && lo <= (k) && (k) < hi)
#else
#define IN(k) (lo <= (k) && (k) < hi)
#endif
#define SEAM(k) do { if (IN(k) && IN((k) + 1)) { if ((k) == 0) cg::this_grid().sync(); else xcd_barrier(bar); } } while (0)

#ifndef PROBE_REP
#define PROBE_REP -1
#endif
#ifndef DOWN_ABL
#define DOWN_ABL 0
#endif
#define NREP(k) ((PROBE_REP == (k)) ? 2 : 1)
#define REPSYNC(k, rep) do { if ((rep) + 1 < NREP(k)) xcd_barrier(bar); } while (0)
    if (IN(0)) { for (int rep = 0; rep < NREP(0); ++rep) { p0_prologue(F); __syncthreads(); REPSYNC(0, rep); } } SEAM(0);
    if (IN(1)) for (int rep = 0; rep < NREP(1); ++rep) { p1_norm1(F); REPSYNC(1, rep); } SEAM(1);
    if (IN(2)) {
        { ge::StaticOrder S; S.init(NROW / 256, 4, F.G, F.bid, F.ws + WS_ACT, (size_t)256 * 2048, F.ws + WS_WIN, (size_t)256 * 2048);
          EpiG1 E{F.ws, F.in[I_QG], F.in[I_KG], 0};
          ge::gemm_run<EpiG1, ge::StaticOrder, ge::AMapPlain, 0>(F.lds, nullptr, 16, 2048u, 128u * 2048u, (size_t)128, ge::AMapPlain{2048u}, 0u, S, E); }
        {
          ge::StaticOrder S; S.init(NROW / 256, 6, F.G, F.bid, F.ws + WS_SCR, (size_t)256 * 1024, F.ws + WS_WIN8, (size_t)256 * 1024);
          if (F.G == 256) { if (F.bid < 16) { S.G = 16; S.lim = 32; } else { S.G = 240; S.c = F.bid - 16; S.base = 32; } }
          EpiG1 E{F.ws, F.in[I_QG], F.in[I_KG], 4};
          ge::gemm_run<EpiG1, ge::StaticOrder, ge::AMapPlain, 0, true>(F.lds, nullptr, 8, 1024u, 128u * 1024u, (size_t)128, ge::AMapPlain{1024u}, 0u, S, E, 0x79797979, 0x7c7c7c7c); }
    }
#if PROBE_REP == 2
    xcd_barrier(bar);
    {
        ge::StaticOrder S; S.init(NROW / 256, 10, F.G, F.bid, F.ws + WS_ACT, (size_t)256 * 2048, F.ws + WS_WIN, (size_t)256 * 2048);
        EpiG1 E{F.ws, F.in[I_QG], F.in[I_KG], 0};
        ge::gemm_run<EpiG1, ge::StaticOrder, ge::AMapPlain, 0>(F.lds, nullptr, 16, 2048u, 128u * 2048u, (size_t)128, ge::AMapPlain{2048u}, 0u, S, E);
    }
#endif
    SEAM(2);
    if (IN(3)) { lru_consts(F); for (int u = F.bid; u < NBATCH * LRU_NCH; u += F.G) lru_unit<false>(F, u / LRU_NCH, u % LRU_NCH); }
#if PROBE_REP == 3
    xcd_barrier(bar);
    { lru_consts(F); for (int u = F.bid; u < NBATCH * LRU_NCH; u += F.G) lru_unit<false>(F, u / LRU_NCH, u % LRU_NCH); }
#endif
    SEAM(3);
    if (IN(4)) for (int rep = 0; rep < NREP(4); ++rep) { lru_carry(F); REPSYNC(4, rep); } SEAM(4);
    if (IN(5)) {
        lru_consts(F);
        for (int rep = 0; rep < NREP(51); ++rep) { for (int u = F.bid; u < NBATCH * LRU_NCH; u += F.G) lru_unit<true>(F, u / LRU_NCH, u % LRU_NCH); REPSYNC(51, rep); }
        const float s1 = wave_sum(F.in[I_LQ1][F.lane] * F.in[I_LK1][F.lane]), s2 = wave_sum(F.in[I_LQ2][F.lane] * F.in[I_LK2][F.lane]);
        const float lam = expf(s1) - expf(s2) + 0.2f;
        const int ca = (F.G % 8 == 0) ? (F.bid % 8) * (F.G / 8) + F.bid / 8 : F.bid;
        for (int rep = 0; rep < NREP(50); ++rep)
        for (int u = ca; u < 528; u += F.G) {
            const bool isl = u < 512; const int b = isl ? (u >> 7) : ((u - 512) >> 2), h = isl ? ((u >> 5) & 3) : ((u - 512) & 3);
#ifdef PROBE_ABL
            if (rep == 0) at::attn_unit<PROBE_ABL>(F, b, h, isl ? NCTX + b * SEQ + (u & 31) * 256 : b * 256, isl ? 132 : 4, lam); else
#endif
            at::attn_unit<0>(F, b, h, isl ? NCTX + b * SEQ + (u & 31) * 256 : b * 256, isl ? 132 : 4, lam);
            __syncthreads();
        }
    } SEAM(5);
    if (IN(6)) {
        ge::StaticOrder S; S.init(NROW / 256, 4, F.G, F.bid, F.ws + WS_ACT, (size_t)256 * 2048, F.ws + WS_WOUT, (size_t)256 * 2048);
        EpiG2 E{F};
        ge::gemm_run<EpiG2, ge::StaticOrder, ge::AMapPlain, 0>(F.lds, nullptr, 16, 2048u, 128u * 2048u, (size_t)128, ge::AMapPlain{2048u}, 0u, S, E);
    }
#if PROBE_REP == 6
    xcd_barrier(bar);
    {
        ge::StaticOrder S; S.init(NROW / 256, 4, F.G, F.bid, F.ws + WS_ACT, (size_t)256 * 2048, F.ws + WS_WOUT, (size_t)256 * 2048);
        EpiG2 E{F};
        ge::gemm_run<EpiG2, ge::StaticOrder, ge::AMapPlain, 0>(F.lds, nullptr, 16, 2048u, 128u * 2048u, (size_t)128, ge::AMapPlain{2048u}, 0u, S, E);
    }
#endif
    SEAM(6);
    if (IN(7)) { router_phase(F, 0); } SEAM(7);
#if PROBE_REP == 80
    if (IN(8)) { moe_up(F, 0, 0); xcd_barrier(bar); }
#endif
    if (IN(8)) { moe_up(F, 0, 0); asm volatile("s_waitcnt vmcnt(0)" ::: "memory"); __syncthreads(); moe_down2<DOWN_ABL>(F, 0); }
#if PROBE_REP == 81
    if (IN(8)) { xcd_barrier(bar); moe_down2<0>(F, 0); }
#endif
    SEAM(8);
    if (IN(9)) {
        combine_phase(F, 0, 0);
        s5_tables(F);
        LAS float* scr = (LAS float*)(F.lds + 32768 + F.wave * 8704);
        for (int it = F.bid * NWAVES + F.wave; it < 65 * 384; it += F.G * NWAVES) conv_expert_item(F, 1, it, scr);
    } SEAM(9);
    if (IN(10)) for (int rep = 0; rep < NREP(10); ++rep) {
        const int cs = (F.G % 8 == 0) ? (F.bid % 8) * (F.G / 8) + F.bid / 8 : F.bid;
        SchedS5a S{F.G, cs, (const char*)(F.ws + WS_HS5L), (const char*)(F.ws + WS_HS5C), (const char*)(F.ws + WS_ACT + AC_S5A)};
        EpiS5a E{F.ws};
        ge::gemm_run<EpiS5a, SchedS5a, ge::AMapPlain, 0>(F.lds, nullptr, 8, 1024u, 128u * 1536u, (size_t)128, ge::AMapPlain{1536u}, 0u, S, E);
        REPSYNC(10, rep);
    } SEAM(10);
    if (IN(11)) { s5_carry(F); } SEAM(11);
    if (IN(12)) for (int rep = 0; rep < NREP(12); ++rep) {
        const int cs = (F.G % 8 == 0) ? (F.bid % 8) * (F.G / 8) + F.bid / 8 : F.bid;
        SchedS5b S{F.G, cs, (const char*)(F.ws + WS_HS5L), (const char*)(F.ws + WS_ACT + AC_S5B)};
        EpiS5b E{F.ws};
        ge::gemm_run<EpiS5b, SchedS5b, ge::AMapPlain, 0>(F.lds, nullptr, 12, 1536u, 128u * 1536u, (size_t)128, ge::AMapPlain{1536u}, 0u, S, E);
        REPSYNC(12, rep);
    } SEAM(12);
    if (IN(13)) for (int rep = 0; rep < NREP(13); ++rep) {
#if PROBE_REP == 13 && defined(PROBE_HOT)
        ge::StaticOrder S; S.init(NLAT / 256, 8, F.G, F.bid, F.ws + WS_BIG + BG_ZS5, rep == 0 ? (size_t)0 : (size_t)8 * 512, F.ws + WS_GLU, rep == 0 ? (size_t)0 : (size_t)256 * 1024);
#else
        ge::StaticOrder S; S.init(NLAT / 256, 8, F.G, F.bid, F.ws + WS_BIG + BG_ZS5, (size_t)8 * 512, F.ws + WS_GLU, (size_t)256 * 1024);
#endif
        EpiGlu E{F};
        ge::gemm_run<EpiGlu, ge::StaticOrder, AMapGlu, 0, true>(F.lds, nullptr, 8, 1024u, 2048u, (size_t)8 * 1024 * 512, AMapGlu{}, 0u, S, E, 0x7a7a7a7a, 0x7d7d7d7d);
        REPSYNC(13, rep);
    } SEAM(13);
    if (IN(14)) { router_phase(F, 1); } SEAM(14);
    if (IN(15)) { moe_up(F, 1, 0); asm volatile("s_waitcnt vmcnt(0)" ::: "memory"); __syncthreads(); moe_down2<0>(F, 1); } SEAM(15);
    if (IN(16)) for (int rep = 0; rep < NREP(16); ++rep) { combine_phase(F, 1, 0); REPSYNC(16, rep); }
#undef IN
#undef SEAM
}

extern "C" void kernel_launch(void* const* d_in, const int* in_sizes, int n_in, void* d_out, int out_size, void* d_ws, size_t ws_size, hipStream_t stream) {
    static int grid = 0;
    if (grid == 0) {
        if (n_in != 42 || out_size != NLAT * DM || ws_size < WS_END) { fprintf(stderr, "kernel_launch: unexpected problem: n_in %d out %d ws %zu (need %zu)\n", n_in, out_size, ws_size, (size_t)WS_END); grid = -1; return; }
        int dev = 0, cus = 0, per_cu = 0;
        if (hipGetDevice(&dev) != hipSuccess || hipDeviceGetAttribute(&cus, hipDeviceAttributeMultiprocessorCount, dev) != hipSuccess) { grid = -1; return; }
        if (hipFuncSetAttribute((const void*)mega_fwd, hipFuncAttributeMaxDynamicSharedMemorySize, LDS_BYTES) != hipSuccess) { fprintf(stderr, "kernel_launch: hipFuncSetAttribute failed\n"); grid = -1; return; }
        if (hipOccupancyMaxActiveBlocksPerMultiprocessor(&per_cu, (const void*)mega_fwd, NTHREADS, LDS_BYTES) != hipSuccess || per_cu < 1) { fprintf(stderr, "kernel_launch: occupancy query failed (%d)\n", per_cu); grid = -1; return; }
        grid = cus * per_cu; if (grid > 256) grid = 256;
        fprintf(stderr, "kernel_launch: cus %d per_cu %d grid %d ws %zu\n", cus, per_cu, grid, ws_size);
    }
    if (grid < 0) return;
    (void)hipMemsetAsync((char*)d_ws + WS_CTL, 0, 65536, stream);
    Args a{};
    for (int i = 0; i < 42; ++i) a.in[i] = (const float*)d_in[i];
    a.out = (float*)d_out; a.ws = (unsigned char*)d_ws;
#if MK_PER_PHASE
    for (int p = 0; p < NPH; ++p) { a.ph_lo = p; a.ph_hi = p + 1; hipLaunchKernelGGL(mega_fwd, dim3(grid), dim3(NTHREADS), LDS_BYTES, stream, a); }
#else
    a.ph_lo = 0; a.ph_hi = NPH;
    void* kargs[] = {&a};
    const hipError_t e = hipLaunchCooperativeKernel((const void*)mega_fwd, dim3(grid), dim3(NTHREADS), kargs, LDS_BYTES, stream);
    if (e != hipSuccess) fprintf(stderr, "kernel_launch: cooperative launch failed: %s (grid %d)\n", hipGetErrorString(e), grid);
#endif
}
```

```cpp
#include <hip/hip_runtime.h>
#include <hip/hip_cooperative_groups.h>
#include <cstdio>
#include <cstdint>
namespace cg = cooperative_groups;

#define LAS __attribute__((address_space(3)))
typedef unsigned short bf16_t;
typedef short bf16x8 __attribute__((ext_vector_type(8)));
typedef short s16x4 __attribute__((ext_vector_type(4)));
typedef float f32x2 __attribute__((ext_vector_type(2)));
typedef float f32x4 __attribute__((ext_vector_type(4)));
typedef float f32x16 __attribute__((ext_vector_type(16)));
typedef unsigned u32x2 __attribute__((ext_vector_type(2)));
typedef int i32x2 __attribute__((ext_vector_type(2)));
typedef unsigned u32x4 __attribute__((ext_vector_type(4)));

constexpr int DM = 1024, NBATCH = 4, SEQ = 8192, CTXL = 256;
constexpr int NCTX = NBATCH * CTXL;
constexpr int NLAT = NBATCH * SEQ;
constexpr int NROW = NCTX + NLAT;
constexpr float EPS = 1e-6f;
constexpr int NTHREADS = 512, NWAVES = 8;
constexpr int LRU_NCH = 264;
constexpr int CAPH = 33792;

constexpr size_t MiB = 1ull << 20;
constexpr size_t WS_CTL = 0;
constexpr size_t WS_MODV = 1 * MiB;
constexpr size_t WS_ROPE = WS_MODV + 256 * 1024;
constexpr size_t WS_LRUW = WS_MODV + 512 * 1024;
constexpr size_t WS_LRUSP = WS_MODV + 768 * 1024;
constexpr size_t WS_WRT = 2 * MiB;
constexpr size_t WS_WIN = 4 * MiB, WS_WIN8 = 6 * MiB, WS_WOUT = 9 * MiB, WS_GLU = 11 * MiB;
constexpr size_t WS_EXP = 15 * MiB;
constexpr size_t WS_ACT = 113 * MiB;
constexpr size_t WS_BIG = 179 * MiB;
constexpr size_t WS_SCR = 410 * MiB;
constexpr size_t WS_LIST = 472 * MiB;
constexpr size_t WS_GATE = 490 * MiB;
constexpr size_t WS_HS5L = 494 * MiB;
constexpr size_t WS_HS5C = 590 * MiB;
constexpr size_t WS_END = 594 * MiB;
constexpr size_t BG_GATE = 0, BG_XA = 33 * MiB, BG_Q = 66 * MiB, BG_K = 99 * MiB, BG_V = 132 * MiB, BG_LSUM = 165 * MiB, BG_LHIN = 175 * MiB;
constexpr size_t BG_MODP = 200 * MiB;
constexpr size_t BG_SSQ = 200 * MiB;
constexpr size_t BG_ZS5 = 0, BG_SLOCL = 64 * MiB, BG_SLOCC = 128 * MiB;
constexpr size_t AC_S5A = 0, AC_S5B = 16 * MiB;
constexpr size_t EXP_STRIDE = 3 * MiB / 2, EXP_WD = 1 * MiB;

constexpr int RING_BYTES = 131072, MISC_OFF = RING_BYTES, LDS_BYTES = 147456;

__device__ __forceinline__ unsigned cvt_pk_bf16(float lo, float hi) { unsigned r; asm("v_cvt_pk_bf16_f32 %0, %1, %2" : "=v"(r) : "v"(lo), "v"(hi)); return r; }
__device__ __forceinline__ bf16_t f2bf(float f) { return (bf16_t)(cvt_pk_bf16(f, 0.f) & 0xffffu); }
__device__ __forceinline__ float bf2f(bf16_t h) { return __uint_as_float(((unsigned)h) << 16); }
__device__ __forceinline__ float bflo(unsigned w) { return __uint_as_float(w << 16); }
__device__ __forceinline__ float bfhi(unsigned w) { return __uint_as_float(w & 0xffff0000u); }
__device__ __forceinline__ float wave_sum(float v) {
#pragma unroll
    for (int o = 1; o < 64; o <<= 1) v += __shfl_xor(v, o);
    return v;
}
__device__ __forceinline__ float sigmoidf_(float x) { return __builtin_amdgcn_rcpf(1.f + __expf(-x)); }
__device__ __forceinline__ float siluf_(float x) { return x * sigmoidf_(x); }
__device__ __forceinline__ float gelu_tanh(float x) { const float u = 0.7978845608028654f * (x + 0.044715f * x * x * x); return x * __builtin_amdgcn_rcpf(1.f + __expf(-2.f * u)); }
__device__ __forceinline__ unsigned pk4_fp8(float a, float b, float c, float d) {
    a = fminf(fmaxf(a, -448.f), 448.f); b = fminf(fmaxf(b, -448.f), 448.f); c = fminf(fmaxf(c, -448.f), 448.f); d = fminf(fmaxf(d, -448.f), 448.f);
    int w = __builtin_amdgcn_cvt_pk_fp8_f32(a, b, 0, false); w = __builtin_amdgcn_cvt_pk_fp8_f32(c, d, w, true); return (unsigned)w; }
typedef int i32x8 __attribute__((ext_vector_type(8)));
typedef int i32x4 __attribute__((ext_vector_type(4)));
__device__ __forceinline__ f32x4 unpk4_fp8(unsigned w) { const f32x2 lo = __builtin_amdgcn_cvt_pk_f32_fp8((int)w, false), hi = __builtin_amdgcn_cvt_pk_f32_fp8((int)w, true); return (f32x4){lo.x, lo.y, hi.x, hi.y}; }
__device__ __forceinline__ int crow(int r, int hi) { return (r & 3) + 8 * (r >> 2) + 4 * hi; }

__device__ __forceinline__ int lane_id() { return (int)__builtin_amdgcn_mbcnt_hi(~0u, __builtin_amdgcn_mbcnt_lo(~0u, 0u)); }

struct Args { const float* in[42]; float* out; unsigned char* ws; int ph_lo, ph_hi; };
struct Frame {
    LAS unsigned char* lds;
    const float* const* in;
    float* out; unsigned char* ws;
    int tid, lane, wave, G, bid;
};
enum { I_X = 0, I_C, I_CTX, I_CCTX, I_MODW, I_MODB, I_N1G, I_N2G, I_WIN, I_WOUT, I_CONVW, I_CONVB, I_LLAM, I_LRW, I_LRB, I_LIW, I_LIB,
       I_QG, I_KG, I_LQ1, I_LK1, I_LQ2, I_LK2, I_SUBG, I_SARE, I_SAIM, I_SLOG, I_SBRE, I_SBIM, I_SCRE, I_SCIM, I_SD, I_GLUW, I_GLUB,
       I_RW, I_RB, I_EWG, I_EWU, I_EWD, I_SWG, I_SWU, I_SWD };

__device__ __forceinline__ int row_mi(int r) { return r < NCTX ? 4 : ((r - NCTX) >> 13); }
__device__ __forceinline__ bf16_t* xb0_ptr(const Frame& F, int r) { return (bf16_t*)F.out + (size_t)r * DM; }
__device__ __forceinline__ bf16_t* xb1_ptr(const Frame& F, int r) { return (bf16_t*)(F.ws + WS_HS5L) + (size_t)r * DM; }
__device__ __forceinline__ f32x4 bf4_to_f32(u32x2 w) { return (f32x4){bflo(w.x), bfhi(w.x), bflo(w.y), bfhi(w.y)}; }
__device__ __forceinline__ u32x2 f32_to_bf4(f32x4 v) { u32x2 w; w.x = cvt_pk_bf16(v.x, v.y); w.y = cvt_pk_bf16(v.z, v.w); return w; }
__device__ __forceinline__ const float* inrow_ptr(const Frame& F, int r) { return r < NCTX ? F.in[I_CTX] + (size_t)r * DM : F.in[I_X] + (size_t)(r - NCTX) * DM; }
__device__ __forceinline__ const float* modv(const Frame& F, int layer, int mi, int chunk) { return (const float*)(F.ws + WS_MODV) + ((size_t)(layer * 5 + mi) * 6 + chunk) * DM; }
namespace ge {
constexpr int BM = 256, BK = 64, HALF = 128, HTB = HALF * BK * 2, STAGE_BYTES = 8 * HTB, NXCD = 8, WGM = 8;
__host__ __device__ __forceinline__ int lds_byte(int r, int c) { const int st = (r >> 4) * 2 + (c >> 5), rr = r & 15, cc = c & 31, ob = rr * 64 + cc * 2; return st * 1024 + (ob ^ (((ob >> 9) & 1) << 5)); }
__host__ __device__ __forceinline__ void stage_rc(int b, int& R, int& C) { const int st = b / 1024, sb = b % 1024, swz = sb ^ (((sb >> 9) & 1) << 5); R = (st >> 1) * 16 + swz / 64; C = (st & 1) * 32 + (swz % 64) / 2; }

struct GUnit { const char* A; const char* B; const i32x2* rows; int pm, pn, aux, nvalid; };

struct StaticOrder {
    __device__ __forceinline__ const i32x2* dummy() const { return nullptr; }
    int nM, nN, nwg, G, c, base = 0, lim = 0x7fffffff; const char* A0; const char* B0; size_t tstepA, tstepB;
    __device__ void init(int nM_, int nN_, int G_, int c_, const void* A, size_t tsA, const void* B, size_t tsB) { nM = nM_; nN = nN_; nwg = nM * nN; G = G_; c = c_; A0 = (const char*)A; B0 = (const char*)B; tstepA = tsA; tstepB = tsB; }
    __device__ bool next(int i, GUnit& u) const {
        const long L = (long)base + (long)i * G + c; if (L >= nwg || L >= lim) return false;
        int wgid = (int)L; { const int q = nwg / NXCD, r = nwg % NXCD, xcd = wgid % NXCD, off = wgid / NXCD; wgid = (xcd < r ? xcd * (q + 1) : r * (q + 1) + (xcd - r) * q) + off; }
        const int nig = WGM * nN, gid = wgid / nig, fm = gid * WGM, gsz = (nM - fm) < WGM ? (nM - fm) : WGM;
        u.pm = fm + ((wgid % nig) % gsz); u.pn = (wgid % nig) / gsz; u.aux = 0; u.nvalid = 256; u.rows = nullptr;
        u.A = A0 + (size_t)u.pm * tstepA; u.B = B0 + (size_t)u.pn * tstepB; return true;
    }
};
__host__ __device__ __forceinline__ int perm32(int rho) { const int n = rho >> 4, i = rho & 15; return 8 * (i >> 2) + 4 * n + (i & 3); }
struct AMapPlain { unsigned lda2; __device__ __forceinline__ unsigned operator()(int R, int C) const { return (unsigned)R * lda2 + (unsigned)C * 2u; } };

template <class Epi, class Sched, class AMap, int GM, bool F8 = false>
__device__ __forceinline__ void gemm_run(LAS unsigned char* lds, const LAS int* rowl, const int nt, const unsigned ldb2, const unsigned hstepA, const size_t kstepA,
                                         const AMap amap, const unsigned lda2g, const Sched& S, const Epi& E, const int sw = 0x7f7f7f7f, const int sa = 0x7f7f7f7f) {
    int tid_ = threadIdx.x; asm volatile("" : "+v"(tid_));
    const int tid = tid_, wid = __builtin_amdgcn_readfirstlane(tid >> 6), lane = tid & 63, wr = wid >> 2, wc = wid & 3, fr = lane & 15, fq = lane >> 4;
    constexpr bool GATHER = GM != 0;
    unsigned voffA = 0, voffB, voffG[2][2] = {{0u, 0u}, {0u, 0u}}, nvoffG[2][2] = {{0u, 0u}, {0u, 0u}};
    int R0, C0; stage_rc(tid * 16, R0, C0);
    voffB = (unsigned)(Epi::PERM ? ((R0 & ~31) + perm32(R0 & 31)) : R0) * ldb2 + (unsigned)C0 * 2u;
    if (GM == 1) {
#pragma unroll
        for (int i = 0; i < 2; ++i) { voffG[0][i] = (unsigned)(rowl[R0 + 64 * i] >> 3) * lda2g + (unsigned)C0 * 2u; voffG[1][i] = (unsigned)(rowl[128 + R0 + 64 * i] >> 3) * lda2g + (unsigned)C0 * 2u; }
    } else if (GM == 0) voffA = amap(R0, C0);
    const unsigned qstepA = hstepA >> 1, qstepB = 64u * ldb2;
#define GE_ROWOFF(dst, U) do { int _t = threadIdx.x; asm volatile("" : "+v"(_t)); int _R, _C; stage_rc((_t & 511) * 16, _R, _C); \
        const bool _id = (U).rows == nullptr; const i32x2* _lp = _id ? (const i32x2*)S.dummy() : (U).rows; const int _nv = _id ? 256 : (U).nvalid; int _e[2][2]; \
        _Pragma("unroll") for (int _h = 0; _h < 2; ++_h) _Pragma("unroll") for (int _i = 0; _i < 2; ++_i) { const int _r = _h * 128 + _R + 64 * _i; _e[_h][_i] = _lp[_r < _nv ? _r : _nv - 1].x; } \
        _Pragma("unroll") for (int _h = 0; _h < 2; ++_h) _Pragma("unroll") for (int _i = 0; _i < 2; ++_i) { const int _r = _h * 128 + _R + 64 * _i; \
            const int _row = _id ? (U).aux + _r : (_e[_h][_i] >> 3); dst[_h][_i] = (unsigned)_row * lda2g + (unsigned)_C * 2u; } } while (0)
    const size_t kstepB = (size_t)(BK * 2);
    const unsigned hstepB = (unsigned)HALF * ldb2;
    const unsigned ldsw = (unsigned)wid * 1024u;
    const int aoff = lds_byte(wr * 64 + fr, F8 ? fq * 16 : fq * 8), boff = lds_byte(wc * 32 + fr, F8 ? fq * 16 : fq * 8);
    constexpr int KOFF = F8 ? 16 : 1024;
#define GE_SA(b, h) (((b) * 2 + (h)) * ge::HTB)
#define GE_SB(b, h) ((4 + (b) * 2 + (h)) * ge::HTB)
#define GE_STAGEB(bufoff, gbase) do { _Pragma("unroll") for (int _i = 0; _i < 2; ++_i) \
        __builtin_amdgcn_global_load_lds((const unsigned*)((const char*)(gbase) + (size_t)(_i * qstepB) + voffB), (LAS unsigned*)(lds + (bufoff) + ldsw + _i * 8192), 16, 0, 0); } while (0)
#define GE_STAGEA(bufoff, gbase, h, NX) do { _Pragma("unroll") for (int _i = 0; _i < 2; ++_i) { \
        const char* _p = GATHER ? (const char*)(gbase) + ((GM == 2 && (NX)) ? nvoffG[h][_i] : voffG[h][_i]) : (const char*)(gbase) + (size_t)((h) * hstepA + _i * qstepA) + voffA; \
        __builtin_amdgcn_global_load_lds((const unsigned*)_p, (LAS unsigned*)(lds + (bufoff) + ldsw + _i * 8192), 16, 0, 0); } } while (0)
#define GE_LDA(dst, b, h) do { _Pragma("unroll") for (int m = 0; m < 4; ++m) _Pragma("unroll") for (int k = 0; k < 2; ++k) dst[m][k] = *(const LAS bf16x8*)(lds + GE_SA(b, h) + aoff + m * 2048 + k * KOFF); } while (0)
#define GE_LDB(dst, b, h) do { _Pragma("unroll") for (int n = 0; n < 2; ++n) _Pragma("unroll") for (int k = 0; k < 2; ++k) dst[n][k] = *(const LAS bf16x8*)(lds + GE_SB(b, h) + boff + n * 2048 + k * KOFF); } while (0)
#define GE_MMA(ai, bj, At, Bt) do { __builtin_amdgcn_s_setprio(1); _Pragma("unroll") for (int m = 0; m < 4; ++m) _Pragma("unroll") for (int n = 0; n < 2; ++n) { \
        if constexpr (F8) { i32x8 _w, _x; { const bf16x8 _w0 = Bt[n][0], _w1 = Bt[n][1], _x0 = At[m][0], _x1 = At[m][1]; \
                const u32x4 _a = *reinterpret_cast<const u32x4*>(&_w0), _b = *reinterpret_cast<const u32x4*>(&_w1), _c = *reinterpret_cast<const u32x4*>(&_x0), _d = *reinterpret_cast<const u32x4*>(&_x1); \
                _w = (i32x8){(int)_a.x, (int)_a.y, (int)_a.z, (int)_a.w, (int)_b.x, (int)_b.y, (int)_b.z, (int)_b.w}; _x = (i32x8){(int)_c.x, (int)_c.y, (int)_c.z, (int)_c.w, (int)_d.x, (int)_d.y, (int)_d.z, (int)_d.w}; } \
              \
            asm volatile("v_mfma_scale_f32_16x16x128_f8f6f4 %0, %1, %2, %0, %3, %4 op_sel_hi:[0,0,0]" : "+v"(acc[ai][bj][m][n]) : "v"(_w), "v"(_x), "v"(sw), "v"(sa)); } \
        else { _Pragma("unroll") for (int k = 0; k < 2; ++k) acc[ai][bj][m][n] = __builtin_amdgcn_mfma_f32_16x16x32_bf16(Bt[n][k], At[m][k], acc[ai][bj][m][n], 0, 0, 0); } } \
        __builtin_amdgcn_s_setprio(0); } while (0)
#define GE_WAIT_V(n) asm volatile("s_waitcnt vmcnt(" #n ")" ::: "memory")
#define GE_WAIT_L(n) asm volatile("s_waitcnt lgkmcnt(" #n ")" ::: "memory")
#define GE_BAR __builtin_amdgcn_s_barrier()
#define GE_SCHED __builtin_amdgcn_sched_barrier(0)
    GUnit cur, nxt; int ui = 0;
    if (!S.next(0, cur)) return;
    f32x4 acc[2][2][4][2];
#pragma unroll
    for (int a = 0; a < 2; ++a)
#pragma unroll
        for (int b = 0; b < 2; ++b)
#pragma unroll
            for (int m = 0; m < 4; ++m)
#pragma unroll
                for (int n = 0; n < 2; ++n) acc[a][b][m][n] = (f32x4){0.f, 0.f, 0.f, 0.f};
    bf16x8 At[4][2], B0[2][2], B1[2][2];
    const char* cA = cur.A; const char* cB = cur.B;
    if (GM == 2) GE_ROWOFF(voffG, cur);
    GE_STAGEB(GE_SB(0, 0), cB); GE_STAGEB(GE_SB(0, 1), cB + hstepB); GE_STAGEA(GE_SA(0, 0), cA, 0, false); GE_STAGEA(GE_SA(0, 1), cA, 1, false);
    if (wr == 1) GE_BAR;
    GE_WAIT_V(2); GE_BAR;
    GE_STAGEB(GE_SB(1, 0), cB + kstepB); GE_STAGEA(GE_SA(1, 0), cA + kstepA, 0, false); GE_STAGEB(GE_SB(1, 1), cB + hstepB + kstepB);
    GE_WAIT_V(6); GE_BAR;
    for (;;) {
        const bool has_next = S.next(ui + 1, nxt);
        typename Epi::Pre pre = E.prefetch(cur, wr, fr);
        const char* nA = has_next ? nxt.A : cA; const char* nB = has_next ? nxt.B : cB;
        if (GM == 2) { if (has_next && nxt.pn == 0) GE_ROWOFF(nvoffG, nxt); else { _Pragma("unroll") for (int _h = 0; _h < 2; ++_h) _Pragma("unroll") for (int _i = 0; _i < 2; ++_i) nvoffG[_h][_i] = voffG[_h][_i]; } }
#pragma unroll 1
        for (int t = 0; t < nt; t += 2) {
            const bool last = (t == nt - 2);
            const char* a1 = cA + (size_t)(t + 1) * kstepA;
            const char* a2 = last ? nA : cA + (size_t)(t + 2) * kstepA; const char* b2 = last ? nB : cB + (size_t)(t + 2) * kstepB;
            const char* a3 = a2 + kstepA; const char* b3 = b2 + kstepB;
            GE_LDB(B0, 0, 0); GE_LDB(B1, 0, 1); GE_SCHED; GE_LDA(At, 0, 0); GE_STAGEA(GE_SA(1, 1), a1, 1, false);
            GE_WAIT_V(8); GE_WAIT_L(0); GE_BAR; GE_MMA(0, 0, At, B0); GE_MMA(0, 1, At, B1); GE_BAR; GE_SCHED;
            GE_LDA(At, 0, 1); GE_STAGEB(GE_SB(0, 0), b2); GE_STAGEB(GE_SB(0, 1), b2 + hstepB); GE_STAGEA(GE_SA(0, 0), a2, 0, last);
            GE_WAIT_V(8); GE_WAIT_L(0); GE_BAR; GE_MMA(1, 0, At, B0); GE_MMA(1, 1, At, B1); GE_BAR; GE_SCHED;
            GE_LDB(B0, 1, 0); GE_LDB(B1, 1, 1); GE_SCHED; GE_LDA(At, 1, 0); GE_STAGEA(GE_SA(0, 1), a2, 1, last);
            GE_WAIT_V(8); GE_WAIT_L(0); GE_BAR; GE_MMA(0, 0, At, B0); GE_MMA(0, 1, At, B1); GE_BAR; GE_SCHED;
            GE_LDA(At, 1, 1); GE_STAGEB(GE_SB(1, 0), b3); GE_STAGEB(GE_SB(1, 1), b3 + hstepB); GE_STAGEA(GE_SA(1, 0), a3, 0, last);
            GE_WAIT_V(8); GE_WAIT_L(0); GE_BAR; GE_MMA(1, 0, At, B0); GE_MMA(1, 1, At, B1); GE_BAR; GE_SCHED;
        }
        if constexpr (F8) asm volatile("s_nop 15\n\ts_nop 15" ::: "memory");
        if (wr == 0) GE_BAR;
        E(acc, cur, wr, wc, fr, fq, pre);
        if (!has_next) break;
#pragma unroll
        for (int a = 0; a < 2; ++a)
#pragma unroll
            for (int b = 0; b < 2; ++b)
#pragma unroll
                for (int m = 0; m < 4; ++m)
#pragma unroll
                    for (int n = 0; n < 2; ++n) acc[a][b][m][n] = (f32x4){0.f, 0.f, 0.f, 0.f};
        cur = nxt; cA = nA; cB = nB; ++ui;
        if (GM == 2) { _Pragma("unroll") for (int _h = 0; _h < 2; ++_h) _Pragma("unroll") for (int _i = 0; _i < 2; ++_i) voffG[_h][_i] = nvoffG[_h][_i]; }
        if (wr == 1) GE_BAR;
    }
    GE_WAIT_V(0);
    GE_BAR;
#undef GE_ROWOFF
#undef GE_SA
#undef GE_SB
#undef GE_STAGEA
#undef GE_STAGEB
#undef GE_LDA
#undef GE_LDB
#undef GE_MMA
#undef GE_WAIT_V
#undef GE_WAIT_L
#undef GE_BAR
#undef GE_SCHED
}
}
__device__ __forceinline__ int tr_dstrow(int n, int kind, int second) {
    if (kind == 1) { if (n < 1024 || n >= 2048) return n; const int tile = n & ~255, wi = n & 255, g = wi >> 6, d = wi & 63; return tile + 128 * (d >> 5) + 32 * g + 8 * ((d >> 2) & 3) + 4 * ((d >> 4) & 1) + (d & 3); }
    if (kind == 2) return (n >> 7) * 256 + (n & 127) + second * 128;
    return n;
}
__device__ __forceinline__ void tr_item(const float* W, int ldw, int K, bf16_t* WT, int kb, int nb, int kind, int second, LAS float* scr, int lane) {
    const int k0 = 64 * kb, n0 = 32 * nb;
#pragma unroll 8
    for (int i = 0; i < 32; ++i) { const int kk = 2 * i + (lane >> 5); scr[kk * 33 + (lane & 31)] = W[(size_t)(k0 + kk) * ldw + n0 + (lane & 31)]; }
    asm volatile("s_waitcnt lgkmcnt(0)" ::: "memory");
    const int c = lane & 7;
#pragma unroll
    for (int j = 0; j < 4; ++j) { const int n = (lane >> 3) + 8 * j; const LAS float* s = scr + (8 * c) * 33 + n;
        u32x4 o; o.x = cvt_pk_bf16(s[0 * 33], s[1 * 33]); o.y = cvt_pk_bf16(s[2 * 33], s[3 * 33]); o.z = cvt_pk_bf16(s[4 * 33], s[5 * 33]); o.w = cvt_pk_bf16(s[6 * 33], s[7 * 33]);
        *(u32x4*)(WT + (size_t)tr_dstrow(n0 + n, kind, second) * K + k0 + 8 * c) = o; }
    asm volatile("s_waitcnt lgkmcnt(0)" ::: "memory");
}
__device__ __forceinline__ void tr_item8(const float* W, int ldw, int K, unsigned char* WT, int kb, int nb, int kind, int second, float scale, LAS float* scr, int lane) {
    const int k0 = 64 * kb, n0 = 32 * nb;
#pragma unroll 8
    for (int i = 0; i < 32; ++i) { const int kk = 2 * i + (lane >> 5); scr[kk * 33 + (lane & 31)] = W[(size_t)(k0 + kk) * ldw + n0 + (lane & 31)] * scale; }
    asm volatile("s_waitcnt lgkmcnt(0)" ::: "memory");
    const int c = lane & 7;
#pragma unroll
    for (int j = 0; j < 4; ++j) { const int n = (lane >> 3) + 8 * j; const LAS float* s = scr + (8 * c) * 33 + n;
        u32x2 o; o.x = pk4_fp8(s[0 * 33], s[1 * 33], s[2 * 33], s[3 * 33]); o.y = pk4_fp8(s[4 * 33], s[5 * 33], s[6 * 33], s[7 * 33]);
        *(u32x2*)(WT + (size_t)tr_dstrow(n0 + n, kind, second) * K + k0 + 8 * c) = o; }
    asm volatile("s_waitcnt lgkmcnt(0)" ::: "memory");
}
__device__ __forceinline__ void conv_expert_item(Frame& F, int layer, int it, LAS float* scr) {
    const int e = it / 384, r = it % 384;
    unsigned char* wgu = F.ws + WS_EXP + (size_t)e * EXP_STRIDE; unsigned char* wd = F.ws + WS_EXP + (size_t)e * EXP_STRIDE + EXP_WD;
    const float *g, *u, *d;
    if (e < 64) { g = F.in[I_EWG] + ((size_t)layer * 64 + e) * 262144; u = F.in[I_EWU] + ((size_t)layer * 64 + e) * 262144; d = F.in[I_EWD] + ((size_t)layer * 64 + e) * 262144; }
    else { g = F.in[I_SWG] + (size_t)layer * 262144; u = F.in[I_SWU] + (size_t)layer * 262144; d = F.in[I_SWD] + (size_t)layer * 262144; }
    if (r < 128) tr_item8(g, 256, 1024, wgu, r / 8, r % 8, 2, 0, 64.f, scr, F.lane);
    else if (r < 256) tr_item8(u, 256, 1024, wgu, (r - 128) / 8, (r - 128) % 8, 2, 1, 64.f, scr, F.lane);
    else tr_item8(d, 1024, 256, wd, (r - 256) / 32, (r - 256) % 32, 0, 0, 32.f, scr, F.lane);
}
__device__ __forceinline__ void p0_prologue(Frame& F) {
    LAS float* sil = (LAS float*)(F.lds);
    for (int i = F.tid; i < 5 * 1024; i += NTHREADS) { const float v = i < 4096 ? F.in[I_C][i] : F.in[I_CCTX][i - 4096]; sil[i] = siluf_(v); }
    __syncthreads();
    LAS float* scr = (LAS float*)(F.lds + 32768 + F.wave * 8704);
    const int gw = F.bid * NWAVES + F.wave, NGW = F.G * NWAVES;
    constexpr int I_MOD = 2 * 96 * 8, I_WINI = 16 * 80, I_WOUTI = 16 * 32, I_GLUI = 16 * 32, I_EXPI = 65 * 384;
    constexpr int NITEMS = I_MOD + I_WINI + I_WOUTI + 2 * I_GLUI + I_EXPI;
    for (int it = gw; it < NITEMS; it += NGW) {
        int r = it;
        if (r < I_MOD) {
            const int kp = r & 7, rr = r >> 3, l = rr / 96, n = (rr % 96) * 64 + F.lane; const float* W = F.in[I_MODW] + ((size_t)l * 1024 + kp * 128) * 6144 + n;
            const LAS float* sl = sil + kp * 128;
            float a0 = 0.f, a1 = 0.f, a2 = 0.f, a3 = 0.f, a4 = 0.f;
#pragma unroll 16
            for (int k = 0; k < 128; ++k) { const float w = W[(size_t)k * 6144]; a0 += sl[k] * w; a1 += sl[1024 + k] * w; a2 += sl[2048 + k] * w; a3 += sl[3072 + k] * w; a4 += sl[4096 + k] * w; }
            float* mp = (float*)(F.ws + WS_BIG + BG_MODP) + ((size_t)kp * 2 + l) * 5 * 6144 + n;
            mp[0] = a0; mp[6144] = a1; mp[2 * 6144] = a2; mp[3 * 6144] = a3; mp[4 * 6144] = a4;
            continue; }
        r -= I_MOD;
        if (r < I_WINI) {
            if (r % 80 < 32) tr_item(F.in[I_WIN], 2560, 1024, (bf16_t*)(F.ws + WS_WIN), r / 80, r % 80, 1, 0, scr, F.lane);
            else tr_item8(F.in[I_WIN], 2560, 1024, F.ws + WS_WIN8 - (size_t)1024 * 1024, r / 80, r % 80, 1, 0, 64.f, scr, F.lane);
            continue; } r -= I_WINI;
        if (r < I_WOUTI) { tr_item(F.in[I_WOUT], 1024, 1024, (bf16_t*)(F.ws + WS_WOUT), r / 32, r % 32, 0, 0, scr, F.lane); continue; } r -= I_WOUTI;
        if (r < I_GLUI) { tr_item8(F.in[I_GLUW], 2048, 1024, F.ws + WS_GLU, r / 32, r % 32, 2, 0, 32.f, scr, F.lane); continue; } r -= I_GLUI;
        if (r < I_GLUI) { tr_item8(F.in[I_GLUW] + 1024, 2048, 1024, F.ws + WS_GLU, r / 32, r % 32, 2, 1, 32.f, scr, F.lane); continue; } r -= I_GLUI;
        conv_expert_item(F, 0, r, scr);
    }
    const int gt = F.bid * NTHREADS + F.tid, NGT = F.G * NTHREADS;
    float* rope = (float*)(F.ws + WS_ROPE);
    for (int i = gt; i < 192 * 16; i += NGT) {
        const int p = i >> 4, f = i & 15; const int pos = p < 128 ? p : p - 128;
        const float inv = powf(10000.0f, -(float)f / 16.0f); const float ang = (float)pos * inv; float s, c; sincosf(ang, &s, &c);
        if (p < 128) { rope[p * 16 + f] = c; rope[2048 + p * 16 + f] = s; } else { rope[4096 + (p - 128) * 16 + f] = c; rope[4096 + 1024 + (p - 128) * 16 + f] = s; }
    }
    bf16_t* lw = (bf16_t*)(F.ws + WS_LRUW);
    for (int i = gt; i < 2 * 2 * 8 * 64 * 64; i += NGT) {
        const int dd = i & 63, e = (i >> 6) & 63, n = (i >> 12) & 7, d = (i >> 15) & 1, type = i >> 16;
        const float* src = type ? F.in[I_LIW] : F.in[I_LRW];
        lw[i] = f2bf(src[((size_t)(d * 8 + n) * 64 + dd) * 64 + e]);
    }
    bf16_t* wrt = (bf16_t*)(F.ws + WS_WRT);
    for (int i = gt; i < 2 * 64 * 1024; i += NGT) {
        const int k = i & 1023, e = (i >> 10) & 63, l = i >> 16; const float w = F.in[I_RW][((size_t)l * 1024 + k) * 64 + e];
        const bf16_t h = f2bf(w); wrt[(size_t)(l * 2 + 0) * 65536 + e * 1024 + k] = h; wrt[(size_t)(l * 2 + 1) * 65536 + e * 1024 + k] = f2bf(w - bf2f(h)); }
    float* sp = (float*)(F.ws + WS_LRUSP);
    for (int i = gt; i < 1024; i += NGT) { const float lam = F.in[I_LLAM][i]; sp[i] = 8.0f * log1pf(expf(-lam)); }
}

__device__ __forceinline__ void p1_norm1(Frame& F) {
    const int gw = F.bid * NWAVES + F.wave, NGW = F.G * NWAVES;
    const float* mp = (const float*)(F.ws + WS_BIG + BG_MODP);
    { float* mv = (float*)(F.ws + WS_MODV);
      for (int i = F.bid * NTHREADS + F.tid; i < 2 * 5 * 6144; i += F.G * NTHREADS) { const int l = i / (5 * 6144), n = i % 6144; float s = F.in[I_MODB][l * 6144 + n];
#pragma unroll
          for (int kp = 0; kp < 8; ++kp) s += mp[(size_t)kp * 2 * 5 * 6144 + i];
          mv[i] = s; } }
    LAS float* lm = (LAS float*)F.lds;
    for (int i = F.tid; i < 5 * 2048; i += NTHREADS) { const int mi = i >> 11, n = i & 2047; float s = F.in[I_MODB][n];
#pragma unroll
        for (int kp = 0; kp < 8; ++kp) s += mp[((size_t)kp * 2 * 5 + mi) * 6144 + n];
        lm[i] = s; }
    __syncthreads();
    bf16_t* H0 = (bf16_t*)(F.ws + WS_ACT);
    const f32x4* gn = (const f32x4*)(F.in[I_N1G]) + F.lane;
    for (int r = gw; r < NROW; r += NGW) {
        const f32x4* xr = (const f32x4*)inrow_ptr(F, r) + F.lane; const int mi = row_mi(r);
        const LAS f32x4* sh = (const LAS f32x4*)(lm + mi * 2048) + F.lane; const LAS f32x4* sc = (const LAS f32x4*)(lm + mi * 2048 + 1024) + F.lane;
        f32x4 v[4]; float s = 0.f;
#pragma unroll
        for (int j = 0; j < 4; ++j) { v[j] = xr[64 * j]; s += (v[j].x * v[j].x + v[j].y * v[j].y) + (v[j].z * v[j].z + v[j].w * v[j].w); }
        const float rstd = rsqrtf(wave_sum(s) * (1.f / DM) + EPS);
        u32x2* o = (u32x2*)(H0 + (size_t)r * DM) + F.lane; unsigned* o8 = (unsigned*)(F.ws + WS_SCR + (size_t)r * DM) + F.lane;
#pragma unroll
        for (int j = 0; j < 4; ++j) { const f32x4 g = gn[64 * j], a = sc[64 * j], b = sh[64 * j];
            const f32x4 y = (v[j] * rstd) * g * (a + 1.0f) + b; u32x2 w; w.x = cvt_pk_bf16(y.x, y.y); w.y = cvt_pk_bf16(y.z, y.w); o[64 * j] = w; o8[64 * j] = pk4_fp8(8.f * y.x, 8.f * y.y, 8.f * y.z, 8.f * y.w); }
    }
}
#define EPI_LOOP_AM _Pragma("unroll") for (int ai = 0; ai < 2; ++ai) _Pragma("unroll") for (int m = 0; m < 4; ++m)
#define EPI_LOOP_BN _Pragma("unroll") for (int bj = 0; bj < 2; ++bj) _Pragma("unroll") for (int n = 0; n < 2; ++n)
typedef f32x4 acc_t[2][2][4][2];
struct NoPre {};
#define EPI_NOPRE using Pre = NoPre; __device__ __forceinline__ NoPre prefetch(const ge::GUnit&, int, int) const { return NoPre{}; }

struct EpiG1 {
    EPI_NOPRE
    static constexpr bool PERM = true;
    unsigned char* ws; const float* qg; const float* kg; int pnoff;
    __device__ __forceinline__ void operator()(const acc_t& acc, const ge::GUnit& u, int wr, int wc, int fr, int fq, const Pre& pre) const {
        const int pn = u.pn + pnoff, row0 = u.pm * 256 + wr * 64 + fr;
        if (pn >= 8) {
            unsigned char* vt = ws + WS_BIG + BG_V + ((size_t)(u.pm * 4 + wr) * 512 + (pn & 1) * 256 + wc * 32 + 8 * fq) * 64 + 4 * fr;
#pragma unroll
            for (int ai = 0; ai < 2; ++ai)
#pragma unroll
                for (int bj = 0; bj < 2; ++bj)
#pragma unroll
                    for (int n = 0; n < 2; ++n)
#pragma unroll
                        for (int i = 0; i < 4; ++i)
                            *(unsigned*)(vt + ((size_t)ai * 1024 + bj * 128 + n * 4 + i) * 64) =
                                pk4_fp8(acc[ai][bj][0][n][i] * 8.f, acc[ai][bj][1][n][i] * 8.f, acc[ai][bj][2][n][i] * 8.f, acc[ai][bj][3][n][i] * 8.f);
            return;
        }
        if (pn < 4) {
            bf16_t* dst = (bf16_t*)(ws + WS_BIG + (pn < 2 ? BG_GATE : BG_XA)); const int colb = (pn & 1) * 256 + wc * 32 + 8 * fq; const bool isg = pn < 2;
            EPI_LOOP_AM { bf16_t* rp = dst + (size_t)(row0 + ai * 128 + m * 16) * 512 + colb;
#pragma unroll
                for (int bj = 0; bj < 2; ++bj) { f32x4 v = acc[ai][bj][m][0], v2 = acc[ai][bj][m][1];
                    if (isg) { v.x = gelu_tanh(v.x); v.y = gelu_tanh(v.y); v.z = gelu_tanh(v.z); v.w = gelu_tanh(v.w); v2.x = gelu_tanh(v2.x); v2.y = gelu_tanh(v2.y); v2.z = gelu_tanh(v2.z); v2.w = gelu_tanh(v2.w); }
                    u32x4 w; w.x = cvt_pk_bf16(v.x, v.y); w.y = cvt_pk_bf16(v.z, v.w); w.z = cvt_pk_bf16(v2.x, v2.y); w.w = cvt_pk_bf16(v2.z, v2.w); *(u32x4*)(rp + bj * 128) = w; } }
            return;
        }
        const bool isk = pn >= 6; const float* gv = isk ? kg : qg;
        unsigned char* dst = ws + WS_BIG + (isk ? BG_K : BG_Q); const int colb = (2 * (pn & 1) + (wc >> 1)) * 128 + (wc & 1) * 64 + 4 * fq;
        const float qs = isk ? 8.0f : 16.f * 0.18033688011112042f;
        f32x4 g4[2][2];
        EPI_LOOP_BN g4[bj][n] = *(const f32x4*)(gv + 32 * bj + 16 * n + 4 * fq);
        const float* rope = (const float*)(ws + WS_ROPE);
        const bool lat = u.pm >= 4;
        EPI_LOOP_AM {
            const int row = row0 + ai * 128 + m * 16;
            float ss = 0.f;
            EPI_LOOP_BN { const f32x4 v = acc[ai][bj][m][n]; ss += (v.x * v.x + v.y * v.y) + (v.z * v.z + v.w * v.w); }
            ss += __shfl_xor(ss, 16); ss += __shfl_xor(ss, 32);
            const float rstd = rsqrtf(ss * (1.f / 64.f) + EPS) * qs;
            f32x4 y[2][2];
            EPI_LOOP_BN y[bj][n] = acc[ai][bj][m][n] * rstd * g4[bj][n];
            if (lat) {
                const int t = (row - NCTX) & (SEQ - 1); const int pr = t >> 6, pc = t & 63;
                const f32x4 c0 = *(const f32x4*)(rope + pr * 16 + 4 * fq), s0 = *(const f32x4*)(rope + 2048 + pr * 16 + 4 * fq);
                const f32x4 c1 = *(const f32x4*)(rope + 4096 + pc * 16 + 4 * fq), s1 = *(const f32x4*)(rope + 5120 + pc * 16 + 4 * fq);
                const f32x4 a0 = y[0][0] * c0 - y[0][1] * s0, b0 = y[0][1] * c0 + y[0][0] * s0;
                const f32x4 a1 = y[1][0] * c1 - y[1][1] * s1, b1 = y[1][1] * c1 + y[1][0] * s1;
                y[0][0] = a0; y[0][1] = b0; y[1][0] = a1; y[1][1] = b1;
            }
            unsigned char* rp = dst + (size_t)row * 512 + colb;
            EPI_LOOP_BN { const f32x4 v = y[bj][n]; *(unsigned*)(rp + 32 * bj + 16 * n) = pk4_fp8(v.x, v.y, v.z, v.w); }
        }
    }
};

struct EpiG2 {
    EPI_NOPRE
    static constexpr bool PERM = false;
    Frame F;
    __device__ __forceinline__ void operator()(const acc_t& acc, const ge::GUnit& u, int wr, int wc, int fr, int fq, const Pre& pre) const {
        const int row0 = u.pm * 256 + wr * 64 + fr, col0 = u.pn * 256 + wc * 32 + 4 * fq; const int mi = u.pm < 4 ? 4 : ((u.pm - 4) >> 5);
        const float* g1 = modv(F, 0, mi, 2) + col0;
        float* ssq = (float*)(F.ws + WS_BIG + BG_SSQ);
        f32x4 gg[2][2];
        EPI_LOOP_BN gg[bj][n] = *(const f32x4*)(g1 + bj * 128 + n * 16);
#pragma unroll
        for (int ai = 0; ai < 2; ++ai) {
            f32x4 xv[4][2][2];
#pragma unroll
            for (int m = 0; m < 4; ++m) { const float* xi = inrow_ptr(F, row0 + ai * 128 + m * 16) + col0;
                EPI_LOOP_BN xv[m][bj][n] = *(const f32x4*)(xi + bj * 128 + n * 16); }
            __builtin_amdgcn_sched_barrier(0);
#pragma unroll
            for (int m = 0; m < 4; ++m) { const int row = row0 + ai * 128 + m * 16; bf16_t* xo = xb0_ptr(F, row) + col0; float ss = 0.f;
                EPI_LOOP_BN { const f32x4 o = xv[m][bj][n] + gg[bj][n] * acc[ai][bj][m][n]; *(u32x2*)(xo + bj * 128 + n * 16) = f32_to_bf4(o);
                    ss += (o.x * o.x + o.y * o.y) + (o.z * o.z + o.w * o.w); }
                ss += __shfl_xor(ss, 16); ss += __shfl_xor(ss, 32);
                if (fq == 0) ssq[(size_t)row * 32 + u.pn * 4 + wc] = ss; }
        }
    }
};

struct EpiUp {
    EPI_NOPRE
    static constexpr bool PERM = true;
    unsigned char* hid;
    __device__ __forceinline__ void operator()(const acc_t& acc, const ge::GUnit& u, int wr, int wc, int fr, int fq, const Pre& pre) const {
        const int row0 = wr * 64 + fr, col0 = u.pn * 128 + wc * 32 + 8 * fq;
        unsigned char* base = hid + (size_t)u.pm * 65536;
        EPI_LOOP_AM { unsigned char* rp = base + (size_t)(row0 + ai * 128 + m * 16) * 256 + col0;
            const f32x4 g = acc[ai][0][m][0], up = acc[ai][1][m][0], g2 = acc[ai][0][m][1], up2 = acc[ai][1][m][1];
            u32x2 w; w.x = pk4_fp8(16.f * siluf_(g.x) * up.x, 16.f * siluf_(g.y) * up.y, 16.f * siluf_(g.z) * up.z, 16.f * siluf_(g.w) * up.w);
            w.y = pk4_fp8(16.f * siluf_(g2.x) * up2.x, 16.f * siluf_(g2.y) * up2.y, 16.f * siluf_(g2.z) * up2.z, 16.f * siluf_(g2.w) * up2.w); *(u32x2*)rp = w; }
    }
};
struct EpiDown {
    static constexpr bool PERM = true;
    struct Pre { i32x2 e[2][4]; };
    unsigned char* Y; int half_base;
    __device__ __forceinline__ Pre prefetch(const ge::GUnit& u, int wr, int fr) const {
        Pre p; const int row0 = wr * 64 + fr;
        EPI_LOOP_AM { const int rt = row0 + ai * 128 + m * 16;
            if (u.rows) p.e[ai][m] = u.rows[rt < u.nvalid ? rt : u.nvalid - 1]; else p.e[ai][m] = (i32x2){((u.aux + rt) << 3) | 6, 0x3f800000}; }
        return p; }
    __device__ __forceinline__ void operator()(const acc_t& acc, const ge::GUnit& u, int wr, int wc, int fr, int fq, const Pre& pre) const {
        const int row0 = wr * 64 + fr, col0 = u.pn * 256 + wc * 32 + 8 * fq;
        EPI_LOOP_AM { const int rt = row0 + ai * 128 + m * 16;
            if (rt < u.nvalid) { const int pk = pre.e[ai][m].x, mrow = pk >> 3, slot = pk & 7; const float gt = 32.f * __int_as_float(pre.e[ai][m].y);
                unsigned char* rp = Y + ((size_t)(mrow - half_base) * 7 + slot) * 1024 + col0;
#pragma unroll
                for (int bj = 0; bj < 2; ++bj) { const f32x4 v = acc[ai][bj][m][0] * gt, v2 = acc[ai][bj][m][1] * gt;
                    u32x2 w; w.x = pk4_fp8(v.x, v.y, v.z, v.w); w.y = pk4_fp8(v2.x, v2.y, v2.z, v2.w); *(u32x2*)(rp + bj * 128) = w; } } }
    }
};

struct EpiS5a {
    EPI_NOPRE
    static constexpr bool PERM = false;
    unsigned char* ws;
    __device__ __forceinline__ void operator()(const acc_t& acc, const ge::GUnit& u, int wr, int wc, int fr, int fq, const Pre& pre) const {
        const int g = u.aux, row0 = wr * 64 + fr, col0 = wc * 32 + 4 * fq; const bool isc = u.pm == 4;
        float* base = isc ? (float*)(ws + WS_BIG + BG_SLOCC) + (size_t)g * 32 * 256 : (float*)(ws + WS_BIG + BG_SLOCL) + ((size_t)g * 1024 + u.pm * 256) * 256;
        EPI_LOOP_AM { const int rt = row0 + ai * 128 + m * 16;
            if (!isc || rt < 32) { float* rp = base + (size_t)rt * 256 + col0;
                EPI_LOOP_BN *(f32x4*)(rp + bj * 128 + n * 16) = acc[ai][bj][m][n]; } }
    }
};
struct EpiS5b {
    EPI_NOPRE
    static constexpr bool PERM = true;
    unsigned char* ws;
    __device__ __forceinline__ void operator()(const acc_t& acc, const ge::GUnit& u, int wr, int wc, int fr, int fq, const Pre& pre) const {
        const int g = u.aux, row0 = u.pm * 256 + wr * 64 + fr, col0 = u.pn * 256 + wc * 32 + 8 * fq;
        unsigned char* base = ws + WS_BIG + BG_ZS5 + (size_t)g * 1024 * 512;
        EPI_LOOP_AM { unsigned char* rp = base + (size_t)(row0 + ai * 128 + m * 16) * 512 + col0;
#pragma unroll
            for (int bj = 0; bj < 2; ++bj) { const f32x4 v = acc[ai][bj][m][0], v2 = acc[ai][bj][m][1];
                u32x2 w; w.x = pk4_fp8(4.f * gelu_tanh(v.x), 4.f * gelu_tanh(v.y), 4.f * gelu_tanh(v.z), 4.f * gelu_tanh(v.w));
                w.y = pk4_fp8(4.f * gelu_tanh(v2.x), 4.f * gelu_tanh(v2.y), 4.f * gelu_tanh(v2.z), 4.f * gelu_tanh(v2.w)); *(u32x2*)(rp + bj * 128) = w; } }
    }
};
struct EpiGlu {
    EPI_NOPRE
    static constexpr bool PERM = false;
    Frame F;
    __device__ __forceinline__ void operator()(const acc_t& acc, const ge::GUnit& u, int wr, int wc, int fr, int fq, const Pre& pre) const {
        const int row0 = u.pm * 256 + wr * 64 + fr, col0 = u.pn * 128 + wc * 32 + 4 * fq; const int mi = u.pm >> 5;
        const float* g1 = modv(F, 1, mi, 2) + col0; const float* gb = F.in[I_GLUB] + col0;
        float* ssq = (float*)(F.ws + WS_BIG + BG_SSQ);
        f32x4 gg[2], bv[2], bg[2];
#pragma unroll
        for (int n = 0; n < 2; ++n) { gg[n] = *(const f32x4*)(g1 + n * 16); bv[n] = *(const f32x4*)(gb + n * 16); bg[n] = *(const f32x4*)(gb + 1024 + n * 16); }
        u32x2 xin[2][4][2];
        EPI_LOOP_AM { const bf16_t* xi = xb0_ptr(F, NCTX + row0 + ai * 128 + m * 16) + col0;
#pragma unroll
            for (int n = 0; n < 2; ++n) xin[ai][m][n] = *(const u32x2*)(xi + n * 16); }
        __builtin_amdgcn_sched_barrier(0);
        EPI_LOOP_AM { const int row = row0 + ai * 128 + m * 16; bf16_t* xo = xb1_ptr(F, row) + col0; float ss = 0.f;
#pragma unroll
            for (int n = 0; n < 2; ++n) { const f32x4 val = acc[ai][0][m][n] + bv[n], gt = acc[ai][1][m][n] + bg[n];
                f32x4 o; o.x = val.x * sigmoidf_(gt.x); o.y = val.y * sigmoidf_(gt.y); o.z = val.z * sigmoidf_(gt.z); o.w = val.w * sigmoidf_(gt.w);
                const f32x4 xn = bf4_to_f32(xin[ai][m][n]) + gg[n] * o; *(u32x2*)(xo + n * 16) = f32_to_bf4(xn); ss += (xn.x * xn.x + xn.y * xn.y) + (xn.z * xn.z + xn.w * xn.w); }
            ss += __shfl_xor(ss, 16); ss += __shfl_xor(ss, 32);
            if (fq == 0) ssq[(size_t)row * 32 + u.pn * 4 + wc] = ss; }
    }
};
constexpr int XCS = 520;
__device__ __forceinline__ void lru_consts(Frame& F) {
    LAS float* cst = (LAS float*)(F.lds + MISC_OFF + F.wave * 1536); const float* sp = (const float*)(F.ws + WS_LRUSP);
#pragma unroll
    for (int d = 0; d < 2; ++d) { const int ch = d * 512 + 64 * F.wave + F.lane; cst[(0 * 2 + d) * 64 + F.lane] = F.in[I_LRB][ch]; cst[(1 * 2 + d) * 64 + F.lane] = F.in[I_LIB][ch]; cst[(2 * 2 + d) * 64 + F.lane] = sp[ch]; }
    __syncthreads();
}
template <int CTRL, int RMASK> __device__ __forceinline__ float dpp_f(float old, float src) {
    return __int_as_float(__builtin_amdgcn_update_dpp(__float_as_int(old), __float_as_int(src), CTRL, RMASK, 0xf, false));
}
#define LRU_SCAN_STEP(CTRL, RM) do { _Pragma("unroll") for (int r = 0; r < 16; ++r) { const float a2 = dpp_f<CTRL, RM>(1.0f, av[r]), b2 = dpp_f<CTRL, RM>(0.0f, bv[r]); bv[r] = av[r] * b2 + bv[r]; av[r] = av[r] * a2; } } while (0)
template <bool FINAL>
__device__ __forceinline__ void lru_unit(Frame& F, int b, int cc) {
    const bool isctx = cc < 8;
    const int seg0 = isctx ? b * 256 : NCTX + b * 8192, segn = isctx ? 256 : 8192, t0 = isctx ? cc * 32 : (cc - 8) * 32;
    LAS bf16_t* xcl = (LAS bf16_t*)F.lds;
    {
        int tq = F.tid; asm volatile("" : "+v"(tq));
        const int tg = tq >> 6, c8 = (tq & 63) * 8; const float* cw = F.in[I_CONVW] + c8;
        const bf16_t* xa = (const bf16_t*)(F.ws + WS_BIG + BG_XA) + (size_t)seg0 * 512 + c8;
        u32x4 xin[7];
#pragma unroll
        for (int k = 0; k < 7; ++k) { const int tp = t0 + 4 * tg - 2 + k; xin[k] = (tp >= 0 && tp < segn) ? *(const u32x4*)(xa + (size_t)tp * 512) : (u32x4){0u, 0u, 0u, 0u}; }
        f32x4 w[4][2]; f32x4 cb[2];
#pragma unroll
        for (int k = 0; k < 4; ++k) { w[k][0] = *(const f32x4*)(cw + k * 512); w[k][1] = *(const f32x4*)(cw + k * 512 + 4); }
        cb[0] = *(const f32x4*)(F.in[I_CONVB] + c8); cb[1] = *(const f32x4*)(F.in[I_CONVB] + c8 + 4);
#pragma unroll
        for (int i = 0; i < 4; ++i) {
            f32x4 o0 = cb[0], o1 = cb[1];
#pragma unroll
            for (int k = 0; k < 4; ++k) { const u32x4 x = xin[i + k];
                o0 += w[k][0] * (f32x4){bflo(x.x), bfhi(x.x), bflo(x.y), bfhi(x.y)}; o1 += w[k][1] * (f32x4){bflo(x.z), bfhi(x.z), bflo(x.w), bfhi(x.w)}; }
            u32x4 ov; ov.x = cvt_pk_bf16(o0.x, o0.y); ov.y = cvt_pk_bf16(o0.z, o0.w); ov.z = cvt_pk_bf16(o1.x, o1.y); ov.w = cvt_pk_bf16(o1.z, o1.w);
            *(LAS u32x4*)(xcl + (4 * tg + i) * XCS + c8) = ov;
        }
    }
    __syncthreads();
    const int n = F.wave, r32 = F.lane & 31, hi = F.lane >> 5;
    const bf16_t* lw = (const bf16_t*)(F.ws + WS_LRUW);
    const LAS float* cst = (const LAS float*)(F.lds + MISC_OFF + n * 1536);
    const int row = seg0 + t0 + r32;
    const float* hin = (const float*)(F.ws + WS_BIG + BG_LHIN) + (size_t)(b * LRU_NCH + cc) * 2 * 512;
    f32x2* sm = (f32x2*)(F.ws + WS_BIG + BG_LSUM) + (size_t)(b * LRU_NCH + cc) * 2 * 512;
#pragma unroll
    for (int eb = 0; eb < 2; ++eb) {
        f32x16 ysum = {};
#pragma unroll
        for (int dd = 0; dd < 2; ++dd) {
            const int d = 1 - dd;
            const int tl = d ? 31 - r32 : r32;
            f32x16 av = {}, bv = {};
#pragma unroll
            for (int ks = 0; ks < 4; ++ks) {
                const bf16x8 xb = *(const LAS bf16x8*)(xcl + tl * XCS + 64 * n + 16 * ks + 8 * hi);
                const bf16x8 wr_ = *(const bf16x8*)(lw + ((size_t)((0 * 2 + d) * 8 + n) * 64 + 32 * eb + r32) * 64 + 16 * ks + 8 * hi);
                const bf16x8 wi_ = *(const bf16x8*)(lw + ((size_t)((1 * 2 + d) * 8 + n) * 64 + 32 * eb + r32) * 64 + 16 * ks + 8 * hi);
                av = __builtin_amdgcn_mfma_f32_32x32x16_bf16(wr_, xb, av, 0, 0, 0);
                bv = __builtin_amdgcn_mfma_f32_32x32x16_bf16(wi_, xb, bv, 0, 0, 0);
            }
#pragma unroll
            for (int r = 0; r < 16; ++r) {
                const int cl = 32 * eb + crow(r, hi);
                const float rg = sigmoidf_(av[r] + cst[(0 * 2 + d) * 64 + cl]), ig = sigmoidf_(bv[r] + cst[(1 * 2 + d) * 64 + cl]);
                const float la = -rg * cst[(2 * 2 + d) * 64 + cl]; const float a = __expf(la);
                const float x = bf2f(xcl[tl * XCS + 64 * n + cl]);
                av[r] = a; bv[r] = __builtin_amdgcn_sqrtf(fmaxf(fmaf(-a, a, 1.0f), 0.f)) * ig * x;
            }
            LRU_SCAN_STEP(0x111, 0xf); LRU_SCAN_STEP(0x112, 0xf); LRU_SCAN_STEP(0x114, 0xf); LRU_SCAN_STEP(0x118, 0xf); LRU_SCAN_STEP(0x142, 0xa);
            if constexpr (!FINAL) {
                if (r32 == 31) {
#pragma unroll
                    for (int r = 0; r < 16; ++r) sm[d * 512 + 64 * n + 32 * eb + crow(r, hi)] = (f32x2){av[r], bv[r]};
                }
            } else {
#pragma unroll
                for (int q = 0; q < 4; ++q) { const f32x4 hv = *(const f32x4*)(hin + d * 512 + 64 * n + 32 * eb + 8 * q + 4 * hi);
#pragma unroll
                    for (int i = 0; i < 4; ++i) { const float h = bv[4 * q + i] + av[4 * q + i] * hv[i];
                        if (d) ysum[4 * q + i] = __int_as_float(__builtin_amdgcn_ds_swizzle(__float_as_int(h), 0x7C1F));
                        else ysum[4 * q + i] += h; } }
            }
        }
        if constexpr (FINAL) {
            const bf16_t* gp = (const bf16_t*)(F.ws + WS_BIG + BG_GATE) + (size_t)row * 512; bf16_t* yo = (bf16_t*)(F.ws + WS_ACT) + (size_t)row * DM;
#pragma unroll
            for (int q = 0; q < 4; ++q) { const int ch0 = 64 * n + 32 * eb + 8 * q + 4 * hi; const u32x2 gw = *(const u32x2*)(gp + ch0);
                u32x2 w; w.x = cvt_pk_bf16(ysum[4 * q] * bflo(gw.x), ysum[4 * q + 1] * bfhi(gw.x)); w.y = cvt_pk_bf16(ysum[4 * q + 2] * bflo(gw.y), ysum[4 * q + 3] * bfhi(gw.y)); *(u32x2*)(yo + ch0) = w; }
        }
    }
    __syncthreads();
}
#undef LRU_SCAN_STEP
__device__ __forceinline__ void lru_carry(Frame& F) {
    for (int i = F.bid; i < 8; i += F.G) {
        const int b = i >> 1, d = i & 1, ch = F.tid;
        const f32x2* __restrict__ sm = (const f32x2*)(F.ws + WS_BIG + BG_LSUM) + (size_t)b * LRU_NCH * 1024 + d * 512 + ch;
        float* __restrict__ hin = (float*)(F.ws + WS_BIG + BG_LHIN) + (size_t)b * LRU_NCH * 1024 + d * 512 + ch;
        float h = 0.f;
#pragma unroll 1
        for (int k0 = 0; k0 < LRU_NCH; k0 += 24) {
            f32x2 st[24]; int cidx[24];
#pragma unroll
            for (int j = 0; j < 24; ++j) { const int k = k0 + j; const int cc = d == 0 ? k : (k < 8 ? 7 - k : LRU_NCH + 7 - k); cidx[j] = cc; st[j] = sm[(size_t)cc * 1024]; }
#pragma unroll
            for (int j = 0; j < 24; ++j) { hin[(size_t)cidx[j] * 1024] = h; h = st[j].x * h + st[j].y; }
        }
    }
}
namespace at {

#define AT_SBAR() __builtin_amdgcn_sched_barrier(0)
typedef __fp16 h16x2 __attribute__((ext_vector_type(2)));
__device__ __forceinline__ int pk4raw(float a, float b, float c, float d) {
    const h16x2 lo = __builtin_amdgcn_cvt_pkrtz(a, b), hi = __builtin_amdgcn_cvt_pkrtz(c, d);
    return (int)__builtin_amdgcn_perm(*reinterpret_cast<const unsigned*>(&hi), *reinterpret_cast<const unsigned*>(&lo), 0x07050301u);
}
__device__ __forceinline__ void exp_lo(f32x16& p0) {
#pragma unroll
    for (int r = 0; r < 16; ++r) p0[r] = __builtin_amdgcn_exp2f(p0[r]);
}
template <int ABL> __device__ __forceinline__ void finishSM(f32x16& p0, f32x16& p1, i32x8& pw) {
#pragma unroll
    for (int r = 0; r < 16; ++r) p1[r] = __builtin_amdgcn_exp2f(p1[r]);
#pragma unroll
    for (int a = 0; a < 4; ++a) { if (ABL == 4) { pw[a] = __float_as_int(p0[4 * a]) | __float_as_int(p0[4 * a + 2]); pw[4 + a] = __float_as_int(p1[4 * a + 1]) | __float_as_int(p1[4 * a + 3]); continue; }
        pw[a] = pk4raw(p0[4 * a], p0[4 * a + 1], p0[4 * a + 2], p0[4 * a + 3]); pw[4 + a] = pk4raw(p1[4 * a], p1[4 * a + 1], p1[4 * a + 2], p1[4 * a + 3]); }
}
__device__ __forceinline__ void qkt(f32x16& p0, f32x16& p1, const LAS char* Ks, const i32x8& qf, int o0, int o1) {
    const i32x4 a0 = *(const LAS i32x4*)(Ks + o0), a1 = *(const LAS i32x4*)(Ks + o1), b0 = *(const LAS i32x4*)(Ks + 2048 + o0), b1 = *(const LAS i32x4*)(Ks + 2048 + o1);
    const i32x8 k0 = {a0[0], a0[1], a0[2], a0[3], a1[0], a1[1], a1[2], a1[3]}, k1 = {b0[0], b0[1], b0[2], b0[3], b1[0], b1[1], b1[2], b1[3]};
    const f32x16 c = {};
    p0 = __builtin_amdgcn_mfma_scale_f32_32x32x64_f8f6f4(k0, qf, c, 0, 0, 0, 0x78787878, 0, 0x7f7f7f7f);
    p1 = __builtin_amdgcn_mfma_scale_f32_32x32x64_f8f6f4(k1, qf, c, 0, 0, 0, 0x78787878, 0, 0x7f7f7f7f);
}
__device__ __forceinline__ void pv_d0(f32x16* o, f32x16& la, const LAS char* Vs, const i32x8& pw, const i32x8& ones, int o0, int o1) {
#pragma unroll
    for (int d0 = 0; d0 < 4; ++d0) {
        const i32x4 a0 = *(const LAS i32x4*)(Vs + d0 * 2048 + o0), a1 = *(const LAS i32x4*)(Vs + d0 * 2048 + o1);
        const i32x8 vf = {a0[0], a0[1], a0[2], a0[3], a1[0], a1[1], a1[2], a1[3]};
        o[d0] = __builtin_amdgcn_mfma_scale_f32_32x32x64_f8f6f4(pw, vf, o[d0], 1, 0, 0, 0, 0, 0);
    }
    la = __builtin_amdgcn_mfma_scale_f32_32x32x64_f8f6f4(pw, ones, la, 1, 0, 0, 0, 0, 0);
}
__device__ __forceinline__ int krow(int b, int j) { return j < 4 ? b * 256 + 64 * j : NCTX + b * 8192 + 64 * (j - 4); }

constexpr int TILE_B = 12288, KOFF_B = 8192, NRING = 5, LI_OFF = NRING * TILE_B;
template <int ABL> __device__ __forceinline__ void attn_unit(Frame& F, int b, int h, int qrow0, int NT, float lam) {
    const int tid = F.tid, wid = F.wave, lane = F.lane, r32 = lane & 31, hi = lane >> 5;
    LAS char* lds = (LAS char*)F.lds;
    const char* Q = (const char*)(F.ws + WS_BIG + BG_Q); const char* K = (const char*)(F.ws + WS_BIG + BG_K); const char* V = (const char*)(F.ws + WS_BIG + BG_V);
    const int irow = wid * 16 + (lane >> 2), lch = ((lane & 3) ^ ((irow >> 2) & 3)) << 4;
    const unsigned voff = (unsigned)h * 8192u + (unsigned)irow * 64u + (unsigned)lch;
    unsigned koff;
    { const int rho = irow & 31, t = (irow >> 5) & 1, key = 16 * (rho & 3) + 8 * ((rho >> 2) & 1) + (rho >> 3) + 4 * t; koff = (unsigned)key * 512u + (unsigned)h * 128u + (unsigned)lch; }
    const int xo = (r32 >> 2) & 3, o0 = r32 * 64 + (((2 * hi) ^ xo) << 4), o1 = r32 * 64 + (((2 * hi + 1) ^ xo) << 4);
#define AT_WAITBAR(N) asm volatile("s_waitcnt vmcnt(" #N ")\n\ts_barrier" ::: "memory")
#define AT_ISSUE(j, LEAD) do { const int _k0 = krow(b, (j)); LAS char* _bf = lds + ((j) % NRING) * TILE_B; \
        __builtin_amdgcn_global_load_lds((const unsigned*)(V + (size_t)(_k0 >> 6) * 32768 + voff), (LAS unsigned*)(_bf + wid * 1024), 16, 0, 0); \
        if (LEAD) __builtin_amdgcn_global_load_lds((const unsigned*)(K + (size_t)_k0 * 512 + m * 64 + koff), (LAS unsigned*)(_bf + KOFF_B + wid * 1024), 16, 0, 0); } while (0)
#define AT_KB(j) (lds + ((j) % NRING) * TILE_B + KOFF_B)
#define AT_VB(j) (lds + ((j) % NRING) * TILE_B)
    i32x8 ones;
#pragma unroll
    for (int i = 0; i < 8; ++i) ones[i] = 0x38383838;
#pragma unroll 1
    for (int m = 0; m < 2; ++m) {
        f32x16 la = {}; f32x16 o[4] = {}; i32x8 qf;
        { const char* Qw = Q + (size_t)(qrow0 + wid * 32 + r32) * 512 + h * 128 + m * 64 + hi * 32;
          const i32x4 q0 = *(const i32x4*)Qw, q1 = *(const i32x4*)(Qw + 16); qf = (i32x8){q0[0], q0[1], q0[2], q0[3], q1[0], q1[1], q1[2], q1[3]}; }
        asm volatile("s_waitcnt vmcnt(0)" ::: "memory");
        f32x16 pA0, pA1, pB0, pB1; i32x8 pw;
        __syncthreads();
        if (wid < 4) {
            AT_ISSUE(0, true); AT_ISSUE(1, true);
            AT_WAITBAR(2); AT_ISSUE(2, true);
            qkt(pA0, pA1, AT_KB(0), qf, o0, o1); exp_lo(pA0);
            for (int j = 1; j + 1 < NT; j += 2) {
                AT_WAITBAR(2); AT_ISSUE(j + 2, true);
                AT_SBAR(); qkt(pB0, pB1, AT_KB(j), qf, o0, o1);
                finishSM<ABL>(pA0, pA1, pw); AT_SBAR();
                pv_d0(o, la, AT_VB(j - 1), pw, ones, o0, o1); exp_lo(pB0);
                AT_WAITBAR(2); if (j + 3 < NT) AT_ISSUE(j + 3, true);
                AT_SBAR(); qkt(pA0, pA1, AT_KB(j + 1), qf, o0, o1);
                finishSM<ABL>(pB0, pB1, pw); AT_SBAR();
                pv_d0(o, la, AT_VB(j), pw, ones, o0, o1); exp_lo(pA0);
            }
            AT_WAITBAR(0);
            AT_SBAR(); qkt(pB0, pB1, AT_KB(NT - 1), qf, o0, o1);
            finishSM<ABL>(pA0, pA1, pw); AT_SBAR();
            pv_d0(o, la, AT_VB(NT - 2), pw, ones, o0, o1); exp_lo(pB0);
            finishSM<ABL>(pB0, pB1, pw); AT_SBAR();
            pv_d0(o, la, AT_VB(NT - 1), pw, ones, o0, o1);
        } else {
            AT_ISSUE(0, false); AT_ISSUE(1, false);
            AT_WAITBAR(1); AT_ISSUE(2, false);
            qkt(pA0, pA1, AT_KB(0), qf, o0, o1);
            for (int j = 1; j + 1 < NT; j += 2) {
                AT_WAITBAR(1); AT_ISSUE(j + 2, false);
                AT_SBAR(); if (j >= 2) pv_d0(o, la, AT_VB(j - 2), pw, ones, o0, o1);
                exp_lo(pA0); AT_SBAR();
                qkt(pB0, pB1, AT_KB(j), qf, o0, o1);
                finishSM<ABL>(pA0, pA1, pw);
                AT_WAITBAR(1); if (j + 3 < NT) AT_ISSUE(j + 3, false);
                AT_SBAR(); pv_d0(o, la, AT_VB(j - 1), pw, ones, o0, o1);
                exp_lo(pB0); AT_SBAR();
                qkt(pA0, pA1, AT_KB(j + 1), qf, o0, o1);
                finishSM<ABL>(pB0, pB1, pw);
            }
            AT_WAITBAR(0);
            AT_SBAR(); pv_d0(o, la, AT_VB(NT - 3), pw, ones, o0, o1);
            exp_lo(pA0); AT_SBAR();
            qkt(pB0, pB1, AT_KB(NT - 1), qf, o0, o1);
            finishSM<ABL>(pA0, pA1, pw); AT_SBAR();
            pv_d0(o, la, AT_VB(NT - 2), pw, ones, o0, o1); exp_lo(pB0);
            finishSM<ABL>(pB0, pB1, pw); AT_SBAR();
            pv_d0(o, la, AT_VB(NT - 1), pw, ones, o0, o1);
        }
        int tid2 = tid; asm volatile("" : "+v"(tid2));
        f32x4* stash = (f32x4*)(F.ws + WS_SCR) + ((size_t)F.bid * NTHREADS + tid2) * 16;
        if (m == 0) {
#pragma unroll
            for (int q = 0; q < 4; ++q) {
                const float r0 = 0.125f * __builtin_amdgcn_rcpf(la[4 * q]), r1 = 0.125f * __builtin_amdgcn_rcpf(la[4 * q + 1]), r2 = 0.125f * __builtin_amdgcn_rcpf(la[4 * q + 2]), r3 = 0.125f * __builtin_amdgcn_rcpf(la[4 * q + 3]);
#pragma unroll
                for (int d0 = 0; d0 < 4; ++d0) stash[d0 * 4 + q] = (f32x4){o[d0][4 * q] * r0, o[d0][4 * q + 1] * r1, o[d0][4 * q + 2] * r2, o[d0][4 * q + 3] * r3};
                asm volatile("" ::: "memory");
            }
        } else {
            const float* sg = F.in[I_SUBG];
            float g4[4];
#pragma unroll
            for (int d0 = 0; d0 < 4; ++d0) g4[d0] = sg[d0 * 32 + r32] * 0.8f;
            const int l2 = tid2 & 63;
            bf16_t* rp = (bf16_t*)(F.ws + WS_ACT) + (size_t)(qrow0 + wid * 32 + 4 * (l2 >> 5)) * DM + 512 + h * 128 + (l2 & 31);
#pragma unroll
            for (int q = 0; q < 4; ++q) {
                f32x4 st[4];
#pragma unroll
                for (int d0 = 0; d0 < 4; ++d0) st[d0] = stash[d0 * 4 + q];
#pragma unroll
                for (int i = 0; i < 4; ++i) { const int r = 4 * q + i; const float rl = 0.125f * __builtin_amdgcn_rcpf(la[r]);
                    float v[4], ss = 0.f;
#pragma unroll
                    for (int d0 = 0; d0 < 4; ++d0) { v[d0] = st[d0][i] - lam * (o[d0][r] * rl); ss += v[d0] * v[d0]; }
                    ss += __shfl_xor(ss, 1); ss += __shfl_xor(ss, 2); ss += __shfl_xor(ss, 4); ss += __shfl_xor(ss, 8); ss += __shfl_xor(ss, 16);
                    const float rstd = rsqrtf(ss * (1.f / 128.f) + EPS);
#pragma unroll
                    for (int d0 = 0; d0 < 4; ++d0) rp[(size_t)i * DM + d0 * 32] = f2bf(v[d0] * rstd * g4[d0]); }
                rp += 8 * DM;
                asm volatile("" : "+v"(rp) :: "memory");
            }
        }
    }
#undef AT_WAITBAR
#undef AT_LWAIT
#undef AT_ISSUE
#undef AT_KB
#undef AT_VB
#undef AT_SBAR
}
}
struct MoeGeo { int layer, NR, HR, UR; };
__device__ __forceinline__ MoeGeo moe_geo(int layer) { MoeGeo g; g.layer = layer; g.NR = layer ? NLAT : NROW; g.HR = g.NR; g.UR = g.NR / 256; return g; }
__device__ __forceinline__ bf16_t* moe_xrow(const Frame& F, int layer, int mrow) { return layer ? xb1_ptr(F, mrow) : xb0_ptr(F, mrow); }
__device__ __forceinline__ int moe_mi(int layer, int mrow) { return layer ? (mrow >> 13) : row_mi(mrow); }

__device__ __forceinline__ void router_phase(Frame& F, int layer) {
    const MoeGeo G = moe_geo(layer);
    LAS float* rs = (LAS float*)F.lds;
    LAS float* lgt = (LAS float*)(F.lds + 1024) + F.wave * 1024;
    LAS int* selE = (LAS int*)(F.lds + 65536);
    LAS float* selG = (LAS float*)(F.lds + 65536 + 4096);
    LAS int* selP = (LAS int*)(F.lds + 65536 + 8192);
    LAS int* hist = (LAS int*)(F.lds + 65536 + 12288);
    LAS int* basev = hist + 64;
    unsigned char* H2 = F.ws + WS_ACT;
    const bf16_t* wh = (const bf16_t*)(F.ws + WS_WRT) + (size_t)(layer * 2) * 65536; const bf16_t* wl = wh + 65536;
    const float* rb = F.in[I_RB] + layer * 64;
    const float* gn = F.in[I_N2G] + layer * DM;
    int* cnt = (int*)(F.ws + WS_CTL) + layer * 128;
    i32x2* list = (i32x2*)(F.ws + WS_LIST);
    const int w = F.wave, e = F.lane, fr = F.lane & 15, kq = F.lane >> 4;
    for (int unit = F.bid; unit < 256; unit += F.G) {
        const int half = 0, mrow0 = unit * G.UR;
        if (F.tid < 64) hist[F.tid] = 0;
        { const float* ssq = (const float*)(F.ws + WS_BIG + BG_SSQ); const int np = layer ? 32 : 16;
          for (int lr = w; lr < G.UR; lr += NWAVES) { const int mrow = mrow0 + lr; float s = F.lane < np ? ssq[(size_t)mrow * 32 + F.lane] : 0.f;
              s = wave_sum(s); if (F.lane == 0) rs[lr] = rsqrtf(s * (1.f / DM) + EPS); } }
        __syncthreads();
        for (int g0 = 16 * w; g0 < G.UR; g0 += 16 * NWAVES) {
            const int nrow = (G.UR - g0) < 16 ? (G.UR - g0) : 16; const bool rok = fr < nrow;
            const int lrow = g0 + (rok ? fr : nrow - 1), mrow = mrow0 + lrow, mi = moe_mi(layer, mrow);
            const bf16_t* xp = moe_xrow(F, layer, mrow) + 8 * kq; const float rstd = rs[lrow];
            const float* shp = modv(F, layer, mi, 3) + 8 * kq; const float* scp = modv(F, layer, mi, 4) + 8 * kq; const float* gp = gn + 8 * kq;
            unsigned char* hp = H2 + (size_t)mrow * DM + 8 * kq;
            const bf16_t* whp = wh + (size_t)fr * 1024 + 8 * kq; const bf16_t* wlp = wl + (size_t)fr * 1024 + 8 * kq;
            f32x4 acc[4];
#pragma unroll
            for (int i = 0; i < 4; ++i) acc[i] = (f32x4){0.f, 0.f, 0.f, 0.f};
#pragma unroll 2
            for (int ks = 0; ks < 32; ++ks) {
                const int k0 = 32 * ks;
                const u32x4 xw = *(const u32x4*)(xp + k0); const f32x4 x0 = bf4_to_f32((u32x2){xw.x, xw.y}), x1 = bf4_to_f32((u32x2){xw.z, xw.w});
                const f32x4 g0v = *(const f32x4*)(gp + k0), g1v = *(const f32x4*)(gp + k0 + 4), c0 = *(const f32x4*)(scp + k0), c1 = *(const f32x4*)(scp + k0 + 4), s0 = *(const f32x4*)(shp + k0), s1 = *(const f32x4*)(shp + k0 + 4);
                const f32x4 y0 = (x0 * rstd) * g0v * (c0 + 1.0f) + s0, y1 = (x1 * rstd) * g1v * (c1 + 1.0f) + s1;
                u32x4 hv; hv.x = cvt_pk_bf16(y0.x, y0.y); hv.y = cvt_pk_bf16(y0.z, y0.w); hv.z = cvt_pk_bf16(y1.x, y1.y); hv.w = cvt_pk_bf16(y1.z, y1.w);
                if (rok) { u32x2 h8; h8.x = pk4_fp8(y0.x, y0.y, y0.z, y0.w); h8.y = pk4_fp8(y1.x, y1.y, y1.z, y1.w); *(u32x2*)(hp + k0) = h8; }
                u32x4 lv; lv.x = cvt_pk_bf16(y0.x - bflo(hv.x), y0.y - bfhi(hv.x)); lv.y = cvt_pk_bf16(y0.z - bflo(hv.y), y0.w - bfhi(hv.y));
                lv.z = cvt_pk_bf16(y1.x - bflo(hv.z), y1.y - bfhi(hv.z)); lv.w = cvt_pk_bf16(y1.z - bflo(hv.w), y1.w - bfhi(hv.w));
                const bf16x8 ah = *reinterpret_cast<const bf16x8*>(&hv), al = *reinterpret_cast<const bf16x8*>(&lv);
#pragma unroll
                for (int blk = 0; blk < 4; ++blk) {
                    const bf16x8 bh = *(const bf16x8*)(whp + (size_t)blk * 16 * 1024 + k0), bl = *(const bf16x8*)(wlp + (size_t)blk * 16 * 1024 + k0);
                    acc[blk] = __builtin_amdgcn_mfma_f32_16x16x32_bf16(ah, bh, acc[blk], 0, 0, 0);
                    acc[blk] = __builtin_amdgcn_mfma_f32_16x16x32_bf16(al, bh, acc[blk], 0, 0, 0);
                    acc[blk] = __builtin_amdgcn_mfma_f32_16x16x32_bf16(ah, bl, acc[blk], 0, 0, 0);
                }
            }
#pragma unroll
            for (int blk = 0; blk < 4; ++blk)
#pragma unroll
                for (int r = 0; r < 4; ++r) lgt[(4 * kq + r) * 64 + 16 * blk + fr] = acc[blk][r];
            asm volatile("s_waitcnt lgkmcnt(0)" ::: "memory");
            const float bias = rb[e];
            for (int rr = 0; rr < nrow; ++rr) {
                const float lg = lgt[rr * 64 + e];
                const float aff = 1.0f / (1.0f + expf(-lg)); const float scv = aff + bias;
                int rank = 0;
#pragma unroll 8
                for (int j = 0; j < 64; ++j) { const float sj = __shfl(scv, j); rank += (sj > scv || (sj == scv && j < e)) ? 1 : 0; }
                const bool sel = rank < 6; const float ssum = wave_sum(sel ? aff : 0.f);
                if (sel) { const int idx = (g0 + rr) * 6 + rank; selE[idx] = e; selG[idx] = aff / ssum * 2.5f; selP[idx] = atomicAdd((int*)&hist[e], 1); }
            }
            asm volatile("s_waitcnt lgkmcnt(0)" ::: "memory");
        }
        __syncthreads();
        if (F.tid < 64) basev[F.tid] = atomicAdd(&cnt[half * 64 + F.tid], hist[F.tid]);
        __syncthreads();
        for (int idx = F.tid; idx < G.UR * 6; idx += NTHREADS) { const int ee = selE[idx], lrow = idx / 6, slot = idx - lrow * 6, mrow = mrow0 + lrow;
            list[(size_t)(half * 64 + ee) * CAPH + basev[ee] + selP[idx]] = (i32x2){mrow * 8 + slot, __float_as_int(selG[idx])};
            ((float*)(F.ws + WS_GATE))[(size_t)mrow * 8 + slot] = selG[idx]; }
        __syncthreads();
    }
}

__device__ __forceinline__ void moe_table(Frame& F, const int* cnt) {
    LAS int* tstart = (LAS int*)(F.lds + MISC_OFF); LAS int* tcnt = tstart + 64;
    if (F.wave == 0) { const int c = cnt[F.lane]; const int nt = (c + 255) >> 8; int incl = nt;
#pragma unroll
        for (int o = 1; o < 64; o <<= 1) { const int v = __shfl_up(incl, o); if (F.lane >= o) incl += v; }
        tstart[F.lane] = incl - nt; tcnt[F.lane] = c; }
    __syncthreads();
}
struct SchedMoe { int G, c, nsh, npn, half_base; const LAS int* tstart; const i32x2* list; const char* A0; const char* W0; size_t wofs, tstepB, astep;
    __device__ __forceinline__ const i32x2* dummy() const { return list; }
    __device__ __forceinline__ bool next(int k, ge::GUnit& u) const {
        const int T = (k / npn) * G + c, pn = k % npn;
        int e = 64, j = T, nv = 256;
        if (T >= nsh) { const int rem = T - nsh, l = lane_id() & 63; const int st = tstart[l], cn_l = tstart[64 + l];
            const unsigned long long m = __ballot(rem >= st && rem < st + ((cn_l + 255) >> 8));
            if (m == 0ull) return false;
            e = __builtin_ctzll(m); j = rem - tstart[e]; const int cn = tstart[64 + e]; nv = (cn - j * 256) < 256 ? (cn - j * 256) : 256; }
        u.pm = T; u.pn = pn; u.nvalid = nv; u.rows = e == 64 ? nullptr : list + (size_t)e * CAPH + j * 256; u.aux = e == 64 ? half_base + j * 256 : 0;
        u.A = A0 + (size_t)T * astep; u.B = W0 + (size_t)e * EXP_STRIDE + wofs + (size_t)pn * tstepB; return true; }
};
__device__ __forceinline__ void moe_up(Frame& F, int layer, int half) {
    const MoeGeo G = moe_geo(layer);
    moe_table(F, (const int*)(F.ws + WS_CTL) + layer * 128 + half * 64);
    const int cs = (F.G % 8 == 0) ? (F.bid % 8) * (F.G / 8) + F.bid / 8 : F.bid;
    SchedMoe S{F.G, cs, G.HR / 256, 2, half * G.HR, (const LAS int*)(F.lds + MISC_OFF), (const i32x2*)(F.ws + WS_LIST) + (size_t)half * 64 * CAPH,
               (const char*)(F.ws + WS_ACT), (const char*)(F.ws + WS_EXP), (size_t)0, (size_t)256 * 1024, (size_t)0};
    EpiUp E{F.ws + WS_SCR};
    ge::gemm_run<EpiUp, SchedMoe, ge::AMapPlain, 2, true>(F.lds, nullptr, 8, 1024u, 0u, (size_t)128, ge::AMapPlain{1024u}, 1024u, S, E, 0x79797979, 0x7f7f7f7f);
}
__device__ __forceinline__ void moe_down(Frame& F, int layer, int half) {
    const MoeGeo G = moe_geo(layer);
    moe_table(F, (const int*)(F.ws + WS_CTL) + layer * 128 + half * 64);
    const int cs = (F.G % 8 == 0) ? (F.bid % 8) * (F.G / 8) + F.bid / 8 : F.bid;
    SchedMoe S{F.G, cs, G.HR / 256, 4, half * G.HR, (const LAS int*)(F.lds + MISC_OFF), (const i32x2*)(F.ws + WS_LIST) + (size_t)half * 64 * CAPH,
               (const char*)(F.ws + WS_SCR), (const char*)(F.ws + WS_EXP), (size_t)EXP_WD, (size_t)256 * 256, (size_t)256 * 256};
    EpiDown E{F.ws + WS_BIG, half * G.HR};
    ge::gemm_run<EpiDown, SchedMoe, ge::AMapPlain, 0, true>(F.lds, nullptr, 2, 256u, 128u * 256u, (size_t)128, ge::AMapPlain{256u}, 0u, S, E, 0x7a7a7a7a, 0x7b7b7b7b);
}

struct DTile { int e, nv, valid, aux, j; };
__device__ __forceinline__ DTile down_tile(int T, int nsh, const LAS int* tstart) {
    DTile t; t.e = 64; t.nv = 256; t.valid = 1; t.j = T;
    if (T >= nsh) { const int rem = T - nsh, l = lane_id() & 63; const int st = tstart[l], cn_l = tstart[64 + l];
        const unsigned long long m = __ballot(rem >= st && rem < st + ((cn_l + 255) >> 8));
        if (m == 0ull) { t.valid = 0; t.aux = 0; return t; }
        t.e = __builtin_ctzll(m); t.j = __builtin_amdgcn_readfirstlane(rem - tstart[t.e]); const int cn = __builtin_amdgcn_readfirstlane(tstart[64 + t.e]); t.nv = (cn - t.j * 256) < 256 ? (cn - t.j * 256) : 256; }
    t.aux = t.e == 64 ? t.j * 256 : 0;
    return t;
}
#ifndef D2_LOCKSTEP
#define D2_LOCKSTEP 0
#endif
template <int ABL> __device__ __forceinline__ void moe_down2(Frame& F, int layer) {
    const MoeGeo G = moe_geo(layer);
    moe_table(F, (const int*)(F.ws + WS_CTL) + layer * 128);
    const int cs = (F.G % 8 == 0) ? (F.bid % 8) * (F.G / 8) + F.bid / 8 : F.bid;
    const LAS int* tstart = (const LAS int*)(F.lds + MISC_OFF);
    const i32x2* list = (const i32x2*)(F.ws + WS_LIST);
    const int nsh = G.HR / 256;
    int tid_ = threadIdx.x; asm volatile("" : "+v"(tid_));
    const int tid = tid_, wid = __builtin_amdgcn_readfirstlane(tid >> 6), lane = tid & 63, grp = wid >> 2, w4 = wid & 3, fr = lane & 15, fq = lane >> 4;
    int ntl = 0; while (down_tile(ntl * F.G + cs, nsh, tstart).valid) ++ntl;
    const int Q = 8 * ntl;
    if (Q == 0) return;
    LAS char* hbuf = (LAS char*)F.lds; LAS char* bbuf = (LAS char*)F.lds + 65536 + grp * 32768; LAS char* ebuf = (LAS char*)F.lds + MISC_OFF + 1024 + wid * 512;
    const unsigned char* HID = F.ws + WS_SCR; const unsigned char* W0 = F.ws + WS_EXP + EXP_WD; unsigned char* Y = F.ws + WS_BIG;
    unsigned xsrc[4];
#pragma unroll
    for (int i = 0; i < 4; ++i) xsrc[i] = (unsigned)fq * 256u + 16u * (unsigned)((lane & 15) ^ (4 * i + fq));
    int wof[2][2];
#pragma unroll
    for (int ks = 0; ks < 2; ++ks)
#pragma unroll
        for (int j = 0; j < 2; ++j) wof[ks][j] = fr * 256 + 16 * ((8 * ks + 2 * fq + j) ^ fr);
    const int sw = 0x7d7d7d7d, sa = 0x7b7b7b7b;
    f32x4 acc[4][4];
    i32x8 hf[4][2];
    i32x2 ent[4];
    DTile cur = down_tile(cs, nsh, tstart), nx = cur;
    u32x4 pw[4]; int ph = -1;
#define D2_DMAH(TI, K) do { const unsigned char* _hp = HID + (size_t)((K) * F.G + cs) * 65536 + (size_t)(32 * wid) * 256; \
        _Pragma("unroll") for (int _i = 0; _i < 8; ++_i) \
            __builtin_amdgcn_global_load_lds((const unsigned*)(_hp + _i * 1024 + xsrc[_i & 3]), (LAS unsigned*)(hbuf + wid * 8192 + _i * 1024), 16, 0, 0); \
        if ((TI).e != 64 && lane < 32) __builtin_amdgcn_global_load_lds((const unsigned*)((const char*)(list + (size_t)(TI).e * CAPH + (TI).j * 256 + 64 * w4) + lane * 16), (LAS unsigned*)ebuf, 16, 0, 0); } while (0)
#define D2_DMA(QQ, TI) do { const unsigned char* _wb = W0 + (size_t)(TI).e * EXP_STRIDE + (size_t)((((QQ) & 7) * 2 + grp) * 64 + 4 * w4) * 256; LAS char* _lb = bbuf + ((QQ) & 1) * 16384 + w4 * 4096; \
        _Pragma("unroll") for (int _i = 0; _i < 4; ++_i) \
            __builtin_amdgcn_global_load_lds((const unsigned*)(_wb + _i * 4096 + xsrc[_i]), (LAS unsigned*)(_lb + _i * 1024), 16, 0, 0); } while (0)
    D2_DMAH(cur, 0);
    D2_DMA(0, cur); D2_DMA(1, cur);
#pragma unroll 1
    for (int s = 0; s <= 2 * Q; ++s) {
        const int u = D2_LOCKSTEP ? s : s - grp; const bool act = u >= 0 && u < 2 * Q; const int q = u >> 1; const bool mf = act && !(u & 1), ep = act && (u & 1);
        if (ABL == 5) asm volatile("s_waitcnt vmcnt(30)" ::: "memory"); else
        if (act && q + 1 < Q) asm volatile("s_waitcnt vmcnt(4)" ::: "memory"); else asm volatile("s_waitcnt vmcnt(0)" ::: "memory");
        if (ABL != 6) __builtin_amdgcn_s_barrier();
#define D2_FLUSH() do { if (ABL == 4) { _Pragma("unroll") for (int _m = 0; _m < 4; ++_m) asm volatile("" :: "v"(pw[_m])); ph = -1; } if (ph >= 0 && ABL != 1) { _Pragma("unroll") for (int _m = 0; _m < 4; ++_m) { const int _rt = 64 * w4 + 16 * _m + fr; \
            if (_rt < cur.nv) { const int _pk = ent[_m].x; *(u32x4*)(Y + ((size_t)(_pk >> 3) * 7 + (_pk & 7)) * 1024 + ph * 64 + 16 * fq) = pw[_m]; } } ph = -1; } } while (0)
        if (mf) {
            D2_FLUSH();
            if ((q & 7) == 0) {
                if (q) cur = nx;
                nx = down_tile(((q >> 3) + 1) * F.G + cs, nsh, tstart);
#pragma unroll
                for (int m = 0; m < 4; ++m) {
#pragma unroll
                    for (int ks = 0; ks < 2; ++ks) { const LAS char* hp = hbuf + (64 * w4 + 16 * m) * 256; const i32x4 a0 = *(const LAS i32x4*)(hp + wof[ks][0]), a1 = *(const LAS i32x4*)(hp + wof[ks][1]);
                        hf[m][ks] = (i32x8){a0[0], a0[1], a0[2], a0[3], a1[0], a1[1], a1[2], a1[3]}; }
                    const int rt = 64 * w4 + 16 * m + fr;
                    if (cur.e != 64) ent[m] = *(const LAS i32x2*)(ebuf + (16 * m + fr) * 8); else ent[m] = (i32x2){((cur.aux + rt) << 3) | 6, 0x3f800000};
                }
            }
            const LAS char* wb = bbuf + (q & 1) * 16384;
            i32x8 wf[2];
#define D2_RD(IDX, DST) do { const i32x4 _a = *(const LAS i32x4*)(wb + ((IDX) & 3) * 4096 + wof[(IDX) >> 2][0]), _b = *(const LAS i32x4*)(wb + ((IDX) & 3) * 4096 + wof[(IDX) >> 2][1]); \
                DST = (i32x8){_a[0], _a[1], _a[2], _a[3], _b[0], _b[1], _b[2], _b[3]}; } while (0)
            D2_RD(0, wf[0]);
#pragma unroll
            for (int idx = 0; idx < 8; ++idx) {
                if (idx + 1 < 8) D2_RD(idx + 1, wf[(idx + 1) & 1]);
                const int nt = idx & 3, ks = idx >> 2;
#pragma unroll
                for (int m = 0; m < 4; ++m) {
                    if (ABL == 2) { if (ks == 0) acc[m][nt] = (f32x4){(float)wf[idx & 1][0], (float)wf[idx & 1][3], 0.f, 0.f}; } else
                    if (ks == 0) asm volatile("v_mfma_scale_f32_16x16x128_f8f6f4 %0, %1, %2, 0, %3, %4 op_sel_hi:[0,0,0]" : "=&v"(acc[m][nt]) : "v"(wf[idx & 1]), "v"(hf[m][0]), "v"(sw), "v"(sa));
                    else asm volatile("v_mfma_scale_f32_16x16x128_f8f6f4 %0, %1, %2, %0, %3, %4 op_sel_hi:[0,0,0]" : "+v"(acc[m][nt]) : "v"(wf[idx & 1]), "v"(hf[m][1]), "v"(sw), "v"(sa));
                }
            }
#undef D2_RD
            asm volatile("s_nop 15\n\ts_nop 15" ::: "memory");
        } else if (ep) {
            ph = (q & 7) * 2 + grp;
            if (ABL != 1)
#pragma unroll
            for (int m = 0; m < 4; ++m) {
                int lo[4];
#pragma unroll
                for (int nt = 0; nt < 4; ++nt) { const float cx = __builtin_amdgcn_fmed3f(acc[m][nt].x, -448.f, 448.f); lo[nt] = __builtin_amdgcn_cvt_pk_fp8_f32(cx, __builtin_amdgcn_fmed3f(acc[m][nt].y, -448.f, 448.f), __float_as_int(cx), false); }
#pragma unroll
                for (int nt = 0; nt < 4; ++nt) lo[nt] = __builtin_amdgcn_cvt_pk_fp8_f32(__builtin_amdgcn_fmed3f(acc[m][nt].z, -448.f, 448.f), __builtin_amdgcn_fmed3f(acc[m][nt].w, -448.f, 448.f), lo[nt], true);
                pw[m] = (u32x4){(unsigned)lo[0], (unsigned)lo[1], (unsigned)lo[2], (unsigned)lo[3]};
            }
            if ((q & 7) == 2 && nx.valid) D2_DMAH(nx, (q >> 3) + 1);
            if (q + 2 < Q && ABL != 3) { if (((q + 2) >> 3) == (q >> 3)) D2_DMA(q + 2, cur); else D2_DMA(q + 2, nx); }
        }
    }
    D2_FLUSH();
#undef D2_FLUSH
#undef D2_DMAH
#undef D2_DMA
    asm volatile("s_waitcnt vmcnt(0)" ::: "memory");
    __syncthreads();
}

__device__ __forceinline__ void combine_phase(Frame& F, int layer, int half) {
    const MoeGeo G = moe_geo(layer);
    const int gw = F.bid * NWAVES + F.wave, NGW = F.G * NWAVES;
    const unsigned char* Y = F.ws + WS_BIG;
    const float* gts = (const float*)(F.ws + WS_GATE);
    const f32x4* gn1 = (const f32x4*)(F.in[I_N1G] + DM) + F.lane;
    for (int lr = gw; lr < G.HR; lr += NGW) {
        const int mrow = half * G.HR + lr, mi = moe_mi(layer, mrow);
        f32x4 a[4];
#pragma unroll
        for (int j = 0; j < 4; ++j) a[j] = (f32x4){0.f, 0.f, 0.f, 0.f};
#pragma unroll
        for (int k = 0; k < 7; ++k) { const unsigned* yp = (const unsigned*)(Y + ((size_t)lr * 7 + k) * 1024) + F.lane;
            const float gk = k < 6 ? gts[(size_t)mrow * 8 + k] : 1.0f;
#pragma unroll
            for (int j = 0; j < 4; ++j) a[j] += unpk4_fp8(yp[64 * j]) * gk; }
#pragma unroll
        for (int j = 0; j < 4; ++j) a[j] = a[j] * (1.0f / 8.0f);
        u32x2* xr = (u32x2*)moe_xrow(F, layer, mrow) + F.lane; const f32x4* g2 = (const f32x4*)modv(F, layer, mi, 5) + F.lane;
        f32x4 v[4]; float s = 0.f;
#pragma unroll
        for (int j = 0; j < 4; ++j) { v[j] = bf4_to_f32(xr[64 * j]) + g2[64 * j] * a[j]; s += (v[j].x * v[j].x + v[j].y * v[j].y) + (v[j].z * v[j].z + v[j].w * v[j].w); }
        if (layer) { f32x4* xo = (f32x4*)(F.out + (size_t)mrow * DM) + F.lane;
#pragma unroll
            for (int j = 0; j < 4; ++j) xo[64 * j] = v[j]; }
        else {
#pragma unroll
            for (int j = 0; j < 4; ++j) xr[64 * j] = f32_to_bf4(v[j]); }
        if (layer == 0) {
            const float rstd = rsqrtf(wave_sum(s) * (1.f / DM) + EPS);
            const f32x4* sh = (const f32x4*)modv(F, 1, mi, 0) + F.lane; const f32x4* sc = (const f32x4*)modv(F, 1, mi, 1) + F.lane;
            bf16_t* base; int tau;
            if (mrow < NCTX) { const int bb = mrow >> 8, t = mrow & 255; tau = t & 31; base = (bf16_t*)(F.ws + WS_HS5C) + (size_t)(bb * 8 + (t >> 5)) * 768; }
            else { const int q = mrow - NCTX, bb = q >> 13, t = q & 8191; tau = t & 31; base = (bf16_t*)(F.ws + WS_HS5L) + (size_t)(bb * 256 + (t >> 5)) * 768; }
            const size_t gstride = mrow < NCTX ? (size_t)32 * 768 : (size_t)1024 * 768;
#pragma unroll
            for (int j = 0; j < 4; ++j) { const f32x4 y = (v[j] * rstd) * gn1[64 * j] * (sc[64 * j] + 1.0f) + sh[64 * j];
                const int c = 4 * F.lane + 256 * j; u32x2 wv; wv.x = cvt_pk_bf16(y.x, y.y); wv.y = cvt_pk_bf16(y.z, y.w);
                *(u32x2*)(base + (size_t)(c >> 4) * gstride + tau * 16 + (c & 15)) = wv; }
        }
    }
}
struct S5P { float dre, dim, cre, cim; };
__device__ __forceinline__ S5P s5_param(const Frame& F, int di, int g, int p) {
    const int idx = (di * 64 + g) * 64 + p;
    const float are = fminf(F.in[I_SARE][idx], -1e-4f), aim = F.in[I_SAIM][idx], dl = expf(F.in[I_SLOG][idx]);
    S5P r; r.dre = are * dl; r.dim = aim * dl;
    float s, c; sincosf(r.dim, &s, &c); const float m = expf(r.dre); const float lr = m * c - 1.0f, li = m * s;
    const float den = 1.0f / (are * are + aim * aim);
    r.cre = (lr * are + li * aim) * den; r.cim = (li * are - lr * aim) * den; return r;
}
__device__ __forceinline__ void cpow(const S5P& q, float k, float& wr, float& wi) { float s, c; sincosf(k * q.dim, &s, &c); const float m = expf(k * q.dre); wr = m * c; wi = m * s; }

__device__ __forceinline__ void s5_tables(Frame& F) {
    bf16_t* TA = (bf16_t*)(F.ws + WS_ACT + AC_S5A);
    bf16_t* TB = (bf16_t*)(F.ws + WS_ACT + AC_S5B);
    LAS float* wl = (LAS float*)(F.lds + MISC_OFF) + F.wave * 256;
    const int gw = F.bid * NWAVES + F.wave, NGW = F.G * NWAVES, p = F.lane;
    constexpr int NA = 64 * 63, NB_ = 64 * 32, NC = 64 * 32;
    const float* bre = F.in[I_SBRE]; const float* bim = F.in[I_SBIM]; const float* cre = F.in[I_SCRE]; const float* cim = F.in[I_SCIM];
    for (int it = gw; it < NA + NB_ + NC; it += NGW) {
        if (it < NA) {
            const int g = it / 63, dlt = it % 63 - 31, ad = dlt < 0 ? -dlt : dlt;
            { const S5P qf = s5_param(F, 0, g, p), qb = s5_param(F, 1, g, p); float wr, wi;
              cpow(qf, (float)ad, wr, wi); wl[p] = wr * qf.cre - wi * qf.cim; wl[64 + p] = wr * qf.cim + wi * qf.cre;
              cpow(qb, (float)ad, wr, wi); wl[128 + p] = wr * qb.cre - wi * qb.cim; wl[192 + p] = wr * qb.cim + wi * qb.cre; }
            asm volatile("s_waitcnt lgkmcnt(0)" ::: "memory");
            const int i = F.lane >> 2, j0 = 4 * (F.lane & 3);
            float acc[4] = {0.f, 0.f, 0.f, 0.f};
#pragma unroll 1
            for (int di = 0; di < 2; ++di) {
                if ((di == 0 && dlt < 0) || (di == 1 && dlt > 0)) continue;
                const float* cr = cre + ((size_t)(di * 64 + g) * 16 + i) * 64; const float* ci = cim + ((size_t)(di * 64 + g) * 16 + i) * 64;
                const float* br = bre + ((size_t)(di * 64 + g) * 64) * 16 + j0; const float* bi = bim + ((size_t)(di * 64 + g) * 64) * 16 + j0;
#pragma unroll 4
                for (int pp = 0; pp < 64; ++pp) { const float wr = wl[di * 128 + pp], wi = wl[di * 128 + 64 + pp]; const float c_r = cr[pp], c_i = ci[pp];
                    const float xr = c_r * wr - c_i * wi, xi = c_r * wi + c_i * wr; const f32x4 b_r = *(const f32x4*)(br + pp * 16), b_i = *(const f32x4*)(bi + pp * 16);
                    acc[0] += xr * b_r.x - xi * b_i.x; acc[1] += xr * b_r.y - xi * b_i.y; acc[2] += xr * b_r.z - xi * b_i.z; acc[3] += xr * b_r.w - xi * b_i.w; }
            }
            if (dlt == 0) { const int jj = i - j0; if (jj >= 0 && jj < 4) { const float dv = F.in[I_SD][g * 16 + i]; if (jj == 0) acc[0] += dv; else if (jj == 1) acc[1] += dv; else if (jj == 2) acc[2] += dv; else acc[3] += dv; } }
            u32x2 wv; wv.x = cvt_pk_bf16(acc[0], acc[1]); wv.y = cvt_pk_bf16(acc[2], acc[3]);
            for (int sg = 0; sg < 32; ++sg) { const int tau = sg + dlt; if (tau >= 0 && tau < 32) *(u32x2*)(TB + ((size_t)g * 512 + tau * 16 + i) * 768 + sg * 16 + j0) = wv; }
            asm volatile("s_waitcnt lgkmcnt(0)" ::: "memory");
        } else if (it < NA + NB_) {
            const int r = it - NA, g = r >> 5, tau = r & 31;
            const S5P qf = s5_param(F, 0, g, p), qb = s5_param(F, 1, g, p); float fr_, fi_, br_, bi_;
            cpow(qf, (float)(tau + 1), fr_, fi_); cpow(qb, (float)(32 - tau), br_, bi_);
            for (int i = 0; i < 16; ++i) {
                const float c0r = cre[((size_t)(0 * 64 + g) * 16 + i) * 64 + p], c0i = cim[((size_t)(0 * 64 + g) * 16 + i) * 64 + p];
                const float c1r = cre[((size_t)(1 * 64 + g) * 16 + i) * 64 + p], c1i = cim[((size_t)(1 * 64 + g) * 16 + i) * 64 + p];
                bf16_t* row = TB + ((size_t)g * 512 + tau * 16 + i) * 768 + 512;
                row[p] = f2bf(c0r * fr_ - c0i * fi_); row[64 + p] = f2bf(-(c0r * fi_ + c0i * fr_));
                row[128 + p] = f2bf(c1r * br_ - c1i * bi_); row[192 + p] = f2bf(-(c1r * bi_ + c1i * br_)); }
        } else {
            const int r = it - NA - NB_, g = r >> 5, sg = r & 31;
            const S5P qf = s5_param(F, 0, g, p), qb = s5_param(F, 1, g, p); float wr, wi;
            cpow(qf, (float)(31 - sg), wr, wi); const float fr_ = wr * qf.cre - wi * qf.cim, fi_ = wr * qf.cim + wi * qf.cre;
            cpow(qb, (float)sg, wr, wi); const float br_ = wr * qb.cre - wi * qb.cim, bi_ = wr * qb.cim + wi * qb.cre;
            const float* b0r = bre + ((size_t)(0 * 64 + g) * 64 + p) * 16; const float* b0i = bim + ((size_t)(0 * 64 + g) * 64 + p) * 16;
            const float* b1r = bre + ((size_t)(1 * 64 + g) * 64 + p) * 16; const float* b1i = bim + ((size_t)(1 * 64 + g) * 64 + p) * 16;
            bf16_t* r0 = TA + ((size_t)g * 256 + p) * 512 + sg * 16;
#pragma unroll
            for (int q4 = 0; q4 < 4; ++q4) { const f32x4 xr = *(const f32x4*)(b0r + 4 * q4), xi = *(const f32x4*)(b0i + 4 * q4), yr = *(const f32x4*)(b1r + 4 * q4), yi = *(const f32x4*)(b1i + 4 * q4);
                const f32x4 are_ = xr * fr_ - xi * fi_, aim_ = xr * fi_ + xi * fr_, bre_ = yr * br_ - yi * bi_, bim_ = yr * bi_ + yi * br_;
                u32x2 w0, w1, w2, w3; w0.x = cvt_pk_bf16(are_.x, are_.y); w0.y = cvt_pk_bf16(are_.z, are_.w); w1.x = cvt_pk_bf16(aim_.x, aim_.y); w1.y = cvt_pk_bf16(aim_.z, aim_.w);
                w2.x = cvt_pk_bf16(bre_.x, bre_.y); w2.y = cvt_pk_bf16(bre_.z, bre_.w); w3.x = cvt_pk_bf16(bim_.x, bim_.y); w3.y = cvt_pk_bf16(bim_.z, bim_.w);
                *(u32x2*)(r0 + 4 * q4) = w0; *(u32x2*)(r0 + (size_t)64 * 512 + 4 * q4) = w1; *(u32x2*)(r0 + (size_t)128 * 512 + 4 * q4) = w2; *(u32x2*)(r0 + (size_t)192 * 512 + 4 * q4) = w3; }
        }
    }
}

struct SchedS5a { __device__ __forceinline__ const i32x2* dummy() const { return nullptr; } int G, c; const char* HL; const char* HC; const char* TA;
    __device__ __forceinline__ bool next(int i, ge::GUnit& u) const { const int L = i * G + c; if (L >= 320) return false; const int g = L / 5, k = L % 5;
        u.aux = g; u.pm = k; u.pn = 0; u.nvalid = 256; u.A = k < 4 ? HL + ((size_t)g * 1024 + k * 256) * 1536 : HC + (size_t)g * 32 * 1536; u.B = TA + (size_t)g * 256 * 1024; return true; } };
struct SchedS5b { __device__ __forceinline__ const i32x2* dummy() const { return nullptr; } int G, c; const char* HL; const char* TB;
    __device__ __forceinline__ bool next(int i, ge::GUnit& u) const { const int L = i * G + c; if (L >= 512) return false; const int g = L >> 3, k = (L >> 1) & 3, pn = L & 1;
        u.aux = g; u.pm = k; u.pn = pn; u.nvalid = 256; u.A = HL + ((size_t)g * 1024 + k * 256) * 1536; u.B = TB + ((size_t)g * 512 + pn * 256) * 1536; return true; } };

__device__ __forceinline__ void s5_carry(Frame& F) {
    LAS float* ex = (LAS float*)F.lds;
    for (int u = F.bid; u < 512; u += F.G) {
        const int di = u & 1, b = (u >> 1) & 3, g = u >> 3, p = F.lane, w = F.wave;
        const S5P q = s5_param(F, di, g, p); float lr, li, gr, gi; cpow(q, 32.0f, lr, li); cpow(q, 1024.0f, gr, gi);
        const float* __restrict__ sl = (const float*)(F.ws + WS_BIG + BG_SLOCL) + ((size_t)g * 1024 + b * 256) * 256 + di * 128 + p;
        const float* __restrict__ sc = (const float*)(F.ws + WS_BIG + BG_SLOCC) + ((size_t)g * 32 + b * 8) * 256 + di * 128 + p;
        bf16_t* __restrict__ ho = (bf16_t*)(F.ws + WS_HS5L) + ((size_t)g * 1024 + b * 256) * 768 + 512 + di * 128 + p;
        float sr[32], si[32];
#pragma unroll
        for (int k = 0; k < 32; ++k) { const int c = di == 0 ? 32 * w + k : 255 - 32 * w - k; sr[k] = sl[(size_t)c * 256]; si[k] = sl[(size_t)c * 256 + 64]; }
        float hr = 0.f, hi_ = 0.f;
        { float cr[8], ci[8];
#pragma unroll
          for (int k = 0; k < 8; ++k) { const int cc = di == 0 ? k : 7 - k; cr[k] = sc[cc * 256]; ci[k] = sc[cc * 256 + 64]; }
#pragma unroll
          for (int k = 0; k < 8; ++k) { const float nr = lr * hr - li * hi_ + cr[k], ni = lr * hi_ + li * hr + ci[k]; hr = nr; hi_ = ni; } }
        float qr = 0.f, qi = 0.f;
#pragma unroll
        for (int k = 0; k < 32; ++k) { const float nr = lr * qr - li * qi + sr[k], ni = lr * qi + li * qr + si[k]; qr = nr; qi = ni; }
        ex[(w * 2 + 0) * 64 + p] = qr; ex[(w * 2 + 1) * 64 + p] = qi;
        __syncthreads();
        for (int v = 0; v < w; ++v) { const float tr = ex[(v * 2 + 0) * 64 + p], ti = ex[(v * 2 + 1) * 64 + p]; const float nr = gr * hr - gi * hi_ + tr, ni = gr * hi_ + gi * hr + ti; hr = nr; hi_ = ni; }
#pragma unroll
        for (int k = 0; k < 32; ++k) { const int c = di == 0 ? 32 * w + k : 255 - 32 * w - k; ho[(size_t)c * 768] = f2bf(hr); ho[(size_t)c * 768 + 64] = f2bf(hi_);
            const float nr = lr * hr - li * hi_ + sr[k], ni = lr * hi_ + li * hr + si[k]; hr = nr; hi_ = ni; }
        __syncthreads();
    }
}

struct AMapGlu { __device__ __forceinline__ unsigned operator()(int R, int C) const { const int c = 2 * C; return (unsigned)((R >> 5) * 512 + (R & 31) * 16) + (unsigned)(c >> 4) * (1024u * 512u) + (unsigned)(c & 15); } };
#ifndef MK_PER_PHASE
#define MK_PER_PHASE 0
#endif
constexpr int NPH = 17;

constexpr size_t CTL_BAR_BYTE = 16384;
#define XB_TMO      128
#define XB_XCNT(j)  (256  + 64 * (j))
#define XB_XSUB(j)  (1280 + 64 * (j))
#define XB_XGEN(j)  (2304 + 64 * (j))
#define XB_TOP      3328
#define XB_TOPGEN   3392
#define XCD_BAR_WORDS 3456
#define XB_SPIN_CAP (1u << 22)
__device__ __forceinline__ unsigned xb_ld(unsigned* p)              { return __hip_atomic_load(p, __ATOMIC_RELAXED, __HIP_MEMORY_SCOPE_AGENT); }
__device__ __forceinline__ unsigned xb_add(unsigned* p, unsigned v) { return __hip_atomic_fetch_add(p, v, __ATOMIC_RELAXED, __HIP_MEMORY_SCOPE_AGENT); }
__device__ __forceinline__ unsigned xb_xcc_id() { return (unsigned)__builtin_amdgcn_s_getreg((3 << 11) | 20) & 0xFu; }
#define XB_SPIN(cond, bar) do { unsigned _sp = 0; while (cond) { __builtin_amdgcn_s_sleep(1); \
    if ((++_sp & 255u) == 0u) { if (xb_ld(&(bar)[XB_TMO])) break; if (_sp > XB_SPIN_CAP) { atomicAdd(&(bar)[XB_TMO], 1u); break; } } } } while (0)
struct XcdBarrier { unsigned* bar; unsigned x; volatile LAS unsigned* st; };
__device__ __forceinline__ XcdBarrier xcd_barrier_post(unsigned* bar, volatile LAS unsigned* st) {
    XcdBarrier b; b.bar = bar; b.x = xb_xcc_id(); b.st = st;
    if (threadIdx.x == 0) (void)xb_add(&bar[XB_XCNT(b.x)], 1u);
    return b;
}
__device__ __forceinline__ void xcd_barrier_complete(unsigned* bar, unsigned x, unsigned& nloc, unsigned& nx) {
    const unsigned G = gridDim.x;
    unsigned sum, cnt, mine, sp = 0u;
    for (;;) {
        sum = 0u; cnt = 0u; mine = 0u;
#pragma unroll
        for (unsigned j = 0; j < 16; ++j) { const unsigned c = xb_ld(&bar[XB_XCNT(j)]); sum += c; cnt += (c > 0u) ? 1u : 0u; mine = (j == x) ? c : mine; }
        if (sum == G) break;
        __builtin_amdgcn_s_sleep(1);
        if ((++sp & 255u) == 0u) { if (xb_ld(&bar[XB_TMO])) break; if (sp > XB_SPIN_CAP) { atomicAdd(&bar[XB_TMO], 1u); break; } }
    }
    nloc = mine > 0u ? mine : 1u; nx = cnt > 0u ? cnt : 1u;
}
__device__ __forceinline__ void xcd_barrier(const XcdBarrier& b) {
    asm volatile("s_waitcnt vmcnt(0)" ::: "memory");
    __syncthreads();
    if (threadIdx.x == 0) {
        unsigned* bar = b.bar;
        __builtin_amdgcn_s_waitcnt(0);
        unsigned nloc = b.st[0], nx = b.st[1];
        if (nloc == 0u) { xcd_barrier_complete(bar, b.x, nloc, nx); b.st[0] = nloc; b.st[1] = nx; }
        const unsigned old = xb_add(&bar[XB_XSUB(b.x)], 1u);
        const unsigned gen = old / nloc;
        if (old + 1u == (gen + 1u) * nloc) {
            __builtin_amdgcn_fence(__ATOMIC_RELEASE, "agent");
            asm volatile("s_waitcnt vmcnt(0)" ::: "memory");
            const unsigned og = xb_add(&bar[XB_TOP], 1u);
            const unsigned tg = og / nx;
            if (og + 1u == (tg + 1u) * nx) xb_add(&bar[XB_TOPGEN], 1u);
            else XB_SPIN(xb_ld(&bar[XB_TOPGEN]) == tg, bar);
            __builtin_amdgcn_fence(__ATOMIC_ACQUIRE, "agent");
            xb_add(&bar[XB_XGEN(b.x)], 1u);
            asm volatile("s_waitcnt vmcnt(0)" ::: "memory");
        } else {
            XB_SPIN(xb_ld(&bar[XB_XGEN(b.x)]) == gen, bar);
            __builtin_amdgcn_fence(__ATOMIC_ACQUIRE, "agent");
            asm volatile("s_waitcnt vmcnt(0)" ::: "memory");
        }
    }
    __syncthreads();
}

__global__ void __launch_bounds__(NTHREADS, 2) mega_fwd(Args args) {
    extern __shared__ __attribute__((aligned(16))) unsigned char lds_raw[];
    Frame F;
    F.lds = (LAS unsigned char*)lds_raw; F.in = args.in; F.out = args.out; F.ws = args.ws;
    F.tid = threadIdx.x; F.lane = F.tid & 63; F.wave = __builtin_amdgcn_readfirstlane(F.tid >> 6); F.G = gridDim.x; F.bid = blockIdx.x;
    const int lo = args.ph_lo, hi = args.ph_hi;
    volatile LAS unsigned* bst = (volatile LAS unsigned*)(F.lds + LDS_BYTES - 16);
    XcdBarrier bar; bar.bar = (unsigned*)(F.ws + WS_CTL + CTL_BAR_BYTE); bar.x = 0; bar.st = bst;
    if (hi - lo > 1) { if (F.tid == 0) { bst[0] = 0u; bst[1] = 0u; } __syncthreads(); bar = xcd_barrier_post((unsigned*)(F.ws + WS_CTL + CTL_BAR_BYTE), bst); }
#ifdef PH_ONLY
#define IN(k) ((k) == PH_ONLY && lo <= (k) && (k) < hi)
#else
#define IN(k) (lo <= (k) && (k) < hi)
#endif
#define SEAM(k) do { if (IN(k) && IN((k) + 1)) { if ((k) == 0) cg::this_grid().sync(); else xcd_barrier(bar); } } while (0)

#ifndef PROBE_REP
#define PROBE_REP -1
#endif
#ifndef DOWN_ABL
#define DOWN_ABL 0
#endif
#define NREP(k) ((PROBE_REP == (k)) ? 2 : 1)
#define REPSYNC(k, rep) do { if ((rep) + 1 < NREP(k)) xcd_barrier(bar); } while (0)
    if (IN(0)) { for (int rep = 0; rep < NREP(0); ++rep) { p0_prologue(F); __syncthreads(); REPSYNC(0, rep); } } SEAM(0);
    if (IN(1)) for (int rep = 0; rep < NREP(1); ++rep) { p1_norm1(F); REPSYNC(1, rep); } SEAM(1);
    if (IN(2)) {
        { ge::StaticOrder S; S.init(NROW / 256, 4, F.G, F.bid, F.ws + WS_ACT, (size_t)256 * 2048, F.ws + WS_WIN, (size_t)256 * 2048);
          EpiG1 E{F.ws, F.in[I_QG], F.in[I_KG], 0};
          ge::gemm_run<EpiG1, ge::StaticOrder, ge::AMapPlain, 0>(F.lds, nullptr, 16, 2048u, 128u * 2048u, (size_t)128, ge::AMapPlain{2048u}, 0u, S, E); }
        {
          ge::StaticOrder S; S.init(NROW / 256, 6, F.G, F.bid, F.ws + WS_SCR, (size_t)256 * 1024, F.ws + WS_WIN8, (size_t)256 * 1024);
          if (F.G == 256) { if (F.bid < 16) { S.G = 16; S.lim = 32; } else { S.G = 240; S.c = F.bid - 16; S.base = 32; } }
          EpiG1 E{F.ws, F.in[I_QG], F.in[I_KG], 4};
          ge::gemm_run<EpiG1, ge::StaticOrder, ge::AMapPlain, 0, true>(F.lds, nullptr, 8, 1024u, 128u * 1024u, (size_t)128, ge::AMapPlain{1024u}, 0u, S, E, 0x79797979, 0x7c7c7c7c); }
    }
#if PROBE_REP == 2
    xcd_barrier(bar);
    {
        ge::StaticOrder S; S.init(NROW / 256, 10, F.G, F.bid, F.ws + WS_ACT, (size_t)256 * 2048, F.ws + WS_WIN, (size_t)256 * 2048);
        EpiG1 E{F.ws, F.in[I_QG], F.in[I_KG], 0};
        ge::gemm_run<EpiG1, ge::StaticOrder, ge::AMapPlain, 0>(F.lds, nullptr, 16, 2048u, 128u * 2048u, (size_t)128, ge::AMapPlain{2048u}, 0u, S, E);
    }
#endif
    SEAM(2);
    if (IN(3)) { lru_consts(F); for (int u = F.bid; u < NBATCH * LRU_NCH; u += F.G) lru_unit<false>(F, u / LRU_NCH, u % LRU_NCH); }
#if PROBE_REP == 3
    xcd_barrier(bar);
    { lru_consts(F); for (int u = F.bid; u < NBATCH * LRU_NCH; u += F.G) lru_unit<false>(F, u / LRU_NCH, u % LRU_NCH); }
#endif
    SEAM(3);
    if (IN(4)) for (int rep = 0; rep < NREP(4); ++rep) { lru_carry(F); REPSYNC(4, rep); } SEAM(4);
    if (IN(5)) {
        lru_consts(F);
        for (int rep = 0; rep < NREP(51); ++rep) { for (int u = F.bid; u < NBATCH * LRU_NCH; u += F.G) lru_unit<true>(F, u / LRU_NCH, u % LRU_NCH); REPSYNC(51, rep); }
        const float s1 = wave_sum(F.in[I_LQ1][F.lane] * F.in[I_LK1][F.lane]), s2 = wave_sum(F.in[I_LQ2][F.lane] * F.in[I_LK2][F.lane]);
        const float lam = expf(s1) - expf(s2) + 0.2f;
        const int ca = (F.G % 8 == 0) ? (F.bid % 8) * (F.G / 8) + F.bid / 8 : F.bid;
        for (int rep = 0; rep < NREP(50); ++rep)
        for (int u = ca; u < 528; u += F.G) {
            const bool isl = u < 512; const int b = isl ? (u >> 7) : ((u - 512) >> 2), h = isl ? ((u >> 5) & 3) : ((u - 512) & 3);
#ifdef PROBE_ABL
            if (rep == 0) at::attn_unit<PROBE_ABL>(F, b, h, isl ? NCTX + b * SEQ + (u & 31) * 256 : b * 256, isl ? 132 : 4, lam); else
#endif
            at::attn_unit<0>(F, b, h, isl ? NCTX + b * SEQ + (u & 31) * 256 : b * 256, isl ? 132 : 4, lam);
            __syncthreads();
        }
    } SEAM(5);
    if (IN(6)) {
        ge::StaticOrder S; S.init(NROW / 256, 4, F.G, F.bid, F.ws + WS_ACT, (size_t)256 * 2048, F.ws + WS_WOUT, (size_t)256 * 2048);
        EpiG2 E{F};
        ge::gemm_run<EpiG2, ge::StaticOrder, ge::AMapPlain, 0>(F.lds, nullptr, 16, 2048u, 128u * 2048u, (size_t)128, ge::AMapPlain{2048u}, 0u, S, E);
    }
#if PROBE_REP == 6
    xcd_barrier(bar);
    {
        ge::StaticOrder S; S.init(NROW / 256, 4, F.G, F.bid, F.ws + WS_ACT, (size_t)256 * 2048, F.ws + WS_WOUT, (size_t)256 * 2048);
        EpiG2 E{F};
        ge::gemm_run<EpiG2, ge::StaticOrder, ge::AMapPlain, 0>(F.lds, nullptr, 16, 2048u, 128u * 2048u, (size_t)128, ge::AMapPlain{2048u}, 0u, S, E);
    }
#endif
    SEAM(6);
    if (IN(7)) { router_phase(F, 0); } SEAM(7);
#if PROBE_REP == 80
    if (IN(8)) { moe_up(F, 0, 0); xcd_barrier(bar); }
#endif
    if (IN(8)) { moe_up(F, 0, 0); asm volatile("s_waitcnt vmcnt(0)" ::: "memory"); __syncthreads(); moe_down2<DOWN_ABL>(F, 0); }
#if PROBE_REP == 81
    if (IN(8)) { xcd_barrier(bar); moe_down2<0>(F, 0); }
#endif
    SEAM(8);
    if (IN(9)) {
        combine_phase(F, 0, 0);
        s5_tables(F);
        LAS float* scr = (LAS float*)(F.lds + 32768 + F.wave * 8704);
        for (int it = F.bid * NWAVES + F.wave; it < 65 * 384; it += F.G * NWAVES) conv_expert_item(F, 1, it, scr);
    } SEAM(9);
    if (IN(10)) for (int rep = 0; rep < NREP(10); ++rep) {
        const int cs = (F.G % 8 == 0) ? (F.bid % 8) * (F.G / 8) + F.bid / 8 : F.bid;
        SchedS5a S{F.G, cs, (const char*)(F.ws + WS_HS5L), (const char*)(F.ws + WS_HS5C), (const char*)(F.ws + WS_ACT + AC_S5A)};
        EpiS5a E{F.ws};
        ge::gemm_run<EpiS5a, SchedS5a, ge::AMapPlain, 0>(F.lds, nullptr, 8, 1024u, 128u * 1536u, (size_t)128, ge::AMapPlain{1536u}, 0u, S, E);
        REPSYNC(10, rep);
    } SEAM(10);
    if (IN(11)) { s5_carry(F); } SEAM(11);
    if (IN(12)) for (int rep = 0; rep < NREP(12); ++rep) {
        const int cs = (F.G % 8 == 0) ? (F.bid % 8) * (F.G / 8) + F.bid / 8 : F.bid;
        SchedS5b S{F.G, cs, (const char*)(F.ws + WS_HS5L), (const char*)(F.ws + WS_ACT + AC_S5B)};
        EpiS5b E{F.ws};
        ge::gemm_run<EpiS5b, SchedS5b, ge::AMapPlain, 0>(F.lds, nullptr, 12, 1536u, 128u * 1536u, (size_t)128, ge::AMapPlain{1536u}, 0u, S, E);
        REPSYNC(12, rep);
    } SEAM(12);
    if (IN(13)) for (int rep = 0; rep < NREP(13); ++rep) {
#if PROBE_REP == 13 && defined(PROBE_HOT)
        ge::StaticOrder S; S.init(NLAT / 256, 8, F.G, F.bid, F.ws + WS_BIG + BG_ZS5, rep == 0 ? (size_t)0 : (size_t)8 * 512, F.ws + WS_GLU, rep == 0 ? (size_t)0 : (size_t)256 * 1024);
#else
        ge::StaticOrder S; S.init(NLAT / 256, 8, F.G, F.bid, F.ws + WS_BIG + BG_ZS5, (size_t)8 * 512, F.ws + WS_GLU, (size_t)256 * 1024);
#endif
        EpiGlu E{F};
        ge::gemm_run<EpiGlu, ge::StaticOrder, AMapGlu, 0, true>(F.lds, nullptr, 8, 1024u, 2048u, (size_t)8 * 1024 * 512, AMapGlu{}, 0u, S, E, 0x7a7a7a7a, 0x7d7d7d7d);
        REPSYNC(13, rep);
    } SEAM(13);
    if (IN(14)) { router_phase(F, 1); } SEAM(14);
    if (IN(15)) { moe_up(F, 1, 0); asm volatile("s_waitcnt vmcnt(0)" ::: "memory"); __syncthreads(); moe_down2<0>(F, 1); } SEAM(15);
    if (IN(16)) for (int rep = 0; rep < NREP(16); ++rep) { combine_phase(F, 1, 0); REPSYNC(16, rep); }
#undef IN
#undef SEAM
}

extern "C" void kernel_launch(void* const* d_in, const int* in_sizes, int n_in, void* d_out, int out_size, void* d_ws, size_t ws_size, hipStream_t stream) {
    static int grid = 0;
    if (grid == 0) {
        if (n_in != 42 || out_size != NLAT * DM || ws_size < WS_END) { fprintf(stderr, "kernel_launch: unexpected problem: n_in %d out %d ws %zu (need %zu)\n", n_in, out_size, ws_size, (size_t)WS_END); grid = -1; return; }
        int dev = 0, cus = 0, per_cu = 0;
        if (hipGetDevice(&dev) != hipSuccess || hipDeviceGetAttribute(&cus, hipDeviceAttributeMultiprocessorCount, dev) != hipSuccess) { grid = -1; return; }
        if (hipFuncSetAttribute((const void*)mega_fwd, hipFuncAttributeMaxDynamicSharedMemorySize, LDS_BYTES) != hipSuccess) { fprintf(stderr, "kernel_launch: hipFuncSetAttribute failed\n"); grid = -1; return; }
        if (hipOccupancyMaxActiveBlocksPerMultiprocessor(&per_cu, (const void*)mega_fwd, NTHREADS, LDS_BYTES) != hipSuccess || per_cu < 1) { fprintf(stderr, "kernel_launch: occupancy query failed (%d)\n", per_cu); grid = -1; return; }
        grid = cus * per_cu; if (grid > 256) grid = 256;
        fprintf(stderr, "kernel_launch: cus %d per_cu %d grid %d ws %zu\n", cus, per_cu, grid, ws_size);
    }
    if (grid < 0) return;
    (void)hipMemsetAsync((char*)d_ws + WS_CTL, 0, 65536, stream);
    Args a{};
    for (int i = 0; i < 42; ++i) a.in[i] = (const float*)d_in[i];
    a.out = (float*)d_out; a.ws = (unsigned char*)d_ws;
#if MK_PER_PHASE
    for (int p = 0; p < NPH; ++p) { a.ph_lo = p; a.ph_hi = p + 1; hipLaunchKernelGGL(mega_fwd, dim3(grid), dim3(NTHREADS), LDS_BYTES, stream, a); }
#else
    a.ph_lo = 0; a.ph_hi = NPH;
    void* kargs[] = {&a};
    const hipError_t e = hipLaunchCooperativeKernel((const void*)mega_fwd, dim3(grid), dim3(NTHREADS), kargs, LDS_BYTES, stream);
    if (e != hipSuccess) fprintf(stderr, "kernel_launch: cooperative launch failed: %s (grid %d)\n", hipGetErrorString(e), grid);
#endif
}
```

```cpp
#include <hip/hip_runtime.h>
#include <hip/hip_cooperative_groups.h>
#include <cstdio>
#include <cstdint>
namespace cg = cooperative_groups;

#define LAS __attribute__((address_space(3)))
typedef unsigned short bf16_t;
typedef short bf16x8 __attribute__((ext_vector_type(8)));
typedef short s16x4 __attribute__((ext_vector_type(4)));
typedef float f32x2 __attribute__((ext_vector_type(2)));
typedef float f32x4 __attribute__((ext_vector_type(4)));
typedef float f32x16 __attribute__((ext_vector_type(16)));
typedef unsigned u32x2 __attribute__((ext_vector_type(2)));
typedef int i32x2 __attribute__((ext_vector_type(2)));
typedef unsigned u32x4 __attribute__((ext_vector_type(4)));

constexpr int DM = 1024, NBATCH = 4, SEQ = 8192, CTXL = 256;
constexpr int NCTX = NBATCH * CTXL;
constexpr int NLAT = NBATCH * SEQ;
constexpr int NROW = NCTX + NLAT;
constexpr float EPS = 1e-6f;
constexpr int NTHREADS = 512, NWAVES = 8;
constexpr int LRU_NCH = 264;
constexpr int CAPH = 33792;

constexpr size_t MiB = 1ull << 20;
constexpr size_t WS_CTL = 0;
constexpr size_t WS_MODV = 1 * MiB;
constexpr size_t WS_ROPE = WS_MODV + 256 * 1024;
constexpr size_t WS_LRUW = WS_MODV + 512 * 1024;
constexpr size_t WS_LRUSP = WS_MODV + 768 * 1024;
constexpr size_t WS_WRT = 2 * MiB;
constexpr size_t WS_WIN = 4 * MiB, WS_WIN8 = 6 * MiB, WS_WOUT = 9 * MiB, WS_GLU = 11 * MiB;
constexpr size_t WS_EXP = 15 * MiB;
constexpr size_t WS_ACT = 113 * MiB;
constexpr size_t WS_BIG = 179 * MiB;
constexpr size_t WS_SCR = 410 * MiB;
constexpr size_t WS_LIST = 472 * MiB;
constexpr size_t WS_GATE = 490 * MiB;
constexpr size_t WS_HS5L = 494 * MiB;
constexpr size_t WS_HS5C = 590 * MiB;
constexpr size_t WS_END = 594 * MiB;
constexpr size_t BG_GATE = 0, BG_XA = 33 * MiB, BG_Q = 66 * MiB, BG_K = 99 * MiB, BG_V = 132 * MiB, BG_LSUM = 165 * MiB, BG_LHIN = 175 * MiB;
constexpr size_t BG_MODP = 200 * MiB;
constexpr size_t BG_SSQ = 200 * MiB;
constexpr size_t BG_ZS5 = 0, BG_SLOCL = 64 * MiB, BG_SLOCC = 128 * MiB;
constexpr size_t AC_S5A = 0, AC_S5B = 16 * MiB;
constexpr size_t EXP_STRIDE = 3 * MiB / 2, EXP_WD = 1 * MiB;

constexpr int RING_BYTES = 131072, MISC_OFF = RING_BYTES, LDS_BYTES = 147456;

__device__ __forceinline__ unsigned cvt_pk_bf16(float lo, float hi) { unsigned r; asm("v_cvt_pk_bf16_f32 %0, %1, %2" : "=v"(r) : "v"(lo), "v"(hi)); return r; }
__device__ __forceinline__ bf16_t f2bf(float f) { return (bf16_t)(cvt_pk_bf16(f, 0.f) & 0xffffu); }
__device__ __forceinline__ float bf2f(bf16_t h) { return __uint_as_float(((unsigned)h) << 16); }
__device__ __forceinline__ float bflo(unsigned w) { return __uint_as_float(w << 16); }
__device__ __forceinline__ float bfhi(unsigned w) { return __uint_as_float(w & 0xffff0000u); }
__device__ __forceinline__ float wave_sum(float v) {
#pragma unroll
    for (int o = 1; o < 64; o <<= 1) v += __shfl_xor(v, o);
    return v;
}
__device__ __forceinline__ float sigmoidf_(float x) { return __builtin_amdgcn_rcpf(1.f + __expf(-x)); }
__device__ __forceinline__ float siluf_(float x) { return x * sigmoidf_(x); }
__device__ __forceinline__ float gelu_tanh(float x) { const float u = 0.7978845608028654f * (x + 0.044715f * x * x * x); return x * __builtin_amdgcn_rcpf(1.f + __expf(-2.f * u)); }
__device__ __forceinline__ unsigned pk4_fp8(float a, float b, float c, float d) {
    a = fminf(fmaxf(a, -448.f), 448.f); b = fminf(fmaxf(b, -448.f), 448.f); c = fminf(fmaxf(c, -448.f), 448.f); d = fminf(fmaxf(d, -448.f), 448.f);
    int w = __builtin_amdgcn_cvt_pk_fp8_f32(a, b, 0, false); w = __builtin_amdgcn_cvt_pk_fp8_f32(c, d, w, true); return (unsigned)w; }
typedef int i32x8 __attribute__((ext_vector_type(8)));
typedef int i32x4 __attribute__((ext_vector_type(4)));
__device__ __forceinline__ f32x4 unpk4_fp8(unsigned w) { const f32x2 lo = __builtin_amdgcn_cvt_pk_f32_fp8((int)w, false), hi = __builtin_amdgcn_cvt_pk_f32_fp8((int)w, true); return (f32x4){lo.x, lo.y, hi.x, hi.y}; }
__device__ __forceinline__ int crow(int r, int hi) { return (r & 3) + 8 * (r >> 2) + 4 * hi; }

__device__ __forceinline__ int lane_id() { return (int)__builtin_amdgcn_mbcnt_hi(~0u, __builtin_amdgcn_mbcnt_lo(~0u, 0u)); }

struct Args { const float* in[42]; float* out; unsigned char* ws; int ph_lo, ph_hi; };
struct Frame {
    LAS unsigned char* lds;
    const float* const* in;
    float* out; unsigned char* ws;
    int tid, lane, wave, G, bid;
};
enum { I_X = 0, I_C, I_CTX, I_CCTX, I_MODW, I_MODB, I_N1G, I_N2G, I_WIN, I_WOUT, I_CONVW, I_CONVB, I_LLAM, I_LRW, I_LRB, I_LIW, I_LIB,
       I_QG, I_KG, I_LQ1, I_LK1, I_LQ2, I_LK2, I_SUBG, I_SARE, I_SAIM, I_SLOG, I_SBRE, I_SBIM, I_SCRE, I_SCIM, I_SD, I_GLUW, I_GLUB,
       I_RW, I_RB, I_EWG, I_EWU, I_EWD, I_SWG, I_SWU, I_SWD };

__device__ __forceinline__ int row_mi(int r) { return r < NCTX ? 4 : ((r - NCTX) >> 13); }
__device__ __forceinline__ bf16_t* xb0_ptr(const Frame& F, int r) { return (bf16_t*)F.out + (size_t)r * DM; }
__device__ __forceinline__ bf16_t* xb1_ptr(const Frame& F, int r) { return (bf16_t*)(F.ws + WS_HS5L) + (size_t)r * DM; }
__device__ __forceinline__ f32x4 bf4_to_f32(u32x2 w) { return (f32x4){bflo(w.x), bfhi(w.x), bflo(w.y), bfhi(w.y)}; }
__device__ __forceinline__ u32x2 f32_to_bf4(f32x4 v) { u32x2 w; w.x = cvt_pk_bf16(v.x, v.y); w.y = cvt_pk_bf16(v.z, v.w); return w; }
__device__ __forceinline__ const float* inrow_ptr(const Frame& F, int r) { return r < NCTX ? F.in[I_CTX] + (size_t)r * DM : F.in[I_X] + (size_t)(r - NCTX) * DM; }
__device__ __forceinline__ const float* modv(const Frame& F, int layer, int mi, int chunk) { return (const float*)(F.ws + WS_MODV) + ((size_t)(layer * 5 + mi) * 6 + chunk) * DM; }
namespace ge {
constexpr int BM = 256, BK = 64, HALF = 128, HTB = HALF * BK * 2, STAGE_BYTES = 8 * HTB, NXCD = 8, WGM = 8;
__host__ __device__ __forceinline__ int lds_byte(int r, int c) { const int st = (r >> 4) * 2 + (c >> 5), rr = r & 15, cc = c & 31, ob = rr * 64 + cc * 2; return st * 1024 + (ob ^ (((ob >> 9) & 1) << 5)); }
__host__ __device__ __forceinline__ void stage_rc(int b, int& R, int& C) { const int st = b / 1024, sb = b % 1024, swz = sb ^ (((sb >> 9) & 1) << 5); R = (st >> 1) * 16 + swz / 64; C = (st & 1) * 32 + (swz % 64) / 2; }

struct GUnit { const char* A; const char* B; const i32x2* rows; int pm, pn, aux, nvalid; };

struct StaticOrder {
    __device__ __forceinline__ const i32x2* dummy() const { return nullptr; }
    int nM, nN, nwg, G, c, base = 0, lim = 0x7fffffff; const char* A0; const char* B0; size_t tstepA, tstepB;
    __device__ void init(int nM_, int nN_, int G_, int c_, const void* A, size_t tsA, const void* B, size_t tsB) { nM = nM_; nN = nN_; nwg = nM * nN; G = G_; c = c_; A0 = (const char*)A; B0 = (const char*)B; tstepA = tsA; tstepB = tsB; }
    __device__ bool next(int i, GUnit& u) const {
        const long L = (long)base + (long)i * G + c; if (L >= nwg || L >= lim) return false;
        int wgid = (int)L; { const int q = nwg / NXCD, r = nwg % NXCD, xcd = wgid % NXCD, off = wgid / NXCD; wgid = (xcd < r ? xcd * (q + 1) : r * (q + 1) + (xcd - r) * q) + off; }
        const int nig = WGM * nN, gid = wgid / nig, fm = gid * WGM, gsz = (nM - fm) < WGM ? (nM - fm) : WGM;
        u.pm = fm + ((wgid % nig) % gsz); u.pn = (wgid % nig) / gsz; u.aux = 0; u.nvalid = 256; u.rows = nullptr;
        u.A = A0 + (size_t)u.pm * tstepA; u.B = B0 + (size_t)u.pn * tstepB; return true;
    }
};
__host__ __device__ __forceinline__ int perm32(int rho) { const int n = rho >> 4, i = rho & 15; return 8 * (i >> 2) + 4 * n + (i & 3); }
struct AMapPlain { unsigned lda2; __device__ __forceinline__ unsigned operator()(int R, int C) const { return (unsigned)R * lda2 + (unsigned)C * 2u; } };

template <class Epi, class Sched, class AMap, int GM, bool F8 = false>
__device__ __forceinline__ void gemm_run(LAS unsigned char* lds, const LAS int* rowl, const int nt, const unsigned ldb2, const unsigned hstepA, const size_t kstepA,
                                         const AMap amap, const unsigned lda2g, const Sched& S, const Epi& E, const int sw = 0x7f7f7f7f, const int sa = 0x7f7f7f7f) {
    int tid_ = threadIdx.x; asm volatile("" : "+v"(tid_));
    const int tid = tid_, wid = __builtin_amdgcn_readfirstlane(tid >> 6), lane = tid & 63, wr = wid >> 2, wc = wid & 3, fr = lane & 15, fq = lane >> 4;
    constexpr bool GATHER = GM != 0;
    unsigned voffA = 0, voffB, voffG[2][2] = {{0u, 0u}, {0u, 0u}}, nvoffG[2][2] = {{0u, 0u}, {0u, 0u}};
    int R0, C0; stage_rc(tid * 16, R0, C0);
    voffB = (unsigned)(Epi::PERM ? ((R0 & ~31) + perm32(R0 & 31)) : R0) * ldb2 + (unsigned)C0 * 2u;
    if (GM == 1) {
#pragma unroll
        for (int i = 0; i < 2; ++i) { voffG[0][i] = (unsigned)(rowl[R0 + 64 * i] >> 3) * lda2g + (unsigned)C0 * 2u; voffG[1][i] = (unsigned)(rowl[128 + R0 + 64 * i] >> 3) * lda2g + (unsigned)C0 * 2u; }
    } else if (GM == 0) voffA = amap(R0, C0);
    const unsigned qstepA = hstepA >> 1, qstepB = 64u * ldb2;
#define GE_ROWOFF(dst, U) do { int _t = threadIdx.x; asm volatile("" : "+v"(_t)); int _R, _C; stage_rc((_t & 511) * 16, _R, _C); \
        const bool _id = (U).rows == nullptr; const i32x2* _lp = _id ? (const i32x2*)S.dummy() : (U).rows; const int _nv = _id ? 256 : (U).nvalid; int _e[2][2]; \
        _Pragma("unroll") for (int _h = 0; _h < 2; ++_h) _Pragma("unroll") for (int _i = 0; _i < 2; ++_i) { const int _r = _h * 128 + _R + 64 * _i; _e[_h][_i] = _lp[_r < _nv ? _r : _nv - 1].x; } \
        _Pragma("unroll") for (int _h = 0; _h < 2; ++_h) _Pragma("unroll") for (int _i = 0; _i < 2; ++_i) { const int _r = _h * 128 + _R + 64 * _i; \
            const int _row = _id ? (U).aux + _r : (_e[_h][_i] >> 3); dst[_h][_i] = (unsigned)_row * lda2g + (unsigned)_C * 2u; } } while (0)
    const size_t kstepB = (size_t)(BK * 2);
    const unsigned hstepB = (unsigned)HALF * ldb2;
    const unsigned ldsw = (unsigned)wid * 1024u;
    const int aoff = lds_byte(wr * 64 + fr, F8 ? fq * 16 : fq * 8), boff = lds_byte(wc * 32 + fr, F8 ? fq * 16 : fq * 8);
    constexpr int KOFF = F8 ? 16 : 1024;
#define GE_SA(b, h) (((b) * 2 + (h)) * ge::HTB)
#define GE_SB(b, h) ((4 + (b) * 2 + (h)) * ge::HTB)
#define GE_STAGEB(bufoff, gbase) do { _Pragma("unroll") for (int _i = 0; _i < 2; ++_i) \
        __builtin_amdgcn_global_load_lds((const unsigned*)((const char*)(gbase) + (size_t)(_i * qstepB) + voffB), (LAS unsigned*)(lds + (bufoff) + ldsw + _i * 8192), 16, 0, 0); } while (0)
#define GE_STAGEA(bufoff, gbase, h, NX) do { _Pragma("unroll") for (int _i = 0; _i < 2; ++_i) { \
        const char* _p = GATHER ? (const char*)(gbase) + ((GM == 2 && (NX)) ? nvoffG[h][_i] : voffG[h][_i]) : (const char*)(gbase) + (size_t)((h) * hstepA + _i * qstepA) + voffA; \
        __builtin_amdgcn_global_load_lds((const unsigned*)_p, (LAS unsigned*)(lds + (bufoff) + ldsw + _i * 8192), 16, 0, 0); } } while (0)
#define GE_LDA(dst, b, h) do { _Pragma("unroll") for (int m = 0; m < 4; ++m) _Pragma("unroll") for (int k = 0; k < 2; ++k) dst[m][k] = *(const LAS bf16x8*)(lds + GE_SA(b, h) + aoff + m * 2048 + k * KOFF); } while (0)
#define GE_LDB(dst, b, h) do { _Pragma("unroll") for (int n = 0; n < 2; ++n) _Pragma("unroll") for (int k = 0; k < 2; ++k) dst[n][k] = *(const LAS bf16x8*)(lds + GE_SB(b, h) + boff + n * 2048 + k * KOFF); } while (0)
#define GE_MMA(ai, bj, At, Bt) do { __builtin_amdgcn_s_setprio(1); _Pragma("unroll") for (int m = 0; m < 4; ++m) _Pragma("unroll") for (int n = 0; n < 2; ++n) { \
        if constexpr (F8) { i32x8 _w, _x; { const bf16x8 _w0 = Bt[n][0], _w1 = Bt[n][1], _x0 = At[m][0], _x1 = At[m][1]; \
                const u32x4 _a = *reinterpret_cast<const u32x4*>(&_w0), _b = *reinterpret_cast<const u32x4*>(&_w1), _c = *reinterpret_cast<const u32x4*>(&_x0), _d = *reinterpret_cast<const u32x4*>(&_x1); \
                _w = (i32x8){(int)_a.x, (int)_a.y, (int)_a.z, (int)_a.w, (int)_b.x, (int)_b.y, (int)_b.z, (int)_b.w}; _x = (i32x8){(int)_c.x, (int)_c.y, (int)_c.z, (int)_c.w, (int)_d.x, (int)_d.y, (int)_d.z, (int)_d.w}; } \
              \
            asm volatile("v_mfma_scale_f32_16x16x128_f8f6f4 %0, %1, %2, %0, %3, %4 op_sel_hi:[0,0,0]" : "+v"(acc[ai][bj][m][n]) : "v"(_w), "v"(_x), "v"(sw), "v"(sa)); } \
        else { _Pragma("unroll") for (int k = 0; k < 2; ++k) acc[ai][bj][m][n] = __builtin_amdgcn_mfma_f32_16x16x32_bf16(Bt[n][k], At[m][k], acc[ai][bj][m][n], 0, 0, 0); } } \
        __builtin_amdgcn_s_setprio(0); } while (0)
#define GE_WAIT_V(n) asm volatile("s_waitcnt vmcnt(" #n ")" ::: "memory")
#define GE_WAIT_L(n) asm volatile("s_waitcnt lgkmcnt(" #n ")" ::: "memory")
#define GE_BAR __builtin_amdgcn_s_barrier()
#define GE_SCHED __builtin_amdgcn_sched_barrier(0)
    GUnit cur, nxt; int ui = 0;
    if (!S.next(0, cur)) return;
    f32x4 acc[2][2][4][2];
#pragma unroll
    for (int a = 0; a < 2; ++a)
#pragma unroll
        for (int b = 0; b < 2; ++b)
#pragma unroll
            for (int m = 0; m < 4; ++m)
#pragma unroll
                for (int n = 0; n < 2; ++n) acc[a][b][m][n] = (f32x4){0.f, 0.f, 0.f, 0.f};
    bf16x8 At[4][2], B0[2][2], B1[2][2];
    const char* cA = cur.A; const char* cB = cur.B;
    if (GM == 2) GE_ROWOFF(voffG, cur);
    GE_STAGEB(GE_SB(0, 0), cB); GE_STAGEB(GE_SB(0, 1), cB + hstepB); GE_STAGEA(GE_SA(0, 0), cA, 0, false); GE_STAGEA(GE_SA(0, 1), cA, 1, false);
    if (wr == 1) GE_BAR;
    GE_WAIT_V(2); GE_BAR;
    GE_STAGEB(GE_SB(1, 0), cB + kstepB); GE_STAGEA(GE_SA(1, 0), cA + kstepA, 0, false); GE_STAGEB(GE_SB(1, 1), cB + hstepB + kstepB);
    GE_WAIT_V(6); GE_BAR;
    for (;;) {
        const bool has_next = S.next(ui + 1, nxt);
        typename Epi::Pre pre = E.prefetch(cur, wr, fr);
        const char* nA = has_next ? nxt.A : cA; const char* nB = has_next ? nxt.B : cB;
        if (GM == 2) { if (has_next && nxt.pn == 0) GE_ROWOFF(nvoffG, nxt); else { _Pragma("unroll") for (int _h = 0; _h < 2; ++_h) _Pragma("unroll") for (int _i = 0; _i < 2; ++_i) nvoffG[_h][_i] = voffG[_h][_i]; } }
#pragma unroll 1
        for (int t = 0; t < nt; t += 2) {
            const bool last = (t == nt - 2);
            const char* a1 = cA + (size_t)(t + 1) * kstepA;
            const char* a2 = last ? nA : cA + (size_t)(t + 2) * kstepA; const char* b2 = last ? nB : cB + (size_t)(t + 2) * kstepB;
            const char* a3 = a2 + kstepA; const char* b3 = b2 + kstepB;
            GE_LDB(B0, 0, 0); GE_LDB(B1, 0, 1); GE_SCHED; GE_LDA(At, 0, 0); GE_STAGEA(GE_SA(1, 1), a1, 1, false);
            GE_WAIT_V(8); GE_WAIT_L(0); GE_BAR; GE_MMA(0, 0, At, B0); GE_MMA(0, 1, At, B1); GE_BAR; GE_SCHED;
            GE_LDA(At, 0, 1); GE_STAGEB(GE_SB(0, 0), b2); GE_STAGEB(GE_SB(0, 1), b2 + hstepB); GE_STAGEA(GE_SA(0, 0), a2, 0, last);
            GE_WAIT_V(8); GE_WAIT_L(0); GE_BAR; GE_MMA(1, 0, At, B0); GE_MMA(1, 1, At, B1); GE_BAR; GE_SCHED;
            GE_LDB(B0, 1, 0); GE_LDB(B1, 1, 1); GE_SCHED; GE_LDA(At, 1, 0); GE_STAGEA(GE_SA(0, 1), a2, 1, last);
            GE_WAIT_V(8); GE_WAIT_L(0); GE_BAR; GE_MMA(0, 0, At, B0); GE_MMA(0, 1, At, B1); GE_BAR; GE_SCHED;
            GE_LDA(At, 1, 1); GE_STAGEB(GE_SB(1, 0), b3); GE_STAGEB(GE_SB(1, 1), b3 + hstepB); GE_STAGEA(GE_SA(1, 0), a3, 0, last);
            GE_WAIT_V(8); GE_WAIT_L(0); GE_BAR; GE_MMA(1, 0, At, B0); GE_MMA(1, 1, At, B1); GE_BAR; GE_SCHED;
        }
        if constexpr (F8) asm volatile("s_nop 15\n\ts_nop 15" ::: "memory");
        if (wr == 0) GE_BAR;
        E(acc, cur, wr, wc, fr, fq, pre);
        if (!has_next) break;
#pragma unroll
        for (int a = 0; a < 2; ++a)
#pragma unroll
            for (int b = 0; b < 2; ++b)
#pragma unroll
                for (int m = 0; m < 4; ++m)
#pragma unroll
                    for (int n = 0; n < 2; ++n) acc[a][b][m][n] = (f32x4){0.f, 0.f, 0.f, 0.f};
        cur = nxt; cA = nA; cB = nB; ++ui;
        if (GM == 2) { _Pragma("unroll") for (int _h = 0; _h < 2; ++_h) _Pragma("unroll") for (int _i = 0; _i < 2; ++_i) voffG[_h][_i] = nvoffG[_h][_i]; }
        if (wr == 1) GE_BAR;
    }
    GE_WAIT_V(0);
    GE_BAR;
#undef GE_ROWOFF
#undef GE_SA
#undef GE_SB
#undef GE_STAGEA
#undef GE_STAGEB
#undef GE_LDA
#undef GE_LDB
#undef GE_MMA
#undef GE_WAIT_V
#undef GE_WAIT_L
#undef GE_BAR
#undef GE_SCHED
}
}
__device__ __forceinline__ int tr_dstrow(int n, int kind, int second) {
    if (kind == 1) { if (n < 1024 || n >= 2048) return n; const int tile = n & ~255, wi = n & 255, g = wi >> 6, d = wi & 63; return tile + 128 * (d >> 5) + 32 * g + 8 * ((d >> 2) & 3) + 4 * ((d >> 4) & 1) + (d & 3); }
    if (kind == 2) return (n >> 7) * 256 + (n & 127) + second * 128;
    return n;
}
__device__ __forceinline__ void tr_item(const float* W, int ldw, int K, bf16_t* WT, int kb, int nb, int kind, int second, LAS float* scr, int lane) {
    const int k0 = 64 * kb, n0 = 32 * nb;
#pragma unroll 8
    for (int i = 0; i < 32; ++i) { const int kk = 2 * i + (lane >> 5); scr[kk * 33 + (lane & 31)] = W[(size_t)(k0 + kk) * ldw + n0 + (lane & 31)]; }
    asm volatile("s_waitcnt lgkmcnt(0)" ::: "memory");
    const int c = lane & 7;
#pragma unroll
    for (int j = 0; j < 4; ++j) { const int n = (lane >> 3) + 8 * j; const LAS float* s = scr + (8 * c) * 33 + n;
        u32x4 o; o.x = cvt_pk_bf16(s[0 * 33], s[1 * 33]); o.y = cvt_pk_bf16(s[2 * 33], s[3 * 33]); o.z = cvt_pk_bf16(s[4 * 33], s[5 * 33]); o.w = cvt_pk_bf16(s[6 * 33], s[7 * 33]);
        *(u32x4*)(WT + (size_t)tr_dstrow(n0 + n, kind, second) * K + k0 + 8 * c) = o; }
    asm volatile("s_waitcnt lgkmcnt(0)" ::: "memory");
}
__device__ __forceinline__ void tr_item8(const float* W, int ldw, int K, unsigned char* WT, int kb, int nb, int kind, int second, float scale, LAS float* scr, int lane) {
    const int k0 = 64 * kb, n0 = 32 * nb;
#pragma unroll 8
    for (int i = 0; i < 32; ++i) { const int kk = 2 * i + (lane >> 5); scr[kk * 33 + (lane & 31)] = W[(size_t)(k0 + kk) * ldw + n0 + (lane & 31)] * scale; }
    asm volatile("s_waitcnt lgkmcnt(0)" ::: "memory");
    const int c = lane & 7;
#pragma unroll
    for (int j = 0; j < 4; ++j) { const int n = (lane >> 3) + 8 * j; const LAS float* s = scr + (8 * c) * 33 + n;
        u32x2 o; o.x = pk4_fp8(s[0 * 33], s[1 * 33], s[2 * 33], s[3 * 33]); o.y = pk4_fp8(s[4 * 33], s[5 * 33], s[6 * 33], s[7 * 33]);
        *(u32x2*)(WT + (size_t)tr_dstrow(n0 + n, kind, second) * K + k0 + 8 * c) = o; }
    asm volatile("s_waitcnt lgkmcnt(0)" ::: "memory");
}
__device__ __forceinline__ void conv_expert_item(Frame& F, int layer, int it, LAS float* scr) {
    const int e = it / 384, r = it % 384;
    unsigned char* wgu = F.ws + WS_EXP + (size_t)e * EXP_STRIDE; unsigned char* wd = F.ws + WS_EXP + (size_t)e * EXP_STRIDE + EXP_WD;
    const float *g, *u, *d;
    if (e < 64) { g = F.in[I_EWG] + ((size_t)layer * 64 + e) * 262144; u = F.in[I_EWU] + ((size_t)layer * 64 + e) * 262144; d = F.in[I_EWD] + ((size_t)layer * 64 + e) * 262144; }
    else { g = F.in[I_SWG] + (size_t)layer * 262144; u = F.in[I_SWU] + (size_t)layer * 262144; d = F.in[I_SWD] + (size_t)layer * 262144; }
    if (r < 128) tr_item8(g, 256, 1024, wgu, r / 8, r % 8, 2, 0, 64.f, scr, F.lane);
    else if (r < 256) tr_item8(u, 256, 1024, wgu, (r - 128) / 8, (r - 128) % 8, 2, 1, 64.f, scr, F.lane);
    else tr_item8(d, 1024, 256, wd, (r - 256) / 32, (r - 256) % 32, 0, 0, 32.f, scr, F.lane);
}
__device__ __forceinline__ void p0_prologue(Frame& F) {
    LAS float* sil = (LAS float*)(F.lds);
    for (int i = F.tid; i < 5 * 1024; i += NTHREADS) { const float v = i < 4096 ? F.in[I_C][i] : F.in[I_CCTX][i - 4096]; sil[i] = siluf_(v); }
    __syncthreads();
    LAS float* scr = (LAS float*)(F.lds + 32768 + F.wave * 8704);
    const int gw = F.bid * NWAVES + F.wave, NGW = F.G * NWAVES;
    constexpr int I_MOD = 2 * 96 * 8, I_WINI = 16 * 80, I_WOUTI = 16 * 32, I_GLUI = 16 * 32, I_EXPI = 65 * 384;
    constexpr int NITEMS = I_MOD + I_WINI + I_WOUTI + 2 * I_GLUI + I_EXPI;
    for (int it = gw; it < NITEMS; it += NGW) {
        int r = it;
        if (r < I_MOD) {
            const int kp = r & 7, rr = r >> 3, l = rr / 96, n = (rr % 96) * 64 + F.lane; const float* W = F.in[I_MODW] + ((size_t)l * 1024 + kp * 128) * 6144 + n;
            const LAS float* sl = sil + kp * 128;
            float a0 = 0.f, a1 = 0.f, a2 = 0.f, a3 = 0.f, a4 = 0.f;
#pragma unroll 16
            for (int k = 0; k < 128; ++k) { const float w = W[(size_t)k * 6144]; a0 += sl[k] * w; a1 += sl[1024 + k] * w; a2 += sl[2048 + k] * w; a3 += sl[3072 + k] * w; a4 += sl[4096 + k] * w; }
            float* mp = (float*)(F.ws + WS_BIG + BG_MODP) + ((size_t)kp * 2 + l) * 5 * 6144 + n;
            mp[0] = a0; mp[6144] = a1; mp[2 * 6144] = a2; mp[3 * 6144] = a3; mp[4 * 6144] = a4;
            continue; }
        r -= I_MOD;
        if (r < I_WINI) {
            if (r % 80 < 32) tr_item(F.in[I_WIN], 2560, 1024, (bf16_t*)(F.ws + WS_WIN), r / 80, r % 80, 1, 0, scr, F.lane);
            else tr_item8(F.in[I_WIN], 2560, 1024, F.ws + WS_WIN8 - (size_t)1024 * 1024, r / 80, r % 80, 1, 0, 64.f, scr, F.lane);
            continue; } r -= I_WINI;
        if (r < I_WOUTI) { tr_item(F.in[I_WOUT], 1024, 1024, (bf16_t*)(F.ws + WS_WOUT), r / 32, r % 32, 0, 0, scr, F.lane); continue; } r -= I_WOUTI;
        if (r < I_GLUI) { tr_item8(F.in[I_GLUW], 2048, 1024, F.ws + WS_GLU, r / 32, r % 32, 2, 0, 32.f, scr, F.lane); continue; } r -= I_GLUI;
        if (r < I_GLUI) { tr_item8(F.in[I_GLUW] + 1024, 2048, 1024, F.ws + WS_GLU, r / 32, r % 32, 2, 1, 32.f, scr, F.lane); continue; } r -= I_GLUI;
        conv_expert_item(F, 0, r, scr);
    }
    const int gt = F.bid * NTHREADS + F.tid, NGT = F.G * NTHREADS;
    float* rope = (float*)(F.ws + WS_ROPE);
    for (int i = gt; i < 192 * 16; i += NGT) {
        const int p = i >> 4, f = i & 15; const int pos = p < 128 ? p : p - 128;
        const float inv = powf(10000.0f, -(float)f / 16.0f); const float ang = (float)pos * inv; float s, c; sincosf(ang, &s, &c);
        if (p < 128) { rope[p * 16 + f] = c; rope[2048 + p * 16 + f] = s; } else { rope[4096 + (p - 128) * 16 + f] = c; rope[4096 + 1024 + (p - 128) * 16 + f] = s; }
    }
    bf16_t* lw = (bf16_t*)(F.ws + WS_LRUW);
    for (int i = gt; i < 2 * 2 * 8 * 64 * 64; i += NGT) {
        const int dd = i & 63, e = (i >> 6) & 63, n = (i >> 12) & 7, d = (i >> 15) & 1, type = i >> 16;
        const float* src = type ? F.in[I_LIW] : F.in[I_LRW];
        lw[i] = f2bf(src[((size_t)(d * 8 + n) * 64 + dd) * 64 + e]);
    }
    bf16_t* wrt = (bf16_t*)(F.ws + WS_WRT);
    for (int i = gt; i < 2 * 64 * 1024; i += NGT) {
        const int k = i & 1023, e = (i >> 10) & 63, l = i >> 16; const float w = F.in[I_RW][((size_t)l * 1024 + k) * 64 + e];
        const bf16_t h = f2bf(w); wrt[(size_t)(l * 2 + 0) * 65536 + e * 1024 + k] = h; wrt[(size_t)(l * 2 + 1) * 65536 + e * 1024 + k] = f2bf(w - bf2f(h)); }
    float* sp = (float*)(F.ws + WS_LRUSP);
    for (int i = gt; i < 1024; i += NGT) { const float lam = F.in[I_LLAM][i]; sp[i] = 8.0f * log1pf(expf(-lam)); }
}

__device__ __forceinline__ void p1_norm1(Frame& F) {
    const int gw = F.bid * NWAVES + F.wave, NGW = F.G * NWAVES;
    const float* mp = (const float*)(F.ws + WS_BIG + BG_MODP);
    { float* mv = (float*)(F.ws + WS_MODV);
      for (int i = F.bid * NTHREADS + F.tid; i < 2 * 5 * 6144; i += F.G * NTHREADS) { const int l = i / (5 * 6144), n = i % 6144; float s = F.in[I_MODB][l * 6144 + n];
#pragma unroll
          for (int kp = 0; kp < 8; ++kp) s += mp[(size_t)kp * 2 * 5 * 6144 + i];
          mv[i] = s; } }
    LAS float* lm = (LAS float*)F.lds;
    for (int i = F.tid; i < 5 * 2048; i += NTHREADS) { const int mi = i >> 11, n = i & 2047; float s = F.in[I_MODB][n];
#pragma unroll
        for (int kp = 0; kp < 8; ++kp) s += mp[((size_t)kp * 2 * 5 + mi) * 6144 + n];
        lm[i] = s; }
    __syncthreads();
    bf16_t* H0 = (bf16_t*)(F.ws + WS_ACT);
    const f32x4* gn = (const f32x4*)(F.in[I_N1G]) + F.lane;
    for (int r = gw; r < NROW; r += NGW) {
        const f32x4* xr = (const f32x4*)inrow_ptr(F, r) + F.lane; const int mi = row_mi(r);
        const LAS f32x4* sh = (const LAS f32x4*)(lm + mi * 2048) + F.lane; const LAS f32x4* sc = (const LAS f32x4*)(lm + mi * 2048 + 1024) + F.lane;
        f32x4 v[4]; float s = 0.f;
#pragma unroll
        for (int j = 0; j < 4; ++j) { v[j] = xr[64 * j]; s += (v[j].x * v[j].x + v[j].y * v[j].y) + (v[j].z * v[j].z + v[j].w * v[j].w); }
        const float rstd = rsqrtf(wave_sum(s) * (1.f / DM) + EPS);
        u32x2* o = (u32x2*)(H0 + (size_t)r * DM) + F.lane; unsigned* o8 = (unsigned*)(F.ws + WS_SCR + (size_t)r * DM) + F.lane;
#pragma unroll
        for (int j = 0; j < 4; ++j) { const f32x4 g = gn[64 * j], a = sc[64 * j], b = sh[64 * j];
            const f32x4 y = (v[j] * rstd) * g * (a + 1.0f) + b; u32x2 w; w.x = cvt_pk_bf16(y.x, y.y); w.y = cvt_pk_bf16(y.z, y.w); o[64 * j] = w; o8[64 * j] = pk4_fp8(8.f * y.x, 8.f * y.y, 8.f * y.z, 8.f * y.w); }
    }
}
#define EPI_LOOP_AM _Pragma("unroll") for (int ai = 0; ai < 2; ++ai) _Pragma("unroll") for (int m = 0; m < 4; ++m)
#define EPI_LOOP_BN _Pragma("unroll") for (int bj = 0; bj < 2; ++bj) _Pragma("unroll") for (int n = 0; n < 2; ++n)
typedef f32x4 acc_t[2][2][4][2];
struct NoPre {};
#define EPI_NOPRE using Pre = NoPre; __device__ __forceinline__ NoPre prefetch(const ge::GUnit&, int, int) const { return NoPre{}; }

struct EpiG1 {
    EPI_NOPRE
    static constexpr bool PERM = true;
    unsigned char* ws; const float* qg; const float* kg; int pnoff;
    __device__ __forceinline__ void operator()(const acc_t& acc, const ge::GUnit& u, int wr, int wc, int fr, int fq, const Pre& pre) const {
        const int pn = u.pn + pnoff, row0 = u.pm * 256 + wr * 64 + fr;
        if (pn >= 8) {
            unsigned char* vt = ws + WS_BIG + BG_V + ((size_t)(u.pm * 4 + wr) * 512 + (pn & 1) * 256 + wc * 32 + 8 * fq) * 64 + 4 * fr;
#pragma unroll
            for (int ai = 0; ai < 2; ++ai)
#pragma unroll
                for (int bj = 0; bj < 2; ++bj)
#pragma unroll
                    for (int n = 0; n < 2; ++n)
#pragma unroll
                        for (int i = 0; i < 4; ++i)
                            *(unsigned*)(vt + ((size_t)ai * 1024 + bj * 128 + n * 4 + i) * 64) =
                                pk4_fp8(acc[ai][bj][0][n][i] * 8.f, acc[ai][bj][1][n][i] * 8.f, acc[ai][bj][2][n][i] * 8.f, acc[ai][bj][3][n][i] * 8.f);
            return;
        }
        if (pn < 4) {
            bf16_t* dst = (bf16_t*)(ws + WS_BIG + (pn < 2 ? BG_GATE : BG_XA)); const int colb = (pn & 1) * 256 + wc * 32 + 8 * fq; const bool isg = pn < 2;
            EPI_LOOP_AM { bf16_t* rp = dst + (size_t)(row0 + ai * 128 + m * 16) * 512 + colb;
#pragma unroll
                for (int bj = 0; bj < 2; ++bj) { f32x4 v = acc[ai][bj][m][0], v2 = acc[ai][bj][m][1];
                    if (isg) { v.x = gelu_tanh(v.x); v.y = gelu_tanh(v.y); v.z = gelu_tanh(v.z); v.w = gelu_tanh(v.w); v2.x = gelu_tanh(v2.x); v2.y = gelu_tanh(v2.y); v2.z = gelu_tanh(v2.z); v2.w = gelu_tanh(v2.w); }
                    u32x4 w; w.x = cvt_pk_bf16(v.x, v.y); w.y = cvt_pk_bf16(v.z, v.w); w.z = cvt_pk_bf16(v2.x, v2.y); w.w = cvt_pk_bf16(v2.z, v2.w); *(u32x4*)(rp + bj * 128) = w; } }
            return;
        }
        const bool isk = pn >= 6; const float* gv = isk ? kg : qg;
        unsigned char* dst = ws + WS_BIG + (isk ? BG_K : BG_Q); const int colb = (2 * (pn & 1) + (wc >> 1)) * 128 + (wc & 1) * 64 + 4 * fq;
        const float qs = isk ? 8.0f : 16.f * 0.18033688011112042f;
        f32x4 g4[2][2];
        EPI_LOOP_BN g4[bj][n] = *(const f32x4*)(gv + 32 * bj + 16 * n + 4 * fq);
        const float* rope = (const float*)(ws + WS_ROPE);
        const bool lat = u.pm >= 4;
        EPI_LOOP_AM {
            const int row = row0 + ai * 128 + m * 16;
            float ss = 0.f;
            EPI_LOOP_BN { const f32x4 v = acc[ai][bj][m][n]; ss += (v.x * v.x + v.y * v.y) + (v.z * v.z + v.w * v.w); }
            ss += __shfl_xor(ss, 16); ss += __shfl_xor(ss, 32);
            const float rstd = rsqrtf(ss * (1.f / 64.f) + EPS) * qs;
            f32x4 y[2][2];
            EPI_LOOP_BN y[bj][n] = acc[ai][bj][m][n] * rstd * g4[bj][n];
            if (lat) {
                const int t = (row - NCTX) & (SEQ - 1); const int pr = t >> 6, pc = t & 63;
                const f32x4 c0 = *(const f32x4*)(rope + pr * 16 + 4 * fq), s0 = *(const f32x4*)(rope + 2048 + pr * 16 + 4 * fq);
                const f32x4 c1 = *(const f32x4*)(rope + 4096 + pc * 16 + 4 * fq), s1 = *(const f32x4*)(rope + 5120 + pc * 16 + 4 * fq);
                const f32x4 a0 = y[0][0] * c0 - y[0][1] * s0, b0 = y[0][1] * c0 + y[0][0] * s0;
                const f32x4 a1 = y[1][0] * c1 - y[1][1] * s1, b1 = y[1][1] * c1 + y[1][0] * s1;
                y[0][0] = a0; y[0][1] = b0; y[1][0] = a1; y[1][1] = b1;
            }
            unsigned char* rp = dst + (size_t)row * 512 + colb;
            EPI_LOOP_BN { const f32x4 v = y[bj][n]; *(unsigned*)(rp + 32 * bj + 16 * n) = pk4_fp8(v.x, v.y, v.z, v.w); }
        }
    }
};

struct EpiG2 {
    EPI_NOPRE
    static constexpr bool PERM = false;
    Frame F;
    __device__ __forceinline__ void operator()(const acc_t& acc, const ge::GUnit& u, int wr, int wc, int fr, int fq, const Pre& pre) const {
        const int row0 = u.pm * 256 + wr * 64 + fr, col0 = u.pn * 256 + wc * 32 + 4 * fq; const int mi = u.pm < 4 ? 4 : ((u.pm - 4) >> 5);
        const float* g1 = modv(F, 0, mi, 2) + col0;
        float* ssq = (float*)(F.ws + WS_BIG + BG_SSQ);
        f32x4 gg[2][2];
        EPI_LOOP_BN gg[bj][n] = *(const f32x4*)(g1 + bj * 128 + n * 16);
#pragma unroll
        for (int ai = 0; ai < 2; ++ai) {
            f32x4 xv[4][2][2];
#pragma unroll
            for (int m = 0; m < 4; ++m) { const float* xi = inrow_ptr(F, row0 + ai * 128 + m * 16) + col0;
                EPI_LOOP_BN xv[m][bj][n] = *(const f32x4*)(xi + bj * 128 + n * 16); }
            __builtin_amdgcn_sched_barrier(0);
#pragma unroll
            for (int m = 0; m < 4; ++m) { const int row = row0 + ai * 128 + m * 16; bf16_t* xo = xb0_ptr(F, row) + col0; float ss = 0.f;
                EPI_LOOP_BN { const f32x4 o = xv[m][bj][n] + gg[bj][n] * acc[ai][bj][m][n]; *(u32x2*)(xo + bj * 128 + n * 16) = f32_to_bf4(o);
                    ss += (o.x * o.x + o.y * o.y) + (o.z * o.z + o.w * o.w); }
                ss += __shfl_xor(ss, 16); ss += __shfl_xor(ss, 32);
                if (fq == 0) ssq[(size_t)row * 32 + u.pn * 4 + wc] = ss; }
        }
    }
};

struct EpiUp {
    EPI_NOPRE
    static constexpr bool PERM = true;
    unsigned char* hid;
    __device__ __forceinline__ void operator()(const acc_t& acc, const ge::GUnit& u, int wr, int wc, int fr, int fq, const Pre& pre) const {
        const int row0 = wr * 64 + fr, col0 = u.pn * 128 + wc * 32 + 8 * fq;
        unsigned char* base = hid + (size_t)u.pm * 65536;
        EPI_LOOP_AM { unsigned char* rp = base + (size_t)(row0 + ai * 128 + m * 16) * 256 + col0;
            const f32x4 g = acc[ai][0][m][0], up = acc[ai][1][m][0], g2 = acc[ai][0][m][1], up2 = acc[ai][1][m][1];
            u32x2 w; w.x = pk4_fp8(16.f * siluf_(g.x) * up.x, 16.f * siluf_(g.y) * up.y, 16.f * siluf_(g.z) * up.z, 16.f * siluf_(g.w) * up.w);
            w.y = pk4_fp8(16.f * siluf_(g2.x) * up2.x, 16.f * siluf_(g2.y) * up2.y, 16.f * siluf_(g2.z) * up2.z, 16.f * siluf_(g2.w) * up2.w); *(u32x2*)rp = w; }
    }
};
struct EpiDown {
    static constexpr bool PERM = true;
    struct Pre { i32x2 e[2][4]; };
    unsigned char* Y; int half_base;
    __device__ __forceinline__ Pre prefetch(const ge::GUnit& u, int wr, int fr) const {
        Pre p; const int row0 = wr * 64 + fr;
        EPI_LOOP_AM { const int rt = row0 + ai * 128 + m * 16;
            if (u.rows) p.e[ai][m] = u.rows[rt < u.nvalid ? rt : u.nvalid - 1]; else p.e[ai][m] = (i32x2){((u.aux + rt) << 3) | 6, 0x3f800000}; }
        return p; }
    __device__ __forceinline__ void operator()(const acc_t& acc, const ge::GUnit& u, int wr, int wc, int fr, int fq, const Pre& pre) const {
        const int row0 = wr * 64 + fr, col0 = u.pn * 256 + wc * 32 + 8 * fq;
        EPI_LOOP_AM { const int rt = row0 + ai * 128 + m * 16;
            if (rt < u.nvalid) { const int pk = pre.e[ai][m].x, mrow = pk >> 3, slot = pk & 7; const float gt = 32.f * __int_as_float(pre.e[ai][m].y);
                unsigned char* rp = Y + ((size_t)(mrow - half_base) * 7 + slot) * 1024 + col0;
#pragma unroll
                for (int bj = 0; bj < 2; ++bj) { const f32x4 v = acc[ai][bj][m][0] * gt, v2 = acc[ai][bj][m][1] * gt;
                    u32x2 w; w.x = pk4_fp8(v.x, v.y, v.z, v.w); w.y = pk4_fp8(v2.x, v2.y, v2.z, v2.w); *(u32x2*)(rp + bj * 128) = w; } } }
    }
};

struct EpiS5a {
    EPI_NOPRE
    static constexpr bool PERM = false;
    unsigned char* ws;
    __device__ __forceinline__ void operator()(const acc_t& acc, const ge::GUnit& u, int wr, int wc, int fr, int fq, const Pre& pre) const {
        const int g = u.aux, row0 = wr * 64 + fr, col0 = wc * 32 + 4 * fq; const bool isc = u.pm == 4;
        float* base = isc ? (float*)(ws + WS_BIG + BG_SLOCC) + (size_t)g * 32 * 256 : (float*)(ws + WS_BIG + BG_SLOCL) + ((size_t)g * 1024 + u.pm * 256) * 256;
        EPI_LOOP_AM { const int rt = row0 + ai * 128 + m * 16;
            if (!isc || rt < 32) { float* rp = base + (size_t)rt * 256 + col0;
                EPI_LOOP_BN *(f32x4*)(rp + bj * 128 + n * 16) = acc[ai][bj][m][n]; } }
    }
};
struct EpiS5b {
    EPI_NOPRE
    static constexpr bool PERM = true;
    unsigned char* ws;
    __device__ __forceinline__ void operator()(const acc_t& acc, const ge::GUnit& u, int wr, int wc, int fr, int fq, const Pre& pre) const {
        const int g = u.aux, row0 = u.pm * 256 + wr * 64 + fr, col0 = u.pn * 256 + wc * 32 + 8 * fq;
        unsigned char* base = ws + WS_BIG + BG_ZS5 + (size_t)g * 1024 * 512;
        EPI_LOOP_AM { unsigned char* rp = base + (size_t)(row0 + ai * 128 + m * 16) * 512 + col0;
#pragma unroll
            for (int bj = 0; bj < 2; ++bj) { const f32x4 v = acc[ai][bj][m][0], v2 = acc[ai][bj][m][1];
                u32x2 w; w.x = pk4_fp8(4.f * gelu_tanh(v.x), 4.f * gelu_tanh(v.y), 4.f * gelu_tanh(v.z), 4.f * gelu_tanh(v.w));
                w.y = pk4_fp8(4.f * gelu_tanh(v2.x), 4.f * gelu_tanh(v2.y), 4.f * gelu_tanh(v2.z), 4.f * gelu_tanh(v2.w)); *(u32x2*)(rp + bj * 128) = w; } }
    }
};
struct EpiGlu {
    EPI_NOPRE
    static constexpr bool PERM = false;
    Frame F;
    __device__ __forceinline__ void operator()(const acc_t& acc, const ge::GUnit& u, int wr, int wc, int fr, int fq, const Pre& pre) const {
        const int row0 = u.pm * 256 + wr * 64 + fr, col0 = u.pn * 128 + wc * 32 + 4 * fq; const int mi = u.pm >> 5;
        const float* g1 = modv(F, 1, mi, 2) + col0; const float* gb = F.in[I_GLUB] + col0;
        float* ssq = (float*)(F.ws + WS_BIG + BG_SSQ);
        f32x4 gg[2], bv[2], bg[2];
#pragma unroll
        for (int n = 0; n < 2; ++n) { gg[n] = *(const f32x4*)(g1 + n * 16); bv[n] = *(const f32x4*)(gb + n * 16); bg[n] = *(const f32x4*)(gb + 1024 + n * 16); }
        u32x2 xin[2][4][2];
        EPI_LOOP_AM { const bf16_t* xi = xb0_ptr(F, NCTX + row0 + ai * 128 + m * 16) + col0;
#pragma unroll
            for (int n = 0; n < 2; ++n) xin[ai][m][n] = *(const u32x2*)(xi + n * 16); }
        __builtin_amdgcn_sched_barrier(0);
        EPI_LOOP_AM { const int row = row0 + ai * 128 + m * 16; bf16_t* xo = xb1_ptr(F, row) + col0; float ss = 0.f;
#pragma unroll
            for (int n = 0; n < 2; ++n) { const f32x4 val = acc[ai][0][m][n] + bv[n], gt = acc[ai][1][m][n] + bg[n];
                f32x4 o; o.x = val.x * sigmoidf_(gt.x); o.y = val.y * sigmoidf_(gt.y); o.z = val.z * sigmoidf_(gt.z); o.w = val.w * sigmoidf_(gt.w);
                const f32x4 xn = bf4_to_f32(xin[ai][m][n]) + gg[n] * o; *(u32x2*)(xo + n * 16) = f32_to_bf4(xn); ss += (xn.x * xn.x + xn.y * xn.y) + (xn.z * xn.z + xn.w * xn.w); }
            ss += __shfl_xor(ss, 16); ss += __shfl_xor(ss, 32);
            if (fq == 0) ssq[(size_t)row * 32 + u.pn * 4 + wc] = ss; }
    }
};
constexpr int XCS = 520;
__device__ __forceinline__ void lru_consts(Frame& F) {
    LAS float* cst = (LAS float*)(F.lds + MISC_OFF + F.wave * 1536); const float* sp = (const float*)(F.ws + WS_LRUSP);
#pragma unroll
    for (int d = 0; d < 2; ++d) { const int ch = d * 512 + 64 * F.wave + F.lane; cst[(0 * 2 + d) * 64 + F.lane] = F.in[I_LRB][ch]; cst[(1 * 2 + d) * 64 + F.lane] = F.in[I_LIB][ch]; cst[(2 * 2 + d) * 64 + F.lane] = sp[ch]; }
    __syncthreads();
}
template <int CTRL, int RMASK> __device__ __forceinline__ float dpp_f(float old, float src) {
    return __int_as_float(__builtin_amdgcn_update_dpp(__float_as_int(old), __float_as_int(src), CTRL, RMASK, 0xf, false));
}
#define LRU_SCAN_STEP(CTRL, RM) do { _Pragma("unroll") for (int r = 0; r < 16; ++r) { const float a2 = dpp_f<CTRL, RM>(1.0f, av[r]), b2 = dpp_f<CTRL, RM>(0.0f, bv[r]); bv[r] = av[r] * b2 + bv[r]; av[r] = av[r] * a2; } } while (0)
template <bool FINAL>
__device__ __forceinline__ void lru_unit(Frame& F, int b, int cc) {
    const bool isctx = cc < 8;
    const int seg0 = isctx ? b * 256 : NCTX + b * 8192, segn = isctx ? 256 : 8192, t0 = isctx ? cc * 32 : (cc - 8) * 32;
    LAS bf16_t* xcl = (LAS bf16_t*)F.lds;
    {
        int tq = F.tid; asm volatile("" : "+v"(tq));
        const int tg = tq >> 6, c8 = (tq & 63) * 8; const float* cw = F.in[I_CONVW] + c8;
        const bf16_t* xa = (const bf16_t*)(F.ws + WS_BIG + BG_XA) + (size_t)seg0 * 512 + c8;
        u32x4 xin[7];
#pragma unroll
        for (int k = 0; k < 7; ++k) { const int tp = t0 + 4 * tg - 2 + k; xin[k] = (tp >= 0 && tp < segn) ? *(const u32x4*)(xa + (size_t)tp * 512) : (u32x4){0u, 0u, 0u, 0u}; }
        f32x4 w[4][2]; f32x4 cb[2];
#pragma unroll
        for (int k = 0; k < 4; ++k) { w[k][0] = *(const f32x4*)(cw + k * 512); w[k][1] = *(const f32x4*)(cw + k * 512 + 4); }
        cb[0] = *(const f32x4*)(F.in[I_CONVB] + c8); cb[1] = *(const f32x4*)(F.in[I_CONVB] + c8 + 4);
#pragma unroll
        for (int i = 0; i < 4; ++i) {
            f32x4 o0 = cb[0], o1 = cb[1];
#pragma unroll
            for (int k = 0; k < 4; ++k) { const u32x4 x = xin[i + k];
                o0 += w[k][0] * (f32x4){bflo(x.x), bfhi(x.x), bflo(x.y), bfhi(x.y)}; o1 += w[k][1] * (f32x4){bflo(x.z), bfhi(x.z), bflo(x.w), bfhi(x.w)}; }
            u32x4 ov; ov.x = cvt_pk_bf16(o0.x, o0.y); ov.y = cvt_pk_bf16(o0.z, o0.w); ov.z = cvt_pk_bf16(o1.x, o1.y); ov.w = cvt_pk_bf16(o1.z, o1.w);
            *(LAS u32x4*)(xcl + (4 * tg + i) * XCS + c8) = ov;
        }
    }
    __syncthreads();
    const int n = F.wave, r32 = F.lane & 31, hi = F.lane >> 5;
    const bf16_t* lw = (const bf16_t*)(F.ws + WS_LRUW);
    const LAS float* cst = (const LAS float*)(F.lds + MISC_OFF + n * 1536);
    const int row = seg0 + t0 + r32;
    const float* hin = (const float*)(F.ws + WS_BIG + BG_LHIN) + (size_t)(b * LRU_NCH + cc) * 2 * 512;
    f32x2* sm = (f32x2*)(F.ws + WS_BIG + BG_LSUM) + (size_t)(b * LRU_NCH + cc) * 2 * 512;
#pragma unroll
    for (int eb = 0; eb < 2; ++eb) {
        f32x16 ysum = {};
#pragma unroll
        for (int dd = 0; dd < 2; ++dd) {
            const int d = 1 - dd;
            const int tl = d ? 31 - r32 : r32;
            f32x16 av = {}, bv = {};
#pragma unroll
            for (int ks = 0; ks < 4; ++ks) {
                const bf16x8 xb = *(const LAS bf16x8*)(xcl + tl * XCS + 64 * n + 16 * ks + 8 * hi);
                const bf16x8 wr_ = *(const bf16x8*)(lw + ((size_t)((0 * 2 + d) * 8 + n) * 64 + 32 * eb + r32) * 64 + 16 * ks + 8 * hi);
                const bf16x8 wi_ = *(const bf16x8*)(lw + ((size_t)((1 * 2 + d) * 8 + n) * 64 + 32 * eb + r32) * 64 + 16 * ks + 8 * hi);
                av = __builtin_amdgcn_mfma_f32_32x32x16_bf16(wr_, xb, av, 0, 0, 0);
                bv = __builtin_amdgcn_mfma_f32_32x32x16_bf16(wi_, xb, bv, 0, 0, 0);
            }
#pragma unroll
            for (int r = 0; r < 16; ++r) {
                const int cl = 32 * eb + crow(r, hi);
                const float rg = sigmoidf_(av[r] + cst[(0 * 2 + d) * 64 + cl]), ig = sigmoidf_(bv[r] + cst[(1 * 2 + d) * 64 + cl]);
                const float la = -rg * cst[(2 * 2 + d) * 64 + cl]; const float a = __expf(la);
                const float x = bf2f(xcl[tl * XCS + 64 * n + cl]);
                av[r] = a; bv[r] = __builtin_amdgcn_sqrtf(fmaxf(fmaf(-a, a, 1.0f), 0.f)) * ig * x;
            }
            LRU_SCAN_STEP(0x111, 0xf); LRU_SCAN_STEP(0x112, 0xf); LRU_SCAN_STEP(0x114, 0xf); LRU_SCAN_STEP(0x118, 0xf); LRU_SCAN_STEP(0x142, 0xa);
            if constexpr (!FINAL) {
                if (r32 == 31) {
#pragma unroll
                    for (int r = 0; r < 16; ++r) sm[d * 512 + 64 * n + 32 * eb + crow(r, hi)] = (f32x2){av[r], bv[r]};
                }
            } else {
#pragma unroll
                for (int q = 0; q < 4; ++q) { const f32x4 hv = *(const f32x4*)(hin + d * 512 + 64 * n + 32 * eb + 8 * q + 4 * hi);
#pragma unroll
                    for (int i = 0; i < 4; ++i) { const float h = bv[4 * q + i] + av[4 * q + i] * hv[i];
                        if (d) ysum[4 * q + i] = __int_as_float(__builtin_amdgcn_ds_swizzle(__float_as_int(h), 0x7C1F));
                        else ysum[4 * q + i] += h; } }
            }
        }
        if constexpr (FINAL) {
            const bf16_t* gp = (const bf16_t*)(F.ws + WS_BIG + BG_GATE) + (size_t)row * 512; bf16_t* yo = (bf16_t*)(F.ws + WS_ACT) + (size_t)row * DM;
#pragma unroll
            for (int q = 0; q < 4; ++q) { const int ch0 = 64 * n + 32 * eb + 8 * q + 4 * hi; const u32x2 gw = *(const u32x2*)(gp + ch0);
                u32x2 w; w.x = cvt_pk_bf16(ysum[4 * q] * bflo(gw.x), ysum[4 * q + 1] * bfhi(gw.x)); w.y = cvt_pk_bf16(ysum[4 * q + 2] * bflo(gw.y), ysum[4 * q + 3] * bfhi(gw.y)); *(u32x2*)(yo + ch0) = w; }
        }
    }
    __syncthreads();
}
#undef LRU_SCAN_STEP
__device__ __forceinline__ void lru_carry(Frame& F) {
    for (int i = F.bid; i < 8; i += F.G) {
        const int b = i >> 1, d = i & 1, ch = F.tid;
        const f32x2* __restrict__ sm = (const f32x2*)(F.ws + WS_BIG + BG_LSUM) + (size_t)b * LRU_NCH * 1024 + d * 512 + ch;
        float* __restrict__ hin = (float*)(F.ws + WS_BIG + BG_LHIN) + (size_t)b * LRU_NCH * 1024 + d * 512 + ch;
        float h = 0.f;
#pragma unroll 1
        for (int k0 = 0; k0 < LRU_NCH; k0 += 24) {
            f32x2 st[24]; int cidx[24];
#pragma unroll
            for (int j = 0; j < 24; ++j) { const int k = k0 + j; const int cc = d == 0 ? k : (k < 8 ? 7 - k : LRU_NCH + 7 - k); cidx[j] = cc; st[j] = sm[(size_t)cc * 1024]; }
#pragma unroll
            for (int j = 0; j < 24; ++j) { hin[(size_t)cidx[j] * 1024] = h; h = st[j].x * h + st[j].y; }
        }
    }
}
namespace at {

#define AT_SBAR() __builtin_amdgcn_sched_barrier(0)
typedef __fp16 h16x2 __attribute__((ext_vector_type(2)));
__device__ __forceinline__ int pk4raw(float a, float b, float c, float d) {
    const h16x2 lo = __builtin_amdgcn_cvt_pkrtz(a, b), hi = __builtin_amdgcn_cvt_pkrtz(c, d);
    return (int)__builtin_amdgcn_perm(*reinterpret_cast<const unsigned*>(&hi), *reinterpret_cast<const unsigned*>(&lo), 0x07050301u);
}
__device__ __forceinline__ void exp_lo(f32x16& p0) {
#pragma unroll
    for (int r = 0; r < 16; ++r) p0[r] = __builtin_amdgcn_exp2f(p0[r]);
}
template <int ABL> __device__ __forceinline__ void finishSM(f32x16& p0, f32x16& p1, i32x8& pw) {
#pragma unroll
    for (int r = 0; r < 16; ++r) p1[r] = __builtin_amdgcn_exp2f(p1[r]);
#pragma unroll
    for (int a = 0; a < 4; ++a) { if (ABL == 4) { pw[a] = __float_as_int(p0[4 * a]) | __float_as_int(p0[4 * a + 2]); pw[4 + a] = __float_as_int(p1[4 * a + 1]) | __float_as_int(p1[4 * a + 3]); continue; }
        pw[a] = pk4raw(p0[4 * a], p0[4 * a + 1], p0[4 * a + 2], p0[4 * a + 3]); pw[4 + a] = pk4raw(p1[4 * a], p1[4 * a + 1], p1[4 * a + 2], p1[4 * a + 3]); }
}
__device__ __forceinline__ void qkt(f32x16& p0, f32x16& p1, const LAS char* Ks, const i32x8& qf, int o0, int o1) {
    const i32x4 a0 = *(const LAS i32x4*)(Ks + o0), a1 = *(const LAS i32x4*)(Ks + o1), b0 = *(const LAS i32x4*)(Ks + 2048 + o0), b1 = *(const LAS i32x4*)(Ks + 2048 + o1);
    const i32x8 k0 = {a0[0], a0[1], a0[2], a0[3], a1[0], a1[1], a1[2], a1[3]}, k1 = {b0[0], b0[1], b0[2], b0[3], b1[0], b1[1], b1[2], b1[3]};
    const f32x16 c = {};
    p0 = __builtin_amdgcn_mfma_scale_f32_32x32x64_f8f6f4(k0, qf, c, 0, 0, 0, 0x78787878, 0, 0x7f7f7f7f);
    p1 = __builtin_amdgcn_mfma_scale_f32_32x32x64_f8f6f4(k1, qf, c, 0, 0, 0, 0x78787878, 0, 0x7f7f7f7f);
}
__device__ __forceinline__ void pv_d0(f32x16* o, f32x16& la, const LAS char* Vs, const i32x8& pw, const i32x8& ones, int o0, int o1) {
#pragma unroll
    for (int d0 = 0; d0 < 4; ++d0) {
        const i32x4 a0 = *(const LAS i32x4*)(Vs + d0 * 2048 + o0), a1 = *(const LAS i32x4*)(Vs + d0 * 2048 + o1);
        const i32x8 vf = {a0[0], a0[1], a0[2], a0[3], a1[0], a1[1], a1[2], a1[3]};
        o[d0] = __builtin_amdgcn_mfma_scale_f32_32x32x64_f8f6f4(pw, vf, o[d0], 1, 0, 0, 0, 0, 0);
    }
    la = __builtin_amdgcn_mfma_scale_f32_32x32x64_f8f6f4(pw, ones, la, 1, 0, 0, 0, 0, 0);
}
__device__ __forceinline__ int krow(int b, int j) { return j < 4 ? b * 256 + 64 * j : NCTX + b * 8192 + 64 * (j - 4); }

constexpr int TILE_B = 12288, KOFF_B = 8192, NRING = 5, LI_OFF = NRING * TILE_B;
template <int ABL> __device__ __forceinline__ void attn_unit(Frame& F, int b, int h, int qrow0, int NT, float lam) {
    const int tid = F.tid, wid = F.wave, lane = F.lane, r32 = lane & 31, hi = lane >> 5;
    LAS char* lds = (LAS char*)F.lds;
    const char* Q = (const char*)(F.ws + WS_BIG + BG_Q); const char* K = (const char*)(F.ws + WS_BIG + BG_K); const char* V = (const char*)(F.ws + WS_BIG + BG_V);
    const int irow = wid * 16 + (lane >> 2), lch = ((lane & 3) ^ ((irow >> 2) & 3)) << 4;
    const unsigned voff = (unsigned)h * 8192u + (unsigned)irow * 64u + (unsigned)lch;
    unsigned koff;
    { const int rho = irow & 31, t = (irow >> 5) & 1, key = 16 * (rho & 3) + 8 * ((rho >> 2) & 1) + (rho >> 3) + 4 * t; koff = (unsigned)key * 512u + (unsigned)h * 128u + (unsigned)lch; }
    const int xo = (r32 >> 2) & 3, o0 = r32 * 64 + (((2 * hi) ^ xo) << 4), o1 = r32 * 64 + (((2 * hi + 1) ^ xo) << 4);
#define AT_WAITBAR(N) asm volatile("s_waitcnt vmcnt(" #N ")\n\ts_barrier" ::: "memory")
#define AT_ISSUE(j, LEAD) do { const int _k0 = krow(b, (j)); LAS char* _bf = lds + ((j) % NRING) * TILE_B; \
        __builtin_amdgcn_global_load_lds((const unsigned*)(V + (size_t)(_k0 >> 6) * 32768 + voff), (LAS unsigned*)(_bf + wid * 1024), 16, 0, 0); \
        if (LEAD) __builtin_amdgcn_global_load_lds((const unsigned*)(K + (size_t)_k0 * 512 + m * 64 + koff), (LAS unsigned*)(_bf + KOFF_B + wid * 1024), 16, 0, 0); } while (0)
#define AT_KB(j) (lds + ((j) % NRING) * TILE_B + KOFF_B)
#define AT_VB(j) (lds + ((j) % NRING) * TILE_B)
    i32x8 ones;
#pragma unroll
    for (int i = 0; i < 8; ++i) ones[i] = 0x38383838;
#pragma unroll 1
    for (int m = 0; m < 2; ++m) {
        f32x16 la = {}; f32x16 o[4] = {}; i32x8 qf;
        { const char* Qw = Q + (size_t)(qrow0 + wid * 32 + r32) * 512 + h * 128 + m * 64 + hi * 32;
          const i32x4 q0 = *(const i32x4*)Qw, q1 = *(const i32x4*)(Qw + 16); qf = (i32x8){q0[0], q0[1], q0[2], q0[3], q1[0], q1[1], q1[2], q1[3]}; }
        asm volatile("s_waitcnt vmcnt(0)" ::: "memory");
        f32x16 pA0, pA1, pB0, pB1; i32x8 pw;
        __syncthreads();
        if (wid < 4) {
            AT_ISSUE(0, true); AT_ISSUE(1, true);
            AT_WAITBAR(2); AT_ISSUE(2, true);
            qkt(pA0, pA1, AT_KB(0), qf, o0, o1); exp_lo(pA0);
            for (int j = 1; j + 1 < NT; j += 2) {
                AT_WAITBAR(2); AT_ISSUE(j + 2, true);
                AT_SBAR(); qkt(pB0, pB1, AT_KB(j), qf, o0, o1);
                finishSM<ABL>(pA0, pA1, pw); AT_SBAR();
                pv_d0(o, la, AT_VB(j - 1), pw, ones, o0, o1); exp_lo(pB0);
                AT_WAITBAR(2); if (j + 3 < NT) AT_ISSUE(j + 3, true);
                AT_SBAR(); qkt(pA0, pA1, AT_KB(j + 1), qf, o0, o1);
                finishSM<ABL>(pB0, pB1, pw); AT_SBAR();
                pv_d0(o, la, AT_VB(j), pw, ones, o0, o1); exp_lo(pA0);
            }
            AT_WAITBAR(0);
            AT_SBAR(); qkt(pB0, pB1, AT_KB(NT - 1), qf, o0, o1);
            finishSM<ABL>(pA0, pA1, pw); AT_SBAR();
            pv_d0(o, la, AT_VB(NT - 2), pw, ones, o0, o1); exp_lo(pB0);
            finishSM<ABL>(pB0, pB1, pw); AT_SBAR();
            pv_d0(o, la, AT_VB(NT - 1), pw, ones, o0, o1);
        } else {
            AT_ISSUE(0, false); AT_ISSUE(1, false);
            AT_WAITBAR(1); AT_ISSUE(2, false);
            qkt(pA0, pA1, AT_KB(0), qf, o0, o1);
            for (int j = 1; j + 1 < NT; j += 2) {
                AT_WAITBAR(1); AT_ISSUE(j + 2, false);
                AT_SBAR(); if (j >= 2) pv_d0(o, la, AT_VB(j - 2), pw, ones, o0, o1);
                exp_lo(pA0); AT_SBAR();
                qkt(pB0, pB1, AT_KB(j), qf, o0, o1);
                finishSM<ABL>(pA0, pA1, pw);
                AT_WAITBAR(1); if (j + 3 < NT) AT_ISSUE(j + 3, false);
                AT_SBAR(); pv_d0(o, la, AT_VB(j - 1), pw, ones, o0, o1);
                exp_lo(pB0); AT_SBAR();
                qkt(pA0, pA1, AT_KB(j + 1), qf, o0, o1);
                finishSM<ABL>(pB0, pB1, pw);
            }
            AT_WAITBAR(0);
            AT_SBAR(); pv_d0(o, la, AT_VB(NT - 3), pw, ones, o0, o1);
            exp_lo(pA0); AT_SBAR();
            qkt(pB0, pB1, AT_KB(NT - 1), qf, o0, o1);
            finishSM<ABL>(pA0, pA1, pw); AT_SBAR();
            pv_d0(o, la, AT_VB(NT - 2), pw, ones, o0, o1); exp_lo(pB0);
            finishSM<ABL>(pB0, pB1, pw); AT_SBAR();
            pv_d0(o, la, AT_VB(NT - 1), pw, ones, o0, o1);
        }
        int tid2 = tid; asm volatile("" : "+v"(tid2));
        f32x4* stash = (f32x4*)(F.ws + WS_SCR) + ((size_t)F.bid * NTHREADS + tid2) * 16;
        if (m == 0) {
#pragma unroll
            for (int q = 0; q < 4; ++q) {
                const float r0 = 0.125f * __builtin_amdgcn_rcpf(la[4 * q]), r1 = 0.125f * __builtin_amdgcn_rcpf(la[4 * q + 1]), r2 = 0.125f * __builtin_amdgcn_rcpf(la[4 * q + 2]), r3 = 0.125f * __builtin_amdgcn_rcpf(la[4 * q + 3]);
#pragma unroll
                for (int d0 = 0; d0 < 4; ++d0) stash[d0 * 4 + q] = (f32x4){o[d0][4 * q] * r0, o[d0][4 * q + 1] * r1, o[d0][4 * q + 2] * r2, o[d0][4 * q + 3] * r3};
                asm volatile("" ::: "memory");
            }
        } else {
            const float* sg = F.in[I_SUBG];
            float g4[4];
#pragma unroll
            for (int d0 = 0; d0 < 4; ++d0) g4[d0] = sg[d0 * 32 + r32] * 0.8f;
            const int l2 = tid2 & 63;
            bf16_t* rp = (bf16_t*)(F.ws + WS_ACT) + (size_t)(qrow0 + wid * 32 + 4 * (l2 >> 5)) * DM + 512 + h * 128 + (l2 & 31);
#pragma unroll
            for (int q = 0; q < 4; ++q) {
                f32x4 st[4];
#pragma unroll
                for (int d0 = 0; d0 < 4; ++d0) st[d0] = stash[d0 * 4 + q];
#pragma unroll
                for (int i = 0; i < 4; ++i) { const int r = 4 * q + i; const float rl = 0.125f * __builtin_amdgcn_rcpf(la[r]);
                    float v[4], ss = 0.f;
#pragma unroll
                    for (int d0 = 0; d0 < 4; ++d0) { v[d0] = st[d0][i] - lam * (o[d0][r] * rl); ss += v[d0] * v[d0]; }
                    ss += __shfl_xor(ss, 1); ss += __shfl_xor(ss, 2); ss += __shfl_xor(ss, 4); ss += __shfl_xor(ss, 8); ss += __shfl_xor(ss, 16);
                    const float rstd = rsqrtf(ss * (1.f / 128.f) + EPS);
#pragma unroll
                    for (int d0 = 0; d0 < 4; ++d0) rp[(size_t)i * DM + d0 * 32] = f2bf(v[d0] * rstd * g4[d0]); }
                rp += 8 * DM;
                asm volatile("" : "+v"(rp) :: "memory");
            }
        }
    }
#undef AT_WAITBAR
#undef AT_LWAIT
#undef AT_ISSUE
#undef AT_KB
#undef AT_VB
#undef AT_SBAR
}
}
struct MoeGeo { int layer, NR, HR, UR; };
__device__ __forceinline__ MoeGeo moe_geo(int layer) { MoeGeo g; g.layer = layer; g.NR = layer ? NLAT : NROW; g.HR = g.NR; g.UR = g.NR / 256; return g; }
__device__ __forceinline__ bf16_t* moe_xrow(const Frame& F, int layer, int mrow) { return layer ? xb1_ptr(F, mrow) : xb0_ptr(F, mrow); }
__device__ __forceinline__ int moe_mi(int layer, int mrow) { return layer ? (mrow >> 13) : row_mi(mrow); }

__device__ __forceinline__ void router_phase(Frame& F, int layer) {
    const MoeGeo G = moe_geo(layer);
    LAS float* rs = (LAS float*)F.lds;
    LAS float* lgt = (LAS float*)(F.lds + 1024) + F.wave * 1024;
    LAS int* selE = (LAS int*)(F.lds + 65536);
    LAS float* selG = (LAS float*)(F.lds + 65536 + 4096);
    LAS int* selP = (LAS int*)(F.lds + 65536 + 8192);
    LAS int* hist = (LAS int*)(F.lds + 65536 + 12288);
    LAS int* basev = hist + 64;
    unsigned char* H2 = F.ws + WS_ACT;
    const bf16_t* wh = (const bf16_t*)(F.ws + WS_WRT) + (size_t)(layer * 2) * 65536; const bf16_t* wl = wh + 65536;
    const float* rb = F.in[I_RB] + layer * 64;
    const float* gn = F.in[I_N2G] + layer * DM;
    int* cnt = (int*)(F.ws + WS_CTL) + layer * 128;
    i32x2* list = (i32x2*)(F.ws + WS_LIST);
    const int w = F.wave, e = F.lane, fr = F.lane & 15, kq = F.lane >> 4;
    for (int unit = F.bid; unit < 256; unit += F.G) {
        const int half = 0, mrow0 = unit * G.UR;
        if (F.tid < 64) hist[F.tid] = 0;
        { const float* ssq = (const float*)(F.ws + WS_BIG + BG_SSQ); const int np = layer ? 32 : 16;
          for (int lr = w; lr < G.UR; lr += NWAVES) { const int mrow = mrow0 + lr; float s = F.lane < np ? ssq[(size_t)mrow * 32 + F.lane] : 0.f;
              s = wave_sum(s); if (F.lane == 0) rs[lr] = rsqrtf(s * (1.f / DM) + EPS); } }
        const int miA = moe_mi(layer, mrow0), miB = moe_mi(layer, mrow0 + G.UR - 1);
        LAS float* tab = (LAS float*)(F.lds + 36864);
        for (int i = F.tid; i < 2048; i += NTHREADS) { const int sl = i >> 10, k = i & 1023, mi = sl ? miB : miA;
            tab[sl * 2048 + k] = gn[k] * (modv(F, layer, mi, 4)[k] + 1.0f); tab[sl * 2048 + 1024 + k] = modv(F, layer, mi, 3)[k]; }
        __syncthreads();
        for (int g0 = 16 * w; g0 < G.UR; g0 += 16 * NWAVES) {
            const int nrow = (G.UR - g0) < 16 ? (G.UR - g0) : 16; const bool rok = fr < nrow;
            const int lrow = g0 + (rok ? fr : nrow - 1), mrow = mrow0 + lrow, mi = moe_mi(layer, mrow);
            const bf16_t* xp = moe_xrow(F, layer, mrow) + 8 * kq; const float rstd = rs[lrow];
            const LAS float* tp = tab + (mi == miA ? 0 : 2048) + 8 * kq;
            unsigned char* hp = H2 + (size_t)mrow * DM + 8 * kq;
            const bf16_t* whp = wh + (size_t)fr * 1024 + 8 * kq;
            f32x4 acc[4];
#pragma unroll
            for (int i = 0; i < 4; ++i) acc[i] = (f32x4){0.f, 0.f, 0.f, 0.f};
            u32x4 xring[8];
#pragma unroll
            for (int i = 0; i < 8; ++i) xring[i] = *(const u32x4*)(xp + 32 * i);
#pragma unroll 1
            for (int ks8 = 0; ks8 < 32; ks8 += 8) {
#pragma unroll
                for (int ki = 0; ki < 8; ++ki) {
                    const int k0 = 32 * (ks8 + ki);
                    const u32x4 xw = xring[ki]; if (ks8 + 8 < 32) xring[ki] = *(const u32x4*)(xp + k0 + 256);
                    const f32x4 x0 = bf4_to_f32((u32x2){xw.x, xw.y}), x1 = bf4_to_f32((u32x2){xw.z, xw.w});
                    const f32x4 a0 = *(const LAS f32x4*)(tp + k0), a1 = *(const LAS f32x4*)(tp + k0 + 4), b0 = *(const LAS f32x4*)(tp + 1024 + k0), b1 = *(const LAS f32x4*)(tp + 1024 + k0 + 4);
                    const f32x4 y0 = (x0 * rstd) * a0 + b0, y1 = (x1 * rstd) * a1 + b1;
                    u32x4 hv; hv.x = cvt_pk_bf16(y0.x, y0.y); hv.y = cvt_pk_bf16(y0.z, y0.w); hv.z = cvt_pk_bf16(y1.x, y1.y); hv.w = cvt_pk_bf16(y1.z, y1.w);
                    if (rok) { u32x2 h8; h8.x = pk4_fp8(y0.x, y0.y, y0.z, y0.w); h8.y = pk4_fp8(y1.x, y1.y, y1.z, y1.w); *(u32x2*)(hp + k0) = h8; }
                    const bf16x8 ah = *reinterpret_cast<const bf16x8*>(&hv);
#pragma unroll
                    for (int blk = 0; blk < 4; ++blk) { const bf16x8 bh = *(const bf16x8*)(whp + (size_t)blk * 16 * 1024 + k0);
                        acc[blk] = __builtin_amdgcn_mfma_f32_16x16x32_bf16(ah, bh, acc[blk], 0, 0, 0); }
                }
            }
#pragma unroll
            for (int blk = 0; blk < 4; ++blk)
#pragma unroll
                for (int r = 0; r < 4; ++r) lgt[(4 * kq + r) * 64 + 16 * blk + fr] = acc[blk][r];
            asm volatile("s_waitcnt lgkmcnt(0)" ::: "memory");
            const float bias = rb[e];
            for (int rr = 0; rr < nrow; ++rr) {
                const float lg = lgt[rr * 64 + e];
                const float aff = 1.0f / (1.0f + expf(-lg)); const float scv = aff + bias;
                int rank = 0;
#pragma unroll 8
                for (int j = 0; j < 64; ++j) { const float sj = __shfl(scv, j); rank += (sj > scv || (sj == scv && j < e)) ? 1 : 0; }
                const bool sel = rank < 6; const float ssum = wave_sum(sel ? aff : 0.f);
                if (sel) { const int idx = (g0 + rr) * 6 + rank; selE[idx] = e; selG[idx] = aff / ssum * 2.5f; selP[idx] = atomicAdd((int*)&hist[e], 1); }
            }
            asm volatile("s_waitcnt lgkmcnt(0)" ::: "memory");
        }
        __syncthreads();
        if (F.tid < 64) basev[F.tid] = atomicAdd(&cnt[half * 64 + F.tid], hist[F.tid]);
        __syncthreads();
        for (int idx = F.tid; idx < G.UR * 6; idx += NTHREADS) { const int ee = selE[idx], lrow = idx / 6, slot = idx - lrow * 6, mrow = mrow0 + lrow;
            list[(size_t)(half * 64 + ee) * CAPH + basev[ee] + selP[idx]] = (i32x2){mrow * 8 + slot, __float_as_int(selG[idx])};
            ((float*)(F.ws + WS_GATE))[(size_t)mrow * 8 + slot] = selG[idx]; }
        __syncthreads();
    }
}

__device__ __forceinline__ void moe_table(Frame& F, const int* cnt) {
    LAS int* tstart = (LAS int*)(F.lds + MISC_OFF); LAS int* tcnt = tstart + 64;
    if (F.wave == 0) { const int c = cnt[F.lane]; const int nt = (c + 255) >> 8; int incl = nt;
#pragma unroll
        for (int o = 1; o < 64; o <<= 1) { const int v = __shfl_up(incl, o); if (F.lane >= o) incl += v; }
        tstart[F.lane] = incl - nt; tcnt[F.lane] = c; }
    __syncthreads();
}
struct SchedMoe { int G, c, nsh, npn, half_base; const LAS int* tstart; const i32x2* list; const char* A0; const char* W0; size_t wofs, tstepB, astep;
    __device__ __forceinline__ const i32x2* dummy() const { return list; }
    __device__ __forceinline__ bool next(int k, ge::GUnit& u) const {
        const int T = (k / npn) * G + c, pn = k % npn;
        int e = 64, j = T, nv = 256;
        if (T >= nsh) { const int rem = T - nsh, l = lane_id() & 63; const int st = tstart[l], cn_l = tstart[64 + l];
            const unsigned long long m = __ballot(rem >= st && rem < st + ((cn_l + 255) >> 8));
            if (m == 0ull) return false;
            e = __builtin_ctzll(m); j = rem - tstart[e]; const int cn = tstart[64 + e]; nv = (cn - j * 256) < 256 ? (cn - j * 256) : 256; }
        u.pm = T; u.pn = pn; u.nvalid = nv; u.rows = e == 64 ? nullptr : list + (size_t)e * CAPH + j * 256; u.aux = e == 64 ? half_base + j * 256 : 0;
        u.A = A0 + (size_t)T * astep; u.B = W0 + (size_t)e * EXP_STRIDE + wofs + (size_t)pn * tstepB; return true; }
};
__device__ __forceinline__ void moe_up(Frame& F, int layer, int half) {
    const MoeGeo G = moe_geo(layer);
    moe_table(F, (const int*)(F.ws + WS_CTL) + layer * 128 + half * 64);
    const int cs = (F.G % 8 == 0) ? (F.bid % 8) * (F.G / 8) + F.bid / 8 : F.bid;
    SchedMoe S{F.G, cs, G.HR / 256, 2, half * G.HR, (const LAS int*)(F.lds + MISC_OFF), (const i32x2*)(F.ws + WS_LIST) + (size_t)half * 64 * CAPH,
               (const char*)(F.ws + WS_ACT), (const char*)(F.ws + WS_EXP), (size_t)0, (size_t)256 * 1024, (size_t)0};
    EpiUp E{F.ws + WS_SCR};
    ge::gemm_run<EpiUp, SchedMoe, ge::AMapPlain, 2, true>(F.lds, nullptr, 8, 1024u, 0u, (size_t)128, ge::AMapPlain{1024u}, 1024u, S, E, 0x79797979, 0x7f7f7f7f);
}
__device__ __forceinline__ void moe_down(Frame& F, int layer, int half) {
    const MoeGeo G = moe_geo(layer);
    moe_table(F, (const int*)(F.ws + WS_CTL) + layer * 128 + half * 64);
    const int cs = (F.G % 8 == 0) ? (F.bid % 8) * (F.G / 8) + F.bid / 8 : F.bid;
    SchedMoe S{F.G, cs, G.HR / 256, 4, half * G.HR, (const LAS int*)(F.lds + MISC_OFF), (const i32x2*)(F.ws + WS_LIST) + (size_t)half * 64 * CAPH,
               (const char*)(F.ws + WS_SCR), (const char*)(F.ws + WS_EXP), (size_t)EXP_WD, (size_t)256 * 256, (size_t)256 * 256};
    EpiDown E{F.ws + WS_BIG, half * G.HR};
    ge::gemm_run<EpiDown, SchedMoe, ge::AMapPlain, 0, true>(F.lds, nullptr, 2, 256u, 128u * 256u, (size_t)128, ge::AMapPlain{256u}, 0u, S, E, 0x7a7a7a7a, 0x7b7b7b7b);
}

struct DTile { int e, nv, valid, aux, j; };
__device__ __forceinline__ DTile down_tile(int T, int nsh, const LAS int* tstart) {
    DTile t; t.e = 64; t.nv = 256; t.valid = 1; t.j = T;
    if (T >= nsh) { const int rem = T - nsh, l = lane_id() & 63; const int st = tstart[l], cn_l = tstart[64 + l];
        const unsigned long long m = __ballot(rem >= st && rem < st + ((cn_l + 255) >> 8));
        if (m == 0ull) { t.valid = 0; t.aux = 0; return t; }
        t.e = __builtin_ctzll(m); t.j = __builtin_amdgcn_readfirstlane(rem - tstart[t.e]); const int cn = __builtin_amdgcn_readfirstlane(tstart[64 + t.e]); t.nv = (cn - t.j * 256) < 256 ? (cn - t.j * 256) : 256; }
    t.aux = t.e == 64 ? t.j * 256 : 0;
    return t;
}
#ifndef D2_LOCKSTEP
#define D2_LOCKSTEP 0
#endif
template <int ABL> __device__ __forceinline__ void moe_down2(Frame& F, int layer) {
    const MoeGeo G = moe_geo(layer);
    moe_table(F, (const int*)(F.ws + WS_CTL) + layer * 128);
    const int cs = (F.G % 8 == 0) ? (F.bid % 8) * (F.G / 8) + F.bid / 8 : F.bid;
    const LAS int* tstart = (const LAS int*)(F.lds + MISC_OFF);
    const i32x2* list = (const i32x2*)(F.ws + WS_LIST);
    const int nsh = G.HR / 256;
    int tid_ = threadIdx.x; asm volatile("" : "+v"(tid_));
    const int tid = tid_, wid = __builtin_amdgcn_readfirstlane(tid >> 6), lane = tid & 63, grp = wid >> 2, w4 = wid & 3, fr = lane & 15, fq = lane >> 4;
    int ntl = 0; while (down_tile(ntl * F.G + cs, nsh, tstart).valid) ++ntl;
    const int Q = 8 * ntl;
    if (Q == 0) return;
    LAS char* hbuf = (LAS char*)F.lds; LAS char* bbuf = (LAS char*)F.lds + 65536 + grp * 32768; LAS char* ebuf = (LAS char*)F.lds + MISC_OFF + 1024 + wid * 512;
    const unsigned char* HID = F.ws + WS_SCR; const unsigned char* W0 = F.ws + WS_EXP + EXP_WD; unsigned char* Y = F.ws + WS_BIG;
    unsigned xsrc[4];
#pragma unroll
    for (int i = 0; i < 4; ++i) xsrc[i] = (unsigned)fq * 256u + 16u * (unsigned)((lane & 15) ^ (4 * i + fq));
    int wof[2][2];
#pragma unroll
    for (int ks = 0; ks < 2; ++ks)
#pragma unroll
        for (int j = 0; j < 2; ++j) wof[ks][j] = fr * 256 + 16 * ((8 * ks + 2 * fq + j) ^ fr);
    const int sw = 0x7d7d7d7d, sa = 0x7b7b7b7b;
    f32x4 acc[4][4];
    i32x8 hf[4][2];
    i32x2 ent[4];
    DTile cur = down_tile(cs, nsh, tstart), nx = cur;
    u32x4 pw[4]; int ph = -1;
#define D2_DMAH(TI, K) do { const unsigned char* _hp = HID + (size_t)((K) * F.G + cs) * 65536 + (size_t)(32 * wid) * 256; \
        _Pragma("unroll") for (int _i = 0; _i < 8; ++_i) \
            __builtin_amdgcn_global_load_lds((const unsigned*)(_hp + _i * 1024 + xsrc[_i & 3]), (LAS unsigned*)(hbuf + wid * 8192 + _i * 1024), 16, 0, 0); \
        if ((TI).e != 64 && lane < 32) __builtin_amdgcn_global_load_lds((const unsigned*)((const char*)(list + (size_t)(TI).e * CAPH + (TI).j * 256 + 64 * w4) + lane * 16), (LAS unsigned*)ebuf, 16, 0, 0); } while (0)
#define D2_DMA(QQ, TI) do { const unsigned char* _wb = W0 + (size_t)(TI).e * EXP_STRIDE + (size_t)((((QQ) & 7) * 2 + grp) * 64 + 4 * w4) * 256; LAS char* _lb = bbuf + ((QQ) & 1) * 16384 + w4 * 4096; \
        _Pragma("unroll") for (int _i = 0; _i < 4; ++_i) \
            __builtin_amdgcn_global_load_lds((const unsigned*)(_wb + _i * 4096 + xsrc[_i]), (LAS unsigned*)(_lb + _i * 1024), 16, 0, 0); } while (0)
    D2_DMAH(cur, 0);
    D2_DMA(0, cur); D2_DMA(1, cur);
#pragma unroll 1
    for (int s = 0; s <= 2 * Q; ++s) {
        const int u = D2_LOCKSTEP ? s : s - grp; const bool act = u >= 0 && u < 2 * Q; const int q = u >> 1; const bool mf = act && !(u & 1), ep = act && (u & 1);
        if (ABL == 5) asm volatile("s_waitcnt vmcnt(30)" ::: "memory"); else
        if (act && q + 1 < Q) asm volatile("s_waitcnt vmcnt(4)" ::: "memory"); else asm volatile("s_waitcnt vmcnt(0)" ::: "memory");
        if (ABL != 6) __builtin_amdgcn_s_barrier();
#define D2_FLUSH() do { if (ABL == 4) { _Pragma("unroll") for (int _m = 0; _m < 4; ++_m) asm volatile("" :: "v"(pw[_m])); ph = -1; } if (ph >= 0 && ABL != 1) { _Pragma("unroll") for (int _m = 0; _m < 4; ++_m) { const int _rt = 64 * w4 + 16 * _m + fr; \
            if (_rt < cur.nv) { const int _pk = ent[_m].x; *(u32x4*)(Y + ((size_t)(_pk >> 3) * 7 + (_pk & 7)) * 1024 + ph * 64 + 16 * fq) = pw[_m]; } } ph = -1; } } while (0)
        if (mf) {
            D2_FLUSH();
            if ((q & 7) == 0) {
                if (q) cur = nx;
                nx = down_tile(((q >> 3) + 1) * F.G + cs, nsh, tstart);
#pragma unroll
                for (int m = 0; m < 4; ++m) {
#pragma unroll
                    for (int ks = 0; ks < 2; ++ks) { const LAS char* hp = hbuf + (64 * w4 + 16 * m) * 256; const i32x4 a0 = *(const LAS i32x4*)(hp + wof[ks][0]), a1 = *(const LAS i32x4*)(hp + wof[ks][1]);
                        hf[m][ks] = (i32x8){a0[0], a0[1], a0[2], a0[3], a1[0], a1[1], a1[2], a1[3]}; }
                    const int rt = 64 * w4 + 16 * m + fr;
                    if (cur.e != 64) ent[m] = *(const LAS i32x2*)(ebuf + (16 * m + fr) * 8); else ent[m] = (i32x2){((cur.aux + rt) << 3) | 6, 0x3f800000};
                }
            }
            const LAS char* wb = bbuf + (q & 1) * 16384;
            i32x8 wf[2];
#define D2_RD(IDX, DST) do { const i32x4 _a = *(const LAS i32x4*)(wb + ((IDX) & 3) * 4096 + wof[(IDX) >> 2][0]), _b = *(const LAS i32x4*)(wb + ((IDX) & 3) * 4096 + wof[(IDX) >> 2][1]); \
                DST = (i32x8){_a[0], _a[1], _a[2], _a[3], _b[0], _b[1], _b[2], _b[3]}; } while (0)
            D2_RD(0, wf[0]);
#pragma unroll
            for (int idx = 0; idx < 8; ++idx) {
                if (idx + 1 < 8) D2_RD(idx + 1, wf[(idx + 1) & 1]);
                const int nt = idx & 3, ks = idx >> 2;
#pragma unroll
                for (int m = 0; m < 4; ++m) {
                    if (ABL == 2) { if (ks == 0) acc[m][nt] = (f32x4){(float)wf[idx & 1][0], (float)wf[idx & 1][3], 0.f, 0.f}; } else
                    if (ks == 0) asm volatile("v_mfma_scale_f32_16x16x128_f8f6f4 %0, %1, %2, 0, %3, %4 op_sel_hi:[0,0,0]" : "=&v"(acc[m][nt]) : "v"(wf[idx & 1]), "v"(hf[m][0]), "v"(sw), "v"(sa));
                    else asm volatile("v_mfma_scale_f32_16x16x128_f8f6f4 %0, %1, %2, %0, %3, %4 op_sel_hi:[0,0,0]" : "+v"(acc[m][nt]) : "v"(wf[idx & 1]), "v"(hf[m][1]), "v"(sw), "v"(sa));
                }
            }
#undef D2_RD
            asm volatile("s_nop 15\n\ts_nop 15" ::: "memory");
        } else if (ep) {
            ph = (q & 7) * 2 + grp;
            if (ABL != 1)
#pragma unroll
            for (int m = 0; m < 4; ++m) {
                int lo[4];
#pragma unroll
                for (int nt = 0; nt < 4; ++nt) { const float cx = __builtin_amdgcn_fmed3f(acc[m][nt].x, -448.f, 448.f); lo[nt] = __builtin_amdgcn_cvt_pk_fp8_f32(cx, __builtin_amdgcn_fmed3f(acc[m][nt].y, -448.f, 448.f), __float_as_int(cx), false); }
#pragma unroll
                for (int nt = 0; nt < 4; ++nt) lo[nt] = __builtin_amdgcn_cvt_pk_fp8_f32(__builtin_amdgcn_fmed3f(acc[m][nt].z, -448.f, 448.f), __builtin_amdgcn_fmed3f(acc[m][nt].w, -448.f, 448.f), lo[nt], true);
                pw[m] = (u32x4){(unsigned)lo[0], (unsigned)lo[1], (unsigned)lo[2], (unsigned)lo[3]};
            }
            if ((q & 7) == 2 && nx.valid) D2_DMAH(nx, (q >> 3) + 1);
            if (q + 2 < Q && ABL != 3) { if (((q + 2) >> 3) == (q >> 3)) D2_DMA(q + 2, cur); else D2_DMA(q + 2, nx); }
        }
    }
    D2_FLUSH();
#undef D2_FLUSH
#undef D2_DMAH
#undef D2_DMA
    asm volatile("s_waitcnt vmcnt(0)" ::: "memory");
    __syncthreads();
}

__device__ __forceinline__ void combine_phase(Frame& F, int layer, int half) {
    const MoeGeo G = moe_geo(layer);
    const int gw = F.bid * NWAVES + F.wave, NGW = F.G * NWAVES;
    const unsigned char* Y = F.ws + WS_BIG;
    const float* gts = (const float*)(F.ws + WS_GATE);
    const f32x4* gn1 = (const f32x4*)(F.in[I_N1G] + DM) + F.lane;
    for (int lr = gw; lr < G.HR; lr += NGW) {
        const int mrow = half * G.HR + lr, mi = moe_mi(layer, mrow);
        f32x4 a[4];
#pragma unroll
        for (int j = 0; j < 4; ++j) a[j] = (f32x4){0.f, 0.f, 0.f, 0.f};
#pragma unroll
        for (int k = 0; k < 7; ++k) { const unsigned* yp = (const unsigned*)(Y + ((size_t)lr * 7 + k) * 1024) + F.lane;
            const float gk = k < 6 ? gts[(size_t)mrow * 8 + k] : 1.0f;
#pragma unroll
            for (int j = 0; j < 4; ++j) a[j] += unpk4_fp8(yp[64 * j]) * gk; }
#pragma unroll
        for (int j = 0; j < 4; ++j) a[j] = a[j] * (1.0f / 8.0f);
        u32x2* xr = (u32x2*)moe_xrow(F, layer, mrow) + F.lane; const f32x4* g2 = (const f32x4*)modv(F, layer, mi, 5) + F.lane;
        f32x4 v[4]; float s = 0.f;
#pragma unroll
        for (int j = 0; j < 4; ++j) { v[j] = bf4_to_f32(xr[64 * j]) + g2[64 * j] * a[j]; s += (v[j].x * v[j].x + v[j].y * v[j].y) + (v[j].z * v[j].z + v[j].w * v[j].w); }
        if (layer) { f32x4* xo = (f32x4*)(F.out + (size_t)mrow * DM) + F.lane;
#pragma unroll
            for (int j = 0; j < 4; ++j) xo[64 * j] = v[j]; }
        else {
#pragma unroll
            for (int j = 0; j < 4; ++j) xr[64 * j] = f32_to_bf4(v[j]); }
        if (layer == 0) {
            const float rstd = rsqrtf(wave_sum(s) * (1.f / DM) + EPS);
            const f32x4* sh = (const f32x4*)modv(F, 1, mi, 0) + F.lane; const f32x4* sc = (const f32x4*)modv(F, 1, mi, 1) + F.lane;
            bf16_t* base; int tau;
            if (mrow < NCTX) { const int bb = mrow >> 8, t = mrow & 255; tau = t & 31; base = (bf16_t*)(F.ws + WS_HS5C) + (size_t)(bb * 8 + (t >> 5)) * 768; }
            else { const int q = mrow - NCTX, bb = q >> 13, t = q & 8191; tau = t & 31; base = (bf16_t*)(F.ws + WS_HS5L) + (size_t)(bb * 256 + (t >> 5)) * 768; }
            const size_t gstride = mrow < NCTX ? (size_t)32 * 768 : (size_t)1024 * 768;
#pragma unroll
            for (int j = 0; j < 4; ++j) { const f32x4 y = (v[j] * rstd) * gn1[64 * j] * (sc[64 * j] + 1.0f) + sh[64 * j];
                const int c = 4 * F.lane + 256 * j; u32x2 wv; wv.x = cvt_pk_bf16(y.x, y.y); wv.y = cvt_pk_bf16(y.z, y.w);
                *(u32x2*)(base + (size_t)(c >> 4) * gstride + tau * 16 + (c & 15)) = wv; }
        }
    }
}
struct S5P { float dre, dim, cre, cim; };
__device__ __forceinline__ S5P s5_param(const Frame& F, int di, int g, int p) {
    const int idx = (di * 64 + g) * 64 + p;
    const float are = fminf(F.in[I_SARE][idx], -1e-4f), aim = F.in[I_SAIM][idx], dl = expf(F.in[I_SLOG][idx]);
    S5P r; r.dre = are * dl; r.dim = aim * dl;
    float s, c; sincosf(r.dim, &s, &c); const float m = expf(r.dre); const float lr = m * c - 1.0f, li = m * s;
    const float den = 1.0f / (are * are + aim * aim);
    r.cre = (lr * are + li * aim) * den; r.cim = (li * are - lr * aim) * den; return r;
}
__device__ __forceinline__ void cpow(const S5P& q, float k, float& wr, float& wi) { float s, c; sincosf(k * q.dim, &s, &c); const float m = expf(k * q.dre); wr = m * c; wi = m * s; }

__device__ __forceinline__ void s5_tables(Frame& F) {
    bf16_t* TA = (bf16_t*)(F.ws + WS_ACT + AC_S5A);
    bf16_t* TB = (bf16_t*)(F.ws + WS_ACT + AC_S5B);
    LAS float* wl = (LAS float*)(F.lds + MISC_OFF) + F.wave * 256;
    const int gw = F.bid * NWAVES + F.wave, NGW = F.G * NWAVES, p = F.lane;
    constexpr int NA = 64 * 63, NB_ = 64 * 32, NC = 64 * 32;
    const float* bre = F.in[I_SBRE]; const float* bim = F.in[I_SBIM]; const float* cre = F.in[I_SCRE]; const float* cim = F.in[I_SCIM];
    for (int it = gw; it < NA + NB_ + NC; it += NGW) {
        if (it < NA) {
            const int g = it / 63, dlt = it % 63 - 31, ad = dlt < 0 ? -dlt : dlt;
            { const S5P qf = s5_param(F, 0, g, p), qb = s5_param(F, 1, g, p); float wr, wi;
              cpow(qf, (float)ad, wr, wi); wl[p] = wr * qf.cre - wi * qf.cim; wl[64 + p] = wr * qf.cim + wi * qf.cre;
              cpow(qb, (float)ad, wr, wi); wl[128 + p] = wr * qb.cre - wi * qb.cim; wl[192 + p] = wr * qb.cim + wi * qb.cre; }
            asm volatile("s_waitcnt lgkmcnt(0)" ::: "memory");
            const int i = F.lane >> 2, j0 = 4 * (F.lane & 3);
            float acc[4] = {0.f, 0.f, 0.f, 0.f};
#pragma unroll 1
            for (int di = 0; di < 2; ++di) {
                if ((di == 0 && dlt < 0) || (di == 1 && dlt > 0)) continue;
                const float* cr = cre + ((size_t)(di * 64 + g) * 16 + i) * 64; const float* ci = cim + ((size_t)(di * 64 + g) * 16 + i) * 64;
                const float* br = bre + ((size_t)(di * 64 + g) * 64) * 16 + j0; const float* bi = bim + ((size_t)(di * 64 + g) * 64) * 16 + j0;
#pragma unroll 4
                for (int pp = 0; pp < 64; ++pp) { const float wr = wl[di * 128 + pp], wi = wl[di * 128 + 64 + pp]; const float c_r = cr[pp], c_i = ci[pp];
                    const float xr = c_r * wr - c_i * wi, xi = c_r * wi + c_i * wr; const f32x4 b_r = *(const f32x4*)(br + pp * 16), b_i = *(const f32x4*)(bi + pp * 16);
                    acc[0] += xr * b_r.x - xi * b_i.x; acc[1] += xr * b_r.y - xi * b_i.y; acc[2] += xr * b_r.z - xi * b_i.z; acc[3] += xr * b_r.w - xi * b_i.w; }
            }
            if (dlt == 0) { const int jj = i - j0; if (jj >= 0 && jj < 4) { const float dv = F.in[I_SD][g * 16 + i]; if (jj == 0) acc[0] += dv; else if (jj == 1) acc[1] += dv; else if (jj == 2) acc[2] += dv; else acc[3] += dv; } }
            u32x2 wv; wv.x = cvt_pk_bf16(acc[0], acc[1]); wv.y = cvt_pk_bf16(acc[2], acc[3]);
            for (int sg = 0; sg < 32; ++sg) { const int tau = sg + dlt; if (tau >= 0 && tau < 32) *(u32x2*)(TB + ((size_t)g * 512 + tau * 16 + i) * 768 + sg * 16 + j0) = wv; }
            asm volatile("s_waitcnt lgkmcnt(0)" ::: "memory");
        } else if (it < NA + NB_) {
            const int r = it - NA, g = r >> 5, tau = r & 31;
            const S5P qf = s5_param(F, 0, g, p), qb = s5_param(F, 1, g, p); float fr_, fi_, br_, bi_;
            cpow(qf, (float)(tau + 1), fr_, fi_); cpow(qb, (float)(32 - tau), br_, bi_);
            for (int i = 0; i < 16; ++i) {
                const float c0r = cre[((size_t)(0 * 64 + g) * 16 + i) * 64 + p], c0i = cim[((size_t)(0 * 64 + g) * 16 + i) * 64 + p];
                const float c1r = cre[((size_t)(1 * 64 + g) * 16 + i) * 64 + p], c1i = cim[((size_t)(1 * 64 + g) * 16 + i) * 64 + p];
                bf16_t* row = TB + ((size_t)g * 512 + tau * 16 + i) * 768 + 512;
                row[p] = f2bf(c0r * fr_ - c0i * fi_); row[64 + p] = f2bf(-(c0r * fi_ + c0i * fr_));
                row[128 + p] = f2bf(c1r * br_ - c1i * bi_); row[192 + p] = f2bf(-(c1r * bi_ + c1i * br_)); }
        } else {
            const int r = it - NA - NB_, g = r >> 5, sg = r & 31;
            const S5P qf = s5_param(F, 0, g, p), qb = s5_param(F, 1, g, p); float wr, wi;
            cpow(qf, (float)(31 - sg), wr, wi); const float fr_ = wr * qf.cre - wi * qf.cim, fi_ = wr * qf.cim + wi * qf.cre;
            cpow(qb, (float)sg, wr, wi); const float br_ = wr * qb.cre - wi * qb.cim, bi_ = wr * qb.cim + wi * qb.cre;
            const float* b0r = bre + ((size_t)(0 * 64 + g) * 64 + p) * 16; const float* b0i = bim + ((size_t)(0 * 64 + g) * 64 + p) * 16;
            const float* b1r = bre + ((size_t)(1 * 64 + g) * 64 + p) * 16; const float* b1i = bim + ((size_t)(1 * 64 + g) * 64 + p) * 16;
            bf16_t* r0 = TA + ((size_t)g * 256 + p) * 512 + sg * 16;
#pragma unroll
            for (int q4 = 0; q4 < 4; ++q4) { const f32x4 xr = *(const f32x4*)(b0r + 4 * q4), xi = *(const f32x4*)(b0i + 4 * q4), yr = *(const f32x4*)(b1r + 4 * q4), yi = *(const f32x4*)(b1i + 4 * q4);
                const f32x4 are_ = xr * fr_ - xi * fi_, aim_ = xr * fi_ + xi * fr_, bre_ = yr * br_ - yi * bi_, bim_ = yr * bi_ + yi * br_;
                u32x2 w0, w1, w2, w3; w0.x = cvt_pk_bf16(are_.x, are_.y); w0.y = cvt_pk_bf16(are_.z, are_.w); w1.x = cvt_pk_bf16(aim_.x, aim_.y); w1.y = cvt_pk_bf16(aim_.z, aim_.w);
                w2.x = cvt_pk_bf16(bre_.x, bre_.y); w2.y = cvt_pk_bf16(bre_.z, bre_.w); w3.x = cvt_pk_bf16(bim_.x, bim_.y); w3.y = cvt_pk_bf16(bim_.z, bim_.w);
                *(u32x2*)(r0 + 4 * q4) = w0; *(u32x2*)(r0 + (size_t)64 * 512 + 4 * q4) = w1; *(u32x2*)(r0 + (size_t)128 * 512 + 4 * q4) = w2; *(u32x2*)(r0 + (size_t)192 * 512 + 4 * q4) = w3; }
        }
    }
}

struct SchedS5a { __device__ __forceinline__ const i32x2* dummy() const { return nullptr; } int G, c; const char* HL; const char* HC; const char* TA;
    __device__ __forceinline__ bool next(int i, ge::GUnit& u) const { const int L = i * G + c; if (L >= 320) return false; const int g = L / 5, k = L % 5;
        u.aux = g; u.pm = k; u.pn = 0; u.nvalid = 256; u.A = k < 4 ? HL + ((size_t)g * 1024 + k * 256) * 1536 : HC + (size_t)g * 32 * 1536; u.B = TA + (size_t)g * 256 * 1024; return true; } };
struct SchedS5b { __device__ __forceinline__ const i32x2* dummy() const { return nullptr; } int G, c; const char* HL; const char* TB;
    __device__ __forceinline__ bool next(int i, ge::GUnit& u) const { const int L = i * G + c; if (L >= 512) return false; const int g = L >> 3, k = (L >> 1) & 3, pn = L & 1;
        u.aux = g; u.pm = k; u.pn = pn; u.nvalid = 256; u.A = HL + ((size_t)g * 1024 + k * 256) * 1536; u.B = TB + ((size_t)g * 512 + pn * 256) * 1536; return true; } };

__device__ __forceinline__ void s5_carry(Frame& F) {
    LAS float* ex = (LAS float*)F.lds;
    for (int u = F.bid; u < 512; u += F.G) {
        const int di = u & 1, b = (u >> 1) & 3, g = u >> 3, p = F.lane, w = F.wave;
        const S5P q = s5_param(F, di, g, p); float lr, li, gr, gi; cpow(q, 32.0f, lr, li); cpow(q, 1024.0f, gr, gi);
        const float* __restrict__ sl = (const float*)(F.ws + WS_BIG + BG_SLOCL) + ((size_t)g * 1024 + b * 256) * 256 + di * 128 + p;
        const float* __restrict__ sc = (const float*)(F.ws + WS_BIG + BG_SLOCC) + ((size_t)g * 32 + b * 8) * 256 + di * 128 + p;
        bf16_t* __restrict__ ho = (bf16_t*)(F.ws + WS_HS5L) + ((size_t)g * 1024 + b * 256) * 768 + 512 + di * 128 + p;
        float sr[32], si[32];
#pragma unroll
        for (int k = 0; k < 32; ++k) { const int c = di == 0 ? 32 * w + k : 255 - 32 * w - k; sr[k] = sl[(size_t)c * 256]; si[k] = sl[(size_t)c * 256 + 64]; }
        float hr = 0.f, hi_ = 0.f;
        { float cr[8], ci[8];
#pragma unroll
          for (int k = 0; k < 8; ++k) { const int cc = di == 0 ? k : 7 - k; cr[k] = sc[cc * 256]; ci[k] = sc[cc * 256 + 64]; }
#pragma unroll
          for (int k = 0; k < 8; ++k) { const float nr = lr * hr - li * hi_ + cr[k], ni = lr * hi_ + li * hr + ci[k]; hr = nr; hi_ = ni; } }
        float qr = 0.f, qi = 0.f;
#pragma unroll
        for (int k = 0; k < 32; ++k) { const float nr = lr * qr - li * qi + sr[k], ni = lr * qi + li * qr + si[k]; qr = nr; qi = ni; }
        ex[(w * 2 + 0) * 64 + p] = qr; ex[(w * 2 + 1) * 64 + p] = qi;
        __syncthreads();
        for (int v = 0; v < w; ++v) { const float tr = ex[(v * 2 + 0) * 64 + p], ti = ex[(v * 2 + 1) * 64 + p]; const float nr = gr * hr - gi * hi_ + tr, ni = gr * hi_ + gi * hr + ti; hr = nr; hi_ = ni; }
#pragma unroll
        for (int k = 0; k < 32; ++k) { const int c = di == 0 ? 32 * w + k : 255 - 32 * w - k; ho[(size_t)c * 768] = f2bf(hr); ho[(size_t)c * 768 + 64] = f2bf(hi_);
            const float nr = lr * hr - li * hi_ + sr[k], ni = lr * hi_ + li * hr + si[k]; hr = nr; hi_ = ni; }
        __syncthreads();
    }
}

struct AMapGlu { __device__ __forceinline__ unsigned operator()(int R, int C) const { const int c = 2 * C; return (unsigned)((R >> 5) * 512 + (R & 31) * 16) + (unsigned)(c >> 4) * (1024u * 512u) + (unsigned)(c & 15); } };
#ifndef MK_PER_PHASE
#define MK_PER_PHASE 0
#endif
constexpr int NPH = 17;

constexpr size_t CTL_BAR_BYTE = 16384;
#define XB_TMO      128
#define XB_XCNT(j)  (256  + 64 * (j))
#define XB_XSUB(j)  (1280 + 64 * (j))
#define XB_XGEN(j)  (2304 + 64 * (j))
#define XB_TOP      3328
#define XB_TOPGEN   3392
#define XCD_BAR_WORDS 3456
#define XB_SPIN_CAP (1u << 22)
__device__ __forceinline__ unsigned xb_ld(unsigned* p)              { return __hip_atomic_load(p, __ATOMIC_RELAXED, __HIP_MEMORY_SCOPE_AGENT); }
__device__ __forceinline__ unsigned xb_add(unsigned* p, unsigned v) { return __hip_atomic_fetch_add(p, v, __ATOMIC_RELAXED, __HIP_MEMORY_SCOPE_AGENT); }
__device__ __forceinline__ unsigned xb_xcc_id() { return (unsigned)__builtin_amdgcn_s_getreg((3 << 11) | 20) & 0xFu; }
#define XB_SPIN(cond, bar) do { unsigned _sp = 0; while (cond) { __builtin_amdgcn_s_sleep(1); \
    if ((++_sp & 255u) == 0u) { if (xb_ld(&(bar)[XB_TMO])) break; if (_sp > XB_SPIN_CAP) { atomicAdd(&(bar)[XB_TMO], 1u); break; } } } } while (0)
struct XcdBarrier { unsigned* bar; unsigned x; volatile LAS unsigned* st; };
__device__ __forceinline__ XcdBarrier xcd_barrier_post(unsigned* bar, volatile LAS unsigned* st) {
    XcdBarrier b; b.bar = bar; b.x = xb_xcc_id(); b.st = st;
    if (threadIdx.x == 0) (void)xb_add(&bar[XB_XCNT(b.x)], 1u);
    return b;
}
__device__ __forceinline__ void xcd_barrier_complete(unsigned* bar, unsigned x, unsigned& nloc, unsigned& nx) {
    const unsigned G = gridDim.x;
    unsigned sum, cnt, mine, sp = 0u;
    for (;;) {
        sum = 0u; cnt = 0u; mine = 0u;
#pragma unroll
        for (unsigned j = 0; j < 16; ++j) { const unsigned c = xb_ld(&bar[XB_XCNT(j)]); sum += c; cnt += (c > 0u) ? 1u : 0u; mine = (j == x) ? c : mine; }
        if (sum == G) break;
        __builtin_amdgcn_s_sleep(1);
        if ((++sp & 255u) == 0u) { if (xb_ld(&bar[XB_TMO])) break; if (sp > XB_SPIN_CAP) { atomicAdd(&bar[XB_TMO], 1u); break; } }
    }
    nloc = mine > 0u ? mine : 1u; nx = cnt > 0u ? cnt : 1u;
}
__device__ __forceinline__ void xcd_barrier(const XcdBarrier& b) {
    asm volatile("s_waitcnt vmcnt(0)" ::: "memory");
    __syncthreads();
    if (threadIdx.x == 0) {
        unsigned* bar = b.bar;
        __builtin_amdgcn_s_waitcnt(0);
        unsigned nloc = b.st[0], nx = b.st[1];
        if (nloc == 0u) { xcd_barrier_complete(bar, b.x, nloc, nx); b.st[0] = nloc; b.st[1] = nx; }
        const unsigned old = xb_add(&bar[XB_XSUB(b.x)], 1u);
        const unsigned gen = old / nloc;
        if (old + 1u == (gen + 1u) * nloc) {
            __builtin_amdgcn_fence(__ATOMIC_RELEASE, "agent");
            asm volatile("s_waitcnt vmcnt(0)" ::: "memory");
            const unsigned og = xb_add(&bar[XB_TOP], 1u);
            const unsigned tg = og / nx;
            if (og + 1u == (tg + 1u) * nx) xb_add(&bar[XB_TOPGEN], 1u);
            else XB_SPIN(xb_ld(&bar[XB_TOPGEN]) == tg, bar);
            __builtin_amdgcn_fence(__ATOMIC_ACQUIRE, "agent");
            xb_add(&bar[XB_XGEN(b.x)], 1u);
            asm volatile("s_waitcnt vmcnt(0)" ::: "memory");
        } else {
            XB_SPIN(xb_ld(&bar[XB_XGEN(b.x)]) == gen, bar);
            __builtin_amdgcn_fence(__ATOMIC_ACQUIRE, "agent");
            asm volatile("s_waitcnt vmcnt(0)" ::: "memory");
        }
    }
    __syncthreads();
}

__global__ void __launch_bounds__(NTHREADS, 2) mega_fwd(Args args) {
    extern __shared__ __attribute__((aligned(16))) unsigned char lds_raw[];
    Frame F;
    F.lds = (LAS unsigned char*)lds_raw; F.in = args.in; F.out = args.out; F.ws = args.ws;
    F.tid = threadIdx.x; F.lane = F.tid & 63; F.wave = __builtin_amdgcn_readfirstlane(F.tid >> 6); F.G = gridDim.x; F.bid = blockIdx.x;
    const int lo = args.ph_lo, hi = args.ph_hi;
    volatile LAS unsigned* bst = (volatile LAS unsigned*)(F.lds + LDS_BYTES - 16);
    XcdBarrier bar; bar.bar = (unsigned*)(F.ws + WS_CTL + CTL_BAR_BYTE); bar.x = 0; bar.st = bst;
    if (hi - lo > 1) { if (F.tid == 0) { bst[0] = 0u; bst[1] = 0u; } __syncthreads(); bar = xcd_barrier_post((unsigned*)(F.ws + WS_CTL + CTL_BAR_BYTE), bst); }
#ifdef PH_ONLY
#define IN(k) ((k) == PH_ONLY && lo <= (k) && (k) < hi)
#else
#define IN(k) (lo <= (k) && (k) < hi)
#endif
#define SEAM(k) do { if (IN(k) && IN((k) + 1)) { if ((k) == 0) cg::this_grid().sync(); else xcd_barrier(bar); } } while (0)

#ifndef PROBE_REP
#define PROBE_REP -1
#endif
#ifndef DOWN_ABL
#define DOWN_ABL 0
#endif
#define NREP(k) ((PROBE_REP == (k)) ? 2 : 1)
#define REPSYNC(k, rep) do { if ((rep) + 1 < NREP(k)) xcd_barrier(bar); } while (0)
    if (IN(0)) { for (int rep = 0; rep < NREP(0); ++rep) { p0_prologue(F); __syncthreads(); REPSYNC(0, rep); } } SEAM(0);
    if (IN(1)) for (int rep = 0; rep < NREP(1); ++rep) { p1_norm1(F); REPSYNC(1, rep); } SEAM(1);
    if (IN(2)) {
        { ge::StaticOrder S; S.init(NROW / 256, 4, F.G, F.bid, F.ws + WS_ACT, (size_t)256 * 2048, F.ws + WS_WIN, (size_t)256 * 2048);
          EpiG1 E{F.ws, F.in[I_QG], F.in[I_KG], 0};
          ge::gemm_run<EpiG1, ge::StaticOrder, ge::AMapPlain, 0>(F.lds, nullptr, 16, 2048u, 128u * 2048u, (size_t)128, ge::AMapPlain{2048u}, 0u, S, E); }
        {
          ge::StaticOrder S; S.init(NROW / 256, 6, F.G, F.bid, F.ws + WS_SCR, (size_t)256 * 1024, F.ws + WS_WIN8, (size_t)256 * 1024);
          if (F.G == 256) { if (F.bid < 16) { S.G = 16; S.lim = 32; } else { S.G = 240; S.c = F.bid - 16; S.base = 32; } }
          EpiG1 E{F.ws, F.in[I_QG], F.in[I_KG], 4};
          ge::gemm_run<EpiG1, ge::StaticOrder, ge::AMapPlain, 0, true>(F.lds, nullptr, 8, 1024u, 128u * 1024u, (size_t)128, ge::AMapPlain{1024u}, 0u, S, E, 0x79797979, 0x7c7c7c7c); }
    }
#if PROBE_REP == 2
    xcd_barrier(bar);
    {
        ge::StaticOrder S; S.init(NROW / 256, 10, F.G, F.bid, F.ws + WS_ACT, (size_t)256 * 2048, F.ws + WS_WIN, (size_t)256 * 2048);
        EpiG1 E{F.ws, F.in[I_QG], F.in[I_KG], 0};
        ge::gemm_run<EpiG1, ge::StaticOrder, ge::AMapPlain, 0>(F.lds, nullptr, 16, 2048u, 128u * 2048u, (size_t)128, ge::AMapPlain{2048u}, 0u, S, E);
    }
#endif
    SEAM(2);
    if (IN(3)) { lru_consts(F); for (int u = F.bid; u < NBATCH * LRU_NCH; u += F.G) lru_unit<false>(F, u / LRU_NCH, u % LRU_NCH); }
#if PROBE_REP == 3
    xcd_barrier(bar);
    { lru_consts(F); for (int u = F.bid; u < NBATCH * LRU_NCH; u += F.G) lru_unit<false>(F, u / LRU_NCH, u % LRU_NCH); }
#endif
    SEAM(3);
    if (IN(4)) for (int rep = 0; rep < NREP(4); ++rep) { lru_carry(F); REPSYNC(4, rep); } SEAM(4);
    if (IN(5)) {
        lru_consts(F);
        for (int rep = 0; rep < NREP(51); ++rep) { for (int u = F.bid; u < NBATCH * LRU_NCH; u += F.G) lru_unit<true>(F, u / LRU_NCH, u % LRU_NCH); REPSYNC(51, rep); }
        const float s1 = wave_sum(F.in[I_LQ1][F.lane] * F.in[I_LK1][F.lane]), s2 = wave_sum(F.in[I_LQ2][F.lane] * F.in[I_LK2][F.lane]);
        const float lam = expf(s1) - expf(s2) + 0.2f;
        const int ca = (F.G % 8 == 0) ? (F.bid % 8) * (F.G / 8) + F.bid / 8 : F.bid;
        for (int rep = 0; rep < NREP(50); ++rep)
        for (int u = ca; u < 528; u += F.G) {
            const bool isl = u < 512; const int b = isl ? (u >> 7) : ((u - 512) >> 2), h = isl ? ((u >> 5) & 3) : ((u - 512) & 3);
#ifdef PROBE_ABL
            if (rep == 0) at::attn_unit<PROBE_ABL>(F, b, h, isl ? NCTX + b * SEQ + (u & 31) * 256 : b * 256, isl ? 132 : 4, lam); else
#endif
            at::attn_unit<0>(F, b, h, isl ? NCTX + b * SEQ + (u & 31) * 256 : b * 256, isl ? 132 : 4, lam);
            __syncthreads();
        }
    } SEAM(5);
    if (IN(6)) {
        ge::StaticOrder S; S.init(NROW / 256, 4, F.G, F.bid, F.ws + WS_ACT, (size_t)256 * 2048, F.ws + WS_WOUT, (size_t)256 * 2048);
        EpiG2 E{F};
        ge::gemm_run<EpiG2, ge::StaticOrder, ge::AMapPlain, 0>(F.lds, nullptr, 16, 2048u, 128u * 2048u, (size_t)128, ge::AMapPlain{2048u}, 0u, S, E);
    }
#if PROBE_REP == 6
    xcd_barrier(bar);
    {
        ge::StaticOrder S; S.init(NROW / 256, 4, F.G, F.bid, F.ws + WS_ACT, (size_t)256 * 2048, F.ws + WS_WOUT, (size_t)256 * 2048);
        EpiG2 E{F};
        ge::gemm_run<EpiG2, ge::StaticOrder, ge::AMapPlain, 0>(F.lds, nullptr, 16, 2048u, 128u * 2048u, (size_t)128, ge::AMapPlain{2048u}, 0u, S, E);
    }
#endif
    SEAM(6);
    if (IN(7)) { router_phase(F, 0); } SEAM(7);
#if PROBE_REP == 80
    if (IN(8)) { moe_up(F, 0, 0); xcd_barrier(bar); }
#endif
    if (IN(8)) { moe_up(F, 0, 0); asm volatile("s_waitcnt vmcnt(0)" ::: "memory"); __syncthreads(); moe_down2<DOWN_ABL>(F, 0); }
#if PROBE_REP == 81
    if (IN(8)) { xcd_barrier(bar); moe_down2<0>(F, 0); }
#endif
    SEAM(8);
    if (IN(9)) {
        combine_phase(F, 0, 0);
        s5_tables(F);
        LAS float* scr = (LAS float*)(F.lds + 32768 + F.wave * 8704);
        for (int it = F.bid * NWAVES + F.wave; it < 65 * 384; it += F.G * NWAVES) conv_expert_item(F, 1, it, scr);
    } SEAM(9);
    if (IN(10)) for (int rep = 0; rep < NREP(10); ++rep) {
        const int cs = (F.G % 8 == 0) ? (F.bid % 8) * (F.G / 8) + F.bid / 8 : F.bid;
        SchedS5a S{F.G, cs, (const char*)(F.ws + WS_HS5L), (const char*)(F.ws + WS_HS5C), (const char*)(F.ws + WS_ACT + AC_S5A)};
        EpiS5a E{F.ws};
        ge::gemm_run<EpiS5a, SchedS5a, ge::AMapPlain, 0>(F.lds, nullptr, 8, 1024u, 128u * 1536u, (size_t)128, ge::AMapPlain{1536u}, 0u, S, E);
        REPSYNC(10, rep);
    } SEAM(10);
    if (IN(11)) { s5_carry(F); } SEAM(11);
    if (IN(12)) for (int rep = 0; rep < NREP(12); ++rep) {
        const int cs = (F.G % 8 == 0) ? (F.bid % 8) * (F.G / 8) + F.bid / 8 : F.bid;
        SchedS5b S{F.G, cs, (const char*)(F.ws + WS_HS5L), (const char*)(F.ws + WS_ACT + AC_S5B)};
        EpiS5b E{F.ws};
        ge::gemm_run<EpiS5b, SchedS5b, ge::AMapPlain, 0>(F.lds, nullptr, 12, 1536u, 128u * 1536u, (size_t)128, ge::AMapPlain{1536u}, 0u, S, E);
        REPSYNC(12, rep);
    } SEAM(12);
    if (IN(13)) for (int rep = 0; rep < NREP(13); ++rep) {
#if PROBE_REP == 13 && defined(PROBE_HOT)
        ge::StaticOrder S; S.init(NLAT / 256, 8, F.G, F.bid, F.ws + WS_BIG + BG_ZS5, rep == 0 ? (size_t)0 : (size_t)8 * 512, F.ws + WS_GLU, rep == 0 ? (size_t)0 : (size_t)256 * 1024);
#else
        ge::StaticOrder S; S.init(NLAT / 256, 8, F.G, F.bid, F.ws + WS_BIG + BG_ZS5, (size_t)8 * 512, F.ws + WS_GLU, (size_t)256 * 1024);
#endif
        EpiGlu E{F};
        ge::gemm_run<EpiGlu, ge::StaticOrder, AMapGlu, 0, true>(F.lds, nullptr, 8, 1024u, 2048u, (size_t)8 * 1024 * 512, AMapGlu{}, 0u, S, E, 0x7a7a7a7a, 0x7d7d7d7d);
        REPSYNC(13, rep);
    } SEAM(13);
    if (IN(14)) { router_phase(F, 1); } SEAM(14);
    if (IN(15)) { moe_up(F, 1, 0); asm volatile("s_waitcnt vmcnt(0)" ::: "memory"); __syncthreads(); moe_down2<0>(F, 1); } SEAM(15);
    if (IN(16)) for (int rep = 0; rep < NREP(16); ++rep) { combine_phase(F, 1, 0); REPSYNC(16, rep); }
#undef IN
#undef SEAM
}

extern "C" void kernel_launch(void* const* d_in, const int* in_sizes, int n_in, void* d_out, int out_size, void* d_ws, size_t ws_size, hipStream_t stream) {
    static int grid = 0;
    if (grid == 0) {
        if (n_in != 42 || out_size != NLAT * DM || ws_size < WS_END) { fprintf(stderr, "kernel_launch: unexpected problem: n_in %d out %d ws %zu (need %zu)\n", n_in, out_size, ws_size, (size_t)WS_END); grid = -1; return; }
        int dev = 0, cus = 0, per_cu = 0;
        if (hipGetDevice(&dev) != hipSuccess || hipDeviceGetAttribute(&cus, hipDeviceAttributeMultiprocessorCount, dev) != hipSuccess) { grid = -1; return; }
        if (hipFuncSetAttribute((const void*)mega_fwd, hipFuncAttributeMaxDynamicSharedMemorySize, LDS_BYTES) != hipSuccess) { fprintf(stderr, "kernel_launch: hipFuncSetAttribute failed\n"); grid = -1; return; }
        if (hipOccupancyMaxActiveBlocksPerMultiprocessor(&per_cu, (const void*)mega_fwd, NTHREADS, LDS_BYTES) != hipSuccess || per_cu < 1) { fprintf(stderr, "kernel_launch: occupancy query failed (%d)\n", per_cu); grid = -1; return; }
        grid = cus * per_cu; if (grid > 256) grid = 256;
        fprintf(stderr, "kernel_launch: cus %d per_cu %d grid %d ws %zu\n", cus, per_cu, grid, ws_size);
    }
    if (grid < 0) return;
    (void)hipMemsetAsync((char*)d_ws + WS_CTL, 0, 65536, stream);
    Args a{};
    for (int i = 0; i < 42; ++i) a.in[i] = (const float*)d_in[i];
    a.out = (float*)d_out; a.ws = (unsigned char*)d_ws;
#if MK_PER_PHASE
    for (int p = 0; p < NPH; ++p) { a.ph_lo = p; a.ph_hi = p + 1; hipLaunchKernelGGL(mega_fwd, dim3(grid), dim3(NTHREADS), LDS_BYTES, stream, a); }
#else
    a.ph_lo = 0; a.ph_hi = NPH;
    void* kargs[] = {&a};
    const hipError_t e = hipLaunchCooperativeKernel((const void*)mega_fwd, dim3(grid), dim3(NTHREADS), kargs, LDS_BYTES, stream);
    if (e != hipSuccess) fprintf(stderr, "kernel_launch: cooperative launch failed: %s (grid %d)\n", hipGetErrorString(e), grid);
#endif
}
```

```cpp
#include <hip/hip_runtime.h>
#include <hip/hip_cooperative_groups.h>
#include <cstdio>
#include <cstdint>
namespace cg = cooperative_groups;

#define LAS __attribute__((address_space(3)))
typedef unsigned short bf16_t;
typedef short bf16x8 __attribute__((ext_vector_type(8)));
typedef short s16x4 __attribute__((ext_vector_type(4)));
typedef float f32x2 __attribute__((ext_vector_type(2)));
typedef float f32x4 __attribute__((ext_vector_type(4)));
typedef float f32x16 __attribute__((ext_vector_type(16)));
typedef unsigned u32x2 __attribute__((ext_vector_type(2)));
typedef int i32x2 __attribute__((ext_vector_type(2)));
typedef unsigned u32x4 __attribute__((ext_vector_type(4)));

constexpr int DM = 1024, NBATCH = 4, SEQ = 8192, CTXL = 256;
constexpr int NCTX = NBATCH * CTXL;
constexpr int NLAT = NBATCH * SEQ;
constexpr int NROW = NCTX + NLAT;
constexpr float EPS = 1e-6f;
constexpr int NTHREADS = 512, NWAVES = 8;
constexpr int LRU_NCH = 264;
constexpr int CAPH = 33792;

constexpr size_t MiB = 1ull << 20;
constexpr size_t WS_CTL = 0;
constexpr size_t WS_MODV = 1 * MiB;
constexpr size_t WS_ROPE = WS_MODV + 256 * 1024;
constexpr size_t WS_LRUW = WS_MODV + 512 * 1024;
constexpr size_t WS_LRUSP = WS_MODV + 768 * 1024;
constexpr size_t WS_WRT = 2 * MiB;
constexpr size_t WS_WIN = 4 * MiB, WS_WIN8 = 6 * MiB, WS_WOUT = 9 * MiB, WS_GLU = 11 * MiB;
constexpr size_t WS_EXP = 15 * MiB;
constexpr size_t WS_ACT = 113 * MiB;
constexpr size_t WS_BIG = 179 * MiB;
constexpr size_t WS_SCR = 410 * MiB;
constexpr size_t WS_LIST = 472 * MiB;
constexpr size_t WS_GATE = 490 * MiB;
constexpr size_t WS_HS5L = 494 * MiB;
constexpr size_t WS_HS5C = 590 * MiB;
constexpr size_t WS_END = 594 * MiB;
constexpr size_t BG_GATE = 0, BG_XA = 33 * MiB, BG_Q = 66 * MiB, BG_K = 99 * MiB, BG_V = 132 * MiB, BG_LSUM = 165 * MiB, BG_LHIN = 175 * MiB;
constexpr size_t BG_MODP = 200 * MiB;
constexpr size_t BG_SSQ = 200 * MiB;
constexpr size_t BG_ZS5 = 0, BG_SLOCL = 64 * MiB, BG_SLOCC = 128 * MiB;
constexpr size_t AC_S5A = 0, AC_S5B = 16 * MiB;
constexpr size_t EXP_STRIDE = 3 * MiB / 2, EXP_WD = 1 * MiB;

constexpr int RING_BYTES = 131072, MISC_OFF = RING_BYTES, LDS_BYTES = 147456;

__device__ __forceinline__ unsigned cvt_pk_bf16(float lo, float hi) { unsigned r; asm("v_cvt_pk_bf16_f32 %0, %1, %2" : "=v"(r) : "v"(lo), "v"(hi)); return r; }
__device__ __forceinline__ bf16_t f2bf(float f) { return (bf16_t)(cvt_pk_bf16(f, 0.f) & 0xffffu); }
__device__ __forceinline__ float bf2f(bf16_t h) { return __uint_as_float(((unsigned)h) << 16); }
__device__ __forceinline__ float bflo(unsigned w) { return __uint_as_float(w << 16); }
__device__ __forceinline__ float bfhi(unsigned w) { return __uint_as_float(w & 0xffff0000u); }
__device__ __forceinline__ float wave_sum(float v) {
#pragma unroll
    for (int o = 1; o < 64; o <<= 1) v += __shfl_xor(v, o);
    return v;
}
__device__ __forceinline__ float sigmoidf_(float x) { return __builtin_amdgcn_rcpf(1.f + __expf(-x)); }
__device__ __forceinline__ float siluf_(float x) { return x * sigmoidf_(x); }
__device__ __forceinline__ float gelu_tanh(float x) { const float u = 0.7978845608028654f * (x + 0.044715f * x * x * x); return x * __builtin_amdgcn_rcpf(1.f + __expf(-2.f * u)); }
__device__ __forceinline__ unsigned pk4_fp8(float a, float b, float c, float d) {
    a = fminf(fmaxf(a, -448.f), 448.f); b = fminf(fmaxf(b, -448.f), 448.f); c = fminf(fmaxf(c, -448.f), 448.f); d = fminf(fmaxf(d, -448.f), 448.f);
    int w = __builtin_amdgcn_cvt_pk_fp8_f32(a, b, 0, false); w = __builtin_amdgcn_cvt_pk_fp8_f32(c, d, w, true); return (unsigned)w; }
typedef int i32x8 __attribute__((ext_vector_type(8)));
typedef int i32x4 __attribute__((ext_vector_type(4)));
__device__ __forceinline__ f32x4 unpk4_fp8(unsigned w) { const f32x2 lo = __builtin_amdgcn_cvt_pk_f32_fp8((int)w, false), hi = __builtin_amdgcn_cvt_pk_f32_fp8((int)w, true); return (f32x4){lo.x, lo.y, hi.x, hi.y}; }
__device__ __forceinline__ int crow(int r, int hi) { return (r & 3) + 8 * (r >> 2) + 4 * hi; }

__device__ __forceinline__ int lane_id() { return (int)__builtin_amdgcn_mbcnt_hi(~0u, __builtin_amdgcn_mbcnt_lo(~0u, 0u)); }

struct Args { const float* in[42]; float* out; unsigned char* ws; int ph_lo, ph_hi; };
struct Frame {
    LAS unsigned char* lds;
    const float* const* in;
    float* out; unsigned char* ws;
    int tid, lane, wave, G, bid;
};
enum { I_X = 0, I_C, I_CTX, I_CCTX, I_MODW, I_MODB, I_N1G, I_N2G, I_WIN, I_WOUT, I_CONVW, I_CONVB, I_LLAM, I_LRW, I_LRB, I_LIW, I_LIB,
       I_QG, I_KG, I_LQ1, I_LK1, I_LQ2, I_LK2, I_SUBG, I_SARE, I_SAIM, I_SLOG, I_SBRE, I_SBIM, I_SCRE, I_SCIM, I_SD, I_GLUW, I_GLUB,
       I_RW, I_RB, I_EWG, I_EWU, I_EWD, I_SWG, I_SWU, I_SWD };

__device__ __forceinline__ int row_mi(int r) { return r < NCTX ? 4 : ((r - NCTX) >> 13); }
__device__ __forceinline__ bf16_t* xb0_ptr(const Frame& F, int r) { return (bf16_t*)F.out + (size_t)r * DM; }
__device__ __forceinline__ bf16_t* xb1_ptr(const Frame& F, int r) { return (bf16_t*)(F.ws + WS_HS5L) + (size_t)r * DM; }
__device__ __forceinline__ f32x4 bf4_to_f32(u32x2 w) { return (f32x4){bflo(w.x), bfhi(w.x), bflo(w.y), bfhi(w.y)}; }
__device__ __forceinline__ u32x2 f32_to_bf4(f32x4 v) { u32x2 w; w.x = cvt_pk_bf16(v.x, v.y); w.y = cvt_pk_bf16(v.z, v.w); return w; }
__device__ __forceinline__ const float* inrow_ptr(const Frame& F, int r) { return r < NCTX ? F.in[I_CTX] + (size_t)r * DM : F.in[I_X] + (size_t)(r - NCTX) * DM; }
__device__ __forceinline__ const float* modv(const Frame& F, int layer, int mi, int chunk) { return (const float*)(F.ws + WS_MODV) + ((size_t)(layer * 5 + mi) * 6 + chunk) * DM; }
namespace ge {
constexpr int BM = 256, BK = 64, HALF = 128, HTB = HALF * BK * 2, STAGE_BYTES = 8 * HTB, NXCD = 8, WGM = 8;
__host__ __device__ __forceinline__ int lds_byte(int r, int c) { const int st = (r >> 4) * 2 + (c >> 5), rr = r & 15, cc = c & 31, ob = rr * 64 + cc * 2; return st * 1024 + (ob ^ (((ob >> 9) & 1) << 5)); }
__host__ __device__ __forceinline__ void stage_rc(int b, int& R, int& C) { const int st = b / 1024, sb = b % 1024, swz = sb ^ (((sb >> 9) & 1) << 5); R = (st >> 1) * 16 + swz / 64; C = (st & 1) * 32 + (swz % 64) / 2; }

struct GUnit { const char* A; const char* B; const i32x2* rows; int pm, pn, aux, nvalid; };

struct StaticOrder {
    __device__ __forceinline__ const i32x2* dummy() const { return nullptr; }
    int nM, nN, nwg, G, c, base = 0, lim = 0x7fffffff; const char* A0; const char* B0; size_t tstepA, tstepB;
    __device__ void init(int nM_, int nN_, int G_, int c_, const void* A, size_t tsA, const void* B, size_t tsB) { nM = nM_; nN = nN_; nwg = nM * nN; G = G_; c = c_; A0 = (const char*)A; B0 = (const char*)B; tstepA = tsA; tstepB = tsB; }
    __device__ bool next(int i, GUnit& u) const {
        const long L = (long)base + (long)i * G + c; if (L >= nwg || L >= lim) return false;
        int wgid = (int)L; { const int q = nwg / NXCD, r = nwg % NXCD, xcd = wgid % NXCD, off = wgid / NXCD; wgid = (xcd < r ? xcd * (q + 1) : r * (q + 1) + (xcd - r) * q) + off; }
        const int nig = WGM * nN, gid = wgid / nig, fm = gid * WGM, gsz = (nM - fm) < WGM ? (nM - fm) : WGM;
        u.pm = fm + ((wgid % nig) % gsz); u.pn = (wgid % nig) / gsz; u.aux = 0; u.nvalid = 256; u.rows = nullptr;
        u.A = A0 + (size_t)u.pm * tstepA; u.B = B0 + (size_t)u.pn * tstepB; return true;
    }
};
__host__ __device__ __forceinline__ int perm32(int rho) { const int n = rho >> 4, i = rho & 15; return 8 * (i >> 2) + 4 * n + (i & 3); }
struct AMapPlain { unsigned lda2; __device__ __forceinline__ unsigned operator()(int R, int C) const { return (unsigned)R * lda2 + (unsigned)C * 2u; } };

template <class Epi, class Sched, class AMap, int GM, bool F8 = false>
__device__ __forceinline__ void gemm_run(LAS unsigned char* lds, const LAS int* rowl, const int nt, const unsigned ldb2, const unsigned hstepA, const size_t kstepA,
                                         const AMap amap, const unsigned lda2g, const Sched& S, const Epi& E, const int sw = 0x7f7f7f7f, const int sa = 0x7f7f7f7f) {
    int tid_ = threadIdx.x; asm volatile("" : "+v"(tid_));
    const int tid = tid_, wid = __builtin_amdgcn_readfirstlane(tid >> 6), lane = tid & 63, wr = wid >> 2, wc = wid & 3, fr = lane & 15, fq = lane >> 4;
    constexpr bool GATHER = GM != 0;
    unsigned voffA = 0, voffB, voffG[2][2] = {{0u, 0u}, {0u, 0u}}, nvoffG[2][2] = {{0u, 0u}, {0u, 0u}};
    int R0, C0; stage_rc(tid * 16, R0, C0);
    voffB = (unsigned)(Epi::PERM ? ((R0 & ~31) + perm32(R0 & 31)) : R0) * ldb2 + (unsigned)C0 * 2u;
    if (GM == 1) {
#pragma unroll
        for (int i = 0; i < 2; ++i) { voffG[0][i] = (unsigned)(rowl[R0 + 64 * i] >> 3) * lda2g + (unsigned)C0 * 2u; voffG[1][i] = (unsigned)(rowl[128 + R0 + 64 * i] >> 3) * lda2g + (unsigned)C0 * 2u; }
    } else if (GM == 0) voffA = amap(R0, C0);
    const unsigned qstepA = hstepA >> 1, qstepB = 64u * ldb2;
#define GE_ROWOFF(dst, U) do { int _t = threadIdx.x; asm volatile("" : "+v"(_t)); int _R, _C; stage_rc((_t & 511) * 16, _R, _C); \
        const bool _id = (U).rows == nullptr; const i32x2* _lp = _id ? (const i32x2*)S.dummy() : (U).rows; const int _nv = _id ? 256 : (U).nvalid; int _e[2][2]; \
        _Pragma("unroll") for (int _h = 0; _h < 2; ++_h) _Pragma("unroll") for (int _i = 0; _i < 2; ++_i) { const int _r = _h * 128 + _R + 64 * _i; _e[_h][_i] = _lp[_r < _nv ? _r : _nv - 1].x; } \
        _Pragma("unroll") for (int _h = 0; _h < 2; ++_h) _Pragma("unroll") for (int _i = 0; _i < 2; ++_i) { const int _r = _h * 128 + _R + 64 * _i; \
            const int _row = _id ? (U).aux + _r : (_e[_h][_i] >> 3); dst[_h][_i] = (unsigned)_row * lda2g + (unsigned)_C * 2u; } } while (0)
    const size_t kstepB = (size_t)(BK * 2);
    const unsigned hstepB = (unsigned)HALF * ldb2;
    const unsigned ldsw = (unsigned)wid * 1024u;
    const int aoff = lds_byte(wr * 64 + fr, F8 ? fq * 16 : fq * 8), boff = lds_byte(wc * 32 + fr, F8 ? fq * 16 : fq * 8);
    constexpr int KOFF = F8 ? 16 : 1024;
#define GE_SA(b, h) (((b) * 2 + (h)) * ge::HTB)
#define GE_SB(b, h) ((4 + (b) * 2 + (h)) * ge::HTB)
#define GE_STAGEB(bufoff, gbase) do { _Pragma("unroll") for (int _i = 0; _i < 2; ++_i) \
        __builtin_amdgcn_global_load_lds((const unsigned*)((const char*)(gbase) + (size_t)(_i * qstepB) + voffB), (LAS unsigned*)(lds + (bufoff) + ldsw + _i * 8192), 16, 0, 0); } while (0)
#define GE_STAGEA(bufoff, gbase, h, NX) do { _Pragma("unroll") for (int _i = 0; _i < 2; ++_i) { \
        const char* _p = GATHER ? (const char*)(gbase) + ((GM == 2 && (NX)) ? nvoffG[h][_i] : voffG[h][_i]) : (const char*)(gbase) + (size_t)((h) * hstepA + _i * qstepA) + voffA; \
        __builtin_amdgcn_global_load_lds((const unsigned*)_p, (LAS unsigned*)(lds + (bufoff) + ldsw + _i * 8192), 16, 0, 0); } } while (0)
#define GE_LDA(dst, b, h) do { _Pragma("unroll") for (int m = 0; m < 4; ++m) _Pragma("unroll") for (int k = 0; k < 2; ++k) dst[m][k] = *(const LAS bf16x8*)(lds + GE_SA(b, h) + aoff + m * 2048 + k * KOFF); } while (0)
#define GE_LDB(dst, b, h) do { _Pragma("unroll") for (int n = 0; n < 2; ++n) _Pragma("unroll") for (int k = 0; k < 2; ++k) dst[n][k] = *(const LAS bf16x8*)(lds + GE_SB(b, h) + boff + n * 2048 + k * KOFF); } while (0)
#define GE_MMA(ai, bj, At, Bt) do { __builtin_amdgcn_s_setprio(1); _Pragma("unroll") for (int m = 0; m < 4; ++m) _Pragma("unroll") for (int n = 0; n < 2; ++n) { \
        if constexpr (F8) { i32x8 _w, _x; { const bf16x8 _w0 = Bt[n][0], _w1 = Bt[n][1], _x0 = At[m][0], _x1 = At[m][1]; \
                const u32x4 _a = *reinterpret_cast<const u32x4*>(&_w0), _b = *reinterpret_cast<const u32x4*>(&_w1), _c = *reinterpret_cast<const u32x4*>(&_x0), _d = *reinterpret_cast<const u32x4*>(&_x1); \
                _w = (i32x8){(int)_a.x, (int)_a.y, (int)_a.z, (int)_a.w, (int)_b.x, (int)_b.y, (int)_b.z, (int)_b.w}; _x = (i32x8){(int)_c.x, (int)_c.y, (int)_c.z, (int)_c.w, (int)_d.x, (int)_d.y, (int)_d.z, (int)_d.w}; } \
              \
            asm volatile("v_mfma_scale_f32_16x16x128_f8f6f4 %0, %1, %2, %0, %3, %4 op_sel_hi:[0,0,0]" : "+v"(acc[ai][bj][m][n]) : "v"(_w), "v"(_x), "v"(sw), "v"(sa)); } \
        else { _Pragma("unroll") for (int k = 0; k < 2; ++k) acc[ai][bj][m][n] = __builtin_amdgcn_mfma_f32_16x16x32_bf16(Bt[n][k], At[m][k], acc[ai][bj][m][n], 0, 0, 0); } } \
        __builtin_amdgcn_s_setprio(0); } while (0)
#define GE_WAIT_V(n) asm volatile("s_waitcnt vmcnt(" #n ")" ::: "memory")
#define GE_WAIT_L(n) asm volatile("s_waitcnt lgkmcnt(" #n ")" ::: "memory")
#define GE_BAR __builtin_amdgcn_s_barrier()
#define GE_SCHED __builtin_amdgcn_sched_barrier(0)
    GUnit cur, nxt; int ui = 0;
    if (!S.next(0, cur)) return;
    f32x4 acc[2][2][4][2];
#pragma unroll
    for (int a = 0; a < 2; ++a)
#pragma unroll
        for (int b = 0; b < 2; ++b)
#pragma unroll
            for (int m = 0; m < 4; ++m)
#pragma unroll
                for (int n = 0; n < 2; ++n) acc[a][b][m][n] = (f32x4){0.f, 0.f, 0.f, 0.f};
    bf16x8 At[4][2], B0[2][2], B1[2][2];
    const char* cA = cur.A; const char* cB = cur.B;
    if (GM == 2) GE_ROWOFF(voffG, cur);
    GE_STAGEB(GE_SB(0, 0), cB); GE_STAGEB(GE_SB(0, 1), cB + hstepB); GE_STAGEA(GE_SA(0, 0), cA, 0, false); GE_STAGEA(GE_SA(0, 1), cA, 1, false);
    if (wr == 1) GE_BAR;
    GE_WAIT_V(2); GE_BAR;
    GE_STAGEB(GE_SB(1, 0), cB + kstepB); GE_STAGEA(GE_SA(1, 0), cA + kstepA, 0, false); GE_STAGEB(GE_SB(1, 1), cB + hstepB + kstepB);
    GE_WAIT_V(6); GE_BAR;
    for (;;) {
        const bool has_next = S.next(ui + 1, nxt);
        typename Epi::Pre pre = E.prefetch(cur, wr, fr);
        const char* nA = has_next ? nxt.A : cA; const char* nB = has_next ? nxt.B : cB;
        if (GM == 2) { if (has_next && nxt.pn == 0) GE_ROWOFF(nvoffG, nxt); else { _Pragma("unroll") for (int _h = 0; _h < 2; ++_h) _Pragma("unroll") for (int _i = 0; _i < 2; ++_i) nvoffG[_h][_i] = voffG[_h][_i]; } }
#pragma unroll 1
        for (int t = 0; t < nt; t += 2) {
            const bool last = (t == nt - 2);
            const char* a1 = cA + (size_t)(t + 1) * kstepA;
            const char* a2 = last ? nA : cA + (size_t)(t + 2) * kstepA; const char* b2 = last ? nB : cB + (size_t)(t + 2) * kstepB;
            const char* a3 = a2 + kstepA; const char* b3 = b2 + kstepB;
            GE_LDB(B0, 0, 0); GE_LDB(B1, 0, 1); GE_SCHED; GE_LDA(At, 0, 0); GE_STAGEA(GE_SA(1, 1), a1, 1, false);
            GE_WAIT_V(8); GE_WAIT_L(0); GE_BAR; GE_MMA(0, 0, At, B0); GE_MMA(0, 1, At, B1); GE_BAR; GE_SCHED;
            GE_LDA(At, 0, 1); GE_STAGEB(GE_SB(0, 0), b2); GE_STAGEB(GE_SB(0, 1), b2 + hstepB); GE_STAGEA(GE_SA(0, 0), a2, 0, last);
            GE_WAIT_V(8); GE_WAIT_L(0); GE_BAR; GE_MMA(1, 0, At, B0); GE_MMA(1, 1, At, B1); GE_BAR; GE_SCHED;
            GE_LDB(B0, 1, 0); GE_LDB(B1, 1, 1); GE_SCHED; GE_LDA(At, 1, 0); GE_STAGEA(GE_SA(0, 1), a2, 1, last);
            GE_WAIT_V(8); GE_WAIT_L(0); GE_BAR; GE_MMA(0, 0, At, B0); GE_MMA(0, 1, At, B1); GE_BAR; GE_SCHED;
            GE_LDA(At, 1, 1); GE_STAGEB(GE_SB(1, 0), b3); GE_STAGEB(GE_SB(1, 1), b3 + hstepB); GE_STAGEA(GE_SA(1, 0), a3, 0, last);
            GE_WAIT_V(8); GE_WAIT_L(0); GE_BAR; GE_MMA(1, 0, At, B0); GE_MMA(1, 1, At, B1); GE_BAR; GE_SCHED;
        }
        if constexpr (F8) asm volatile("s_nop 15\n\ts_nop 15" ::: "memory");
        if (wr == 0) GE_BAR;
        E(acc, cur, wr, wc, fr, fq, pre);
        if (!has_next) break;
#pragma unroll
        for (int a = 0; a < 2; ++a)
#pragma unroll
            for (int b = 0; b < 2; ++b)
#pragma unroll
                for (int m = 0; m < 4; ++m)
#pragma unroll
                    for (int n = 0; n < 2; ++n) acc[a][b][m][n] = (f32x4){0.f, 0.f, 0.f, 0.f};
        cur = nxt; cA = nA; cB = nB; ++ui;
        if (GM == 2) { _Pragma("unroll") for (int _h = 0; _h < 2; ++_h) _Pragma("unroll") for (int _i = 0; _i < 2; ++_i) voffG[_h][_i] = nvoffG[_h][_i]; }
        if (wr == 1) GE_BAR;
    }
    GE_WAIT_V(0);
    GE_BAR;
#undef GE_ROWOFF
#undef GE_SA
#undef GE_SB
#undef GE_STAGEA
#undef GE_STAGEB
#undef GE_LDA
#undef GE_LDB
#undef GE_MMA
#undef GE_WAIT_V
#undef GE_WAIT_L
#undef GE_BAR
#undef GE_SCHED
}
}
__device__ __forceinline__ int tr_dstrow(int n, int kind, int second) {
    if (kind == 1) { if (n < 1024 || n >= 2048) return n; const int tile = n & ~255, wi = n & 255, g = wi >> 6, d = wi & 63; return tile + 128 * (d >> 5) + 32 * g + 8 * ((d >> 2) & 3) + 4 * ((d >> 4) & 1) + (d & 3); }
    if (kind == 2) return (n >> 7) * 256 + (n & 127) + second * 128;
    return n;
}
__device__ __forceinline__ void tr_item(const float* W, int ldw, int K, bf16_t* WT, int kb, int nb, int kind, int second, LAS float* scr, int lane) {
    const int k0 = 64 * kb, n0 = 32 * nb;
#pragma unroll 8
    for (int i = 0; i < 32; ++i) { const int kk = 2 * i + (lane >> 5); scr[kk * 33 + (lane & 31)] = W[(size_t)(k0 + kk) * ldw + n0 + (lane & 31)]; }
    asm volatile("s_waitcnt lgkmcnt(0)" ::: "memory");
    const int c = lane & 7;
#pragma unroll
    for (int j = 0; j < 4; ++j) { const int n = (lane >> 3) + 8 * j; const LAS float* s = scr + (8 * c) * 33 + n;
        u32x4 o; o.x = cvt_pk_bf16(s[0 * 33], s[1 * 33]); o.y = cvt_pk_bf16(s[2 * 33], s[3 * 33]); o.z = cvt_pk_bf16(s[4 * 33], s[5 * 33]); o.w = cvt_pk_bf16(s[6 * 33], s[7 * 33]);
        *(u32x4*)(WT + (size_t)tr_dstrow(n0 + n, kind, second) * K + k0 + 8 * c) = o; }
    asm volatile("s_waitcnt lgkmcnt(0)" ::: "memory");
}
__device__ __forceinline__ void tr_item8(const float* W, int ldw, int K, unsigned char* WT, int kb, int nb, int kind, int second, float scale, LAS float* scr, int lane) {
    const int k0 = 64 * kb, n0 = 32 * nb;
#pragma unroll 8
    for (int i = 0; i < 32; ++i) { const int kk = 2 * i + (lane >> 5); scr[kk * 33 + (lane & 31)] = W[(size_t)(k0 + kk) * ldw + n0 + (lane & 31)] * scale; }
    asm volatile("s_waitcnt lgkmcnt(0)" ::: "memory");
    const int c = lane & 7;
#pragma unroll
    for (int j = 0; j < 4; ++j) { const int n = (lane >> 3) + 8 * j; const LAS float* s = scr + (8 * c) * 33 + n;
        u32x2 o; o.x = pk4_fp8(s[0 * 33], s[1 * 33], s[2 * 33], s[3 * 33]); o.y = pk4_fp8(s[4 * 33], s[5 * 33], s[6 * 33], s[7 * 33]);
        *(u32x2*)(WT + (size_t)tr_dstrow(n0 + n, kind, second) * K + k0 + 8 * c) = o; }
    asm volatile("s_waitcnt lgkmcnt(0)" ::: "memory");
}
__device__ __forceinline__ void conv_expert_item(Frame& F, int layer, int it, LAS float* scr) {
    const int e = it / 384, r = it % 384;
    unsigned char* wgu = F.ws + WS_EXP + (size_t)e * EXP_STRIDE; unsigned char* wd = F.ws + WS_EXP + (size_t)e * EXP_STRIDE + EXP_WD;
    const float *g, *u, *d;
    if (e < 64) { g = F.in[I_EWG] + ((size_t)layer * 64 + e) * 262144; u = F.in[I_EWU] + ((size_t)layer * 64 + e) * 262144; d = F.in[I_EWD] + ((size_t)layer * 64 + e) * 262144; }
    else { g = F.in[I_SWG] + (size_t)layer * 262144; u = F.in[I_SWU] + (size_t)layer * 262144; d = F.in[I_SWD] + (size_t)layer * 262144; }
    if (r < 128) tr_item8(g, 256, 1024, wgu, r / 8, r % 8, 2, 0, 64.f, scr, F.lane);
    else if (r < 256) tr_item8(u, 256, 1024, wgu, (r - 128) / 8, (r - 128) % 8, 2, 1, 64.f, scr, F.lane);
    else tr_item8(d, 1024, 256, wd, (r - 256) / 32, (r - 256) % 32, 0, 0, 32.f, scr, F.lane);
}
__device__ __forceinline__ void p0_prologue(Frame& F) {
    LAS float* sil = (LAS float*)(F.lds);
    for (int i = F.tid; i < 5 * 1024; i += NTHREADS) { const float v = i < 4096 ? F.in[I_C][i] : F.in[I_CCTX][i - 4096]; sil[i] = siluf_(v); }
    __syncthreads();
    LAS float* scr = (LAS float*)(F.lds + 32768 + F.wave * 8704);
    const int gw = F.bid * NWAVES + F.wave, NGW = F.G * NWAVES;
    constexpr int I_MOD = 2 * 96 * 8, I_WINI = 16 * 80, I_WOUTI = 16 * 32, I_GLUI = 16 * 32, I_EXPI = 65 * 384;
    constexpr int NITEMS = I_MOD + I_WINI + I_WOUTI + 2 * I_GLUI + I_EXPI;
    for (int it = gw; it < NITEMS; it += NGW) {
        int r = it;
        if (r < I_MOD) {
            const int kp = r & 7, rr = r >> 3, l = rr / 96, n = (rr % 96) * 64 + F.lane; const float* W = F.in[I_MODW] + ((size_t)l * 1024 + kp * 128) * 6144 + n;
            const LAS float* sl = sil + kp * 128;
            float a0 = 0.f, a1 = 0.f, a2 = 0.f, a3 = 0.f, a4 = 0.f;
#pragma unroll 16
            for (int k = 0; k < 128; ++k) { const float w = W[(size_t)k * 6144]; a0 += sl[k] * w; a1 += sl[1024 + k] * w; a2 += sl[2048 + k] * w; a3 += sl[3072 + k] * w; a4 += sl[4096 + k] * w; }
            float* mp = (float*)(F.ws + WS_BIG + BG_MODP) + ((size_t)kp * 2 + l) * 5 * 6144 + n;
            mp[0] = a0; mp[6144] = a1; mp[2 * 6144] = a2; mp[3 * 6144] = a3; mp[4 * 6144] = a4;
            continue; }
        r -= I_MOD;
        if (r < I_WINI) {
            if (r % 80 < 32) tr_item(F.in[I_WIN], 2560, 1024, (bf16_t*)(F.ws + WS_WIN), r / 80, r % 80, 1, 0, scr, F.lane);
            else tr_item8(F.in[I_WIN], 2560, 1024, F.ws + WS_WIN8 - (size_t)1024 * 1024, r / 80, r % 80, 1, 0, 64.f, scr, F.lane);
            continue; } r -= I_WINI;
        if (r < I_WOUTI) { tr_item(F.in[I_WOUT], 1024, 1024, (bf16_t*)(F.ws + WS_WOUT), r / 32, r % 32, 0, 0, scr, F.lane); continue; } r -= I_WOUTI;
        if (r < I_GLUI) { tr_item8(F.in[I_GLUW], 2048, 1024, F.ws + WS_GLU, r / 32, r % 32, 2, 0, 32.f, scr, F.lane); continue; } r -= I_GLUI;
        if (r < I_GLUI) { tr_item8(F.in[I_GLUW] + 1024, 2048, 1024, F.ws + WS_GLU, r / 32, r % 32, 2, 1, 32.f, scr, F.lane); continue; } r -= I_GLUI;
        conv_expert_item(F, 0, r, scr);
    }
    const int gt = F.bid * NTHREADS + F.tid, NGT = F.G * NTHREADS;
    float* rope = (float*)(F.ws + WS_ROPE);
    for (int i = gt; i < 192 * 16; i += NGT) {
        const int p = i >> 4, f = i & 15; const int pos = p < 128 ? p : p - 128;
        const float inv = powf(10000.0f, -(float)f / 16.0f); const float ang = (float)pos * inv; float s, c; sincosf(ang, &s, &c);
        if (p < 128) { rope[p * 16 + f] = c; rope[2048 + p * 16 + f] = s; } else { rope[4096 + (p - 128) * 16 + f] = c; rope[4096 + 1024 + (p - 128) * 16 + f] = s; }
    }
    bf16_t* lw = (bf16_t*)(F.ws + WS_LRUW);
    for (int i = gt; i < 2 * 2 * 8 * 64 * 64; i += NGT) {
        const int dd = i & 63, e = (i >> 6) & 63, n = (i >> 12) & 7, d = (i >> 15) & 1, type = i >> 16;
        const float* src = type ? F.in[I_LIW] : F.in[I_LRW];
        lw[i] = f2bf(src[((size_t)(d * 8 + n) * 64 + dd) * 64 + e]);
    }
    bf16_t* wrt = (bf16_t*)(F.ws + WS_WRT);
    for (int i = gt; i < 2 * 64 * 1024; i += NGT) {
        const int k = i & 1023, e = (i >> 10) & 63, l = i >> 16; const float w = F.in[I_RW][((size_t)l * 1024 + k) * 64 + e];
        const bf16_t h = f2bf(w); wrt[(size_t)(l * 2 + 0) * 65536 + e * 1024 + k] = h; wrt[(size_t)(l * 2 + 1) * 65536 + e * 1024 + k] = f2bf(w - bf2f(h)); }
    float* sp = (float*)(F.ws + WS_LRUSP);
    for (int i = gt; i < 1024; i += NGT) { const float lam = F.in[I_LLAM][i]; sp[i] = 8.0f * log1pf(expf(-lam)); }
}

__device__ __forceinline__ void p1_norm1(Frame& F) {
    const int gw = F.bid * NWAVES + F.wave, NGW = F.G * NWAVES;
    const float* mp = (const float*)(F.ws + WS_BIG + BG_MODP);
    { float* mv = (float*)(F.ws + WS_MODV);
      for (int i = F.bid * NTHREADS + F.tid; i < 2 * 5 * 6144; i += F.G * NTHREADS) { const int l = i / (5 * 6144), n = i % 6144; float s = F.in[I_MODB][l * 6144 + n];
#pragma unroll
          for (int kp = 0; kp < 8; ++kp) s += mp[(size_t)kp * 2 * 5 * 6144 + i];
          mv[i] = s; } }
    LAS float* lm = (LAS float*)F.lds;
    for (int i = F.tid; i < 5 * 2048; i += NTHREADS) { const int mi = i >> 11, n = i & 2047; float s = F.in[I_MODB][n];
#pragma unroll
        for (int kp = 0; kp < 8; ++kp) s += mp[((size_t)kp * 2 * 5 + mi) * 6144 + n];
        lm[i] = s; }
    __syncthreads();
    bf16_t* H0 = (bf16_t*)(F.ws + WS_ACT);
    const f32x4* gn = (const f32x4*)(F.in[I_N1G]) + F.lane;
    for (int r = gw; r < NROW; r += NGW) {
        const f32x4* xr = (const f32x4*)inrow_ptr(F, r) + F.lane; const int mi = row_mi(r);
        const LAS f32x4* sh = (const LAS f32x4*)(lm + mi * 2048) + F.lane; const LAS f32x4* sc = (const LAS f32x4*)(lm + mi * 2048 + 1024) + F.lane;
        f32x4 v[4]; float s = 0.f;
#pragma unroll
        for (int j = 0; j < 4; ++j) { v[j] = xr[64 * j]; s += (v[j].x * v[j].x + v[j].y * v[j].y) + (v[j].z * v[j].z + v[j].w * v[j].w); }
        const float rstd = rsqrtf(wave_sum(s) * (1.f / DM) + EPS);
        u32x2* o = (u32x2*)(H0 + (size_t)r * DM) + F.lane; unsigned* o8 = (unsigned*)(F.ws + WS_SCR + (size_t)r * DM) + F.lane;
#pragma unroll
        for (int j = 0; j < 4; ++j) { const f32x4 g = gn[64 * j], a = sc[64 * j], b = sh[64 * j];
            const f32x4 y = (v[j] * rstd) * g * (a + 1.0f) + b; u32x2 w; w.x = cvt_pk_bf16(y.x, y.y); w.y = cvt_pk_bf16(y.z, y.w); o[64 * j] = w; o8[64 * j] = pk4_fp8(8.f * y.x, 8.f * y.y, 8.f * y.z, 8.f * y.w); }
    }
}
#define EPI_LOOP_AM _Pragma("unroll") for (int ai = 0; ai < 2; ++ai) _Pragma("unroll") for (int m = 0; m < 4; ++m)
#define EPI_LOOP_BN _Pragma("unroll") for (int bj = 0; bj < 2; ++bj) _Pragma("unroll") for (int n = 0; n < 2; ++n)
typedef f32x4 acc_t[2][2][4][2];
struct NoPre {};
#define EPI_NOPRE using Pre = NoPre; __device__ __forceinline__ NoPre prefetch(const ge::GUnit&, int, int) const { return NoPre{}; }

struct EpiG1 {
    EPI_NOPRE
    static constexpr bool PERM = true;
    unsigned char* ws; const float* qg; const float* kg; int pnoff;
    __device__ __forceinline__ void operator()(const acc_t& acc, const ge::GUnit& u, int wr, int wc, int fr, int fq, const Pre& pre) const {
        const int pn = u.pn + pnoff, row0 = u.pm * 256 + wr * 64 + fr;
        if (pn >= 8) {
            unsigned char* vt = ws + WS_BIG + BG_V + ((size_t)(u.pm * 4 + wr) * 512 + (pn & 1) * 256 + wc * 32 + 8 * fq) * 64 + 4 * fr;
#pragma unroll
            for (int ai = 0; ai < 2; ++ai)
#pragma unroll
                for (int bj = 0; bj < 2; ++bj)
#pragma unroll
                    for (int n = 0; n < 2; ++n)
#pragma unroll
                        for (int i = 0; i < 4; ++i)
                            *(unsigned*)(vt + ((size_t)ai * 1024 + bj * 128 + n * 4 + i) * 64) =
                                pk4_fp8(acc[ai][bj][0][n][i] * 8.f, acc[ai][bj][1][n][i] * 8.f, acc[ai][bj][2][n][i] * 8.f, acc[ai][bj][3][n][i] * 8.f);
            return;
        }
        if (pn < 4) {
            bf16_t* dst = (bf16_t*)(ws + WS_BIG + (pn < 2 ? BG_GATE : BG_XA)); const int colb = (pn & 1) * 256 + wc * 32 + 8 * fq; const bool isg = pn < 2;
            EPI_LOOP_AM { bf16_t* rp = dst + (size_t)(row0 + ai * 128 + m * 16) * 512 + colb;
#pragma unroll
                for (int bj = 0; bj < 2; ++bj) { f32x4 v = acc[ai][bj][m][0], v2 = acc[ai][bj][m][1];
                    if (isg) { v.x = gelu_tanh(v.x); v.y = gelu_tanh(v.y); v.z = gelu_tanh(v.z); v.w = gelu_tanh(v.w); v2.x = gelu_tanh(v2.x); v2.y = gelu_tanh(v2.y); v2.z = gelu_tanh(v2.z); v2.w = gelu_tanh(v2.w); }
                    u32x4 w; w.x = cvt_pk_bf16(v.x, v.y); w.y = cvt_pk_bf16(v.z, v.w); w.z = cvt_pk_bf16(v2.x, v2.y); w.w = cvt_pk_bf16(v2.z, v2.w); *(u32x4*)(rp + bj * 128) = w; } }
            return;
        }
        const bool isk = pn >= 6; const float* gv = isk ? kg : qg;
        unsigned char* dst = ws + WS_BIG + (isk ? BG_K : BG_Q); const int colb = (2 * (pn & 1) + (wc >> 1)) * 128 + (wc & 1) * 64 + 4 * fq;
        const float qs = isk ? 8.0f : 16.f * 0.18033688011112042f;
        f32x4 g4[2][2];
        EPI_LOOP_BN g4[bj][n] = *(const f32x4*)(gv + 32 * bj + 16 * n + 4 * fq);
        const float* rope = (const float*)(ws + WS_ROPE);
        const bool lat = u.pm >= 4;
        EPI_LOOP_AM {
            const int row = row0 + ai * 128 + m * 16;
            float ss = 0.f;
            EPI_LOOP_BN { const f32x4 v = acc[ai][bj][m][n]; ss += (v.x * v.x + v.y * v.y) + (v.z * v.z + v.w * v.w); }
            ss += __shfl_xor(ss, 16); ss += __shfl_xor(ss, 32);
            const float rstd = rsqrtf(ss * (1.f / 64.f) + EPS) * qs;
            f32x4 y[2][2];
            EPI_LOOP_BN y[bj][n] = acc[ai][bj][m][n] * rstd * g4[bj][n];
            if (lat) {
                const int t = (row - NCTX) & (SEQ - 1); const int pr = t >> 6, pc = t & 63;
                const f32x4 c0 = *(const f32x4*)(rope + pr * 16 + 4 * fq), s0 = *(const f32x4*)(rope + 2048 + pr * 16 + 4 * fq);
                const f32x4 c1 = *(const f32x4*)(rope + 4096 + pc * 16 + 4 * fq), s1 = *(const f32x4*)(rope + 5120 + pc * 16 + 4 * fq);
                const f32x4 a0 = y[0][0] * c0 - y[0][1] * s0, b0 = y[0][1] * c0 + y[0][0] * s0;
                const f32x4 a1 = y[1][0] * c1 - y[1][1] * s1, b1 = y[1][1] * c1 + y[1][0] * s1;
                y[0][0] = a0; y[0][1] = b0; y[1][0] = a1; y[1][1] = b1;
            }
            unsigned char* rp = dst + (size_t)row * 512 + colb;
            EPI_LOOP_BN { const f32x4 v = y[bj][n]; *(unsigned*)(rp + 32 * bj + 16 * n) = pk4_fp8(v.x, v.y, v.z, v.w); }
        }
    }
};

struct EpiG2 {
    EPI_NOPRE
    static constexpr bool PERM = false;
    Frame F;
    __device__ __forceinline__ void operator()(const acc_t& acc, const ge::GUnit& u, int wr, int wc, int fr, int fq, const Pre& pre) const {
        const int row0 = u.pm * 256 + wr * 64 + fr, col0 = u.pn * 256 + wc * 32 + 4 * fq; const int mi = u.pm < 4 ? 4 : ((u.pm - 4) >> 5);
        const float* g1 = modv(F, 0, mi, 2) + col0;
        float* ssq = (float*)(F.ws + WS_BIG + BG_SSQ);
        f32x4 gg[2][2];
        EPI_LOOP_BN gg[bj][n] = *(const f32x4*)(g1 + bj * 128 + n * 16);
#pragma unroll
        for (int ai = 0; ai < 2; ++ai) {
            f32x4 xv[4][2][2];
#pragma unroll
            for (int m = 0; m < 4; ++m) { const float* xi = inrow_ptr(F, row0 + ai * 128 + m * 16) + col0;
                EPI_LOOP_BN xv[m][bj][n] = *(const f32x4*)(xi + bj * 128 + n * 16); }
            __builtin_amdgcn_sched_barrier(0);
#pragma unroll
            for (int m = 0; m < 4; ++m) { const int row = row0 + ai * 128 + m * 16; bf16_t* xo = xb0_ptr(F, row) + col0; float ss = 0.f;
                EPI_LOOP_BN { const f32x4 o = xv[m][bj][n] + gg[bj][n] * acc[ai][bj][m][n]; *(u32x2*)(xo + bj * 128 + n * 16) = f32_to_bf4(o);
                    ss += (o.x * o.x + o.y * o.y) + (o.z * o.z + o.w * o.w); }
                ss += __shfl_xor(ss, 16); ss += __shfl_xor(ss, 32);
                if (fq == 0) ssq[(size_t)row * 32 + u.pn * 4 + wc] = ss; }
        }
    }
};

struct EpiUp {
    EPI_NOPRE
    static constexpr bool PERM = true;
    unsigned char* hid;
    __device__ __forceinline__ void operator()(const acc_t& acc, const ge::GUnit& u, int wr, int wc, int fr, int fq, const Pre& pre) const {
        const int row0 = wr * 64 + fr, col0 = u.pn * 128 + wc * 32 + 8 * fq;
        unsigned char* base = hid + (size_t)u.pm * 65536;
        EPI_LOOP_AM { unsigned char* rp = base + (size_t)(row0 + ai * 128 + m * 16) * 256 + col0;
            const f32x4 g = acc[ai][0][m][0], up = acc[ai][1][m][0], g2 = acc[ai][0][m][1], up2 = acc[ai][1][m][1];
            u32x2 w; w.x = pk4_fp8(16.f * siluf_(g.x) * up.x, 16.f * siluf_(g.y) * up.y, 16.f * siluf_(g.z) * up.z, 16.f * siluf_(g.w) * up.w);
            w.y = pk4_fp8(16.f * siluf_(g2.x) * up2.x, 16.f * siluf_(g2.y) * up2.y, 16.f * siluf_(g2.z) * up2.z, 16.f * siluf_(g2.w) * up2.w); *(u32x2*)rp = w; }
    }
};
struct EpiDown {
    static constexpr bool PERM = true;
    struct Pre { i32x2 e[2][4]; };
    unsigned char* Y; int half_base;
    __device__ __forceinline__ Pre prefetch(const ge::GUnit& u, int wr, int fr) const {
        Pre p; const int row0 = wr * 64 + fr;
        EPI_LOOP_AM { const int rt = row0 + ai * 128 + m * 16;
            if (u.rows) p.e[ai][m] = u.rows[rt < u.nvalid ? rt : u.nvalid - 1]; else p.e[ai][m] = (i32x2){((u.aux + rt) << 3) | 6, 0x3f800000}; }
        return p; }
    __device__ __forceinline__ void operator()(const acc_t& acc, const ge::GUnit& u, int wr, int wc, int fr, int fq, const Pre& pre) const {
        const int row0 = wr * 64 + fr, col0 = u.pn * 256 + wc * 32 + 8 * fq;
        EPI_LOOP_AM { const int rt = row0 + ai * 128 + m * 16;
            if (rt < u.nvalid) { const int pk = pre.e[ai][m].x, mrow = pk >> 3, slot = pk & 7; const float gt = 32.f * __int_as_float(pre.e[ai][m].y);
                unsigned char* rp = Y + ((size_t)(mrow - half_base) * 7 + slot) * 1024 + col0;
#pragma unroll
                for (int bj = 0; bj < 2; ++bj) { const f32x4 v = acc[ai][bj][m][0] * gt, v2 = acc[ai][bj][m][1] * gt;
                    u32x2 w; w.x = pk4_fp8(v.x, v.y, v.z, v.w); w.y = pk4_fp8(v2.x, v2.y, v2.z, v2.w); *(u32x2*)(rp + bj * 128) = w; } } }
    }
};

struct EpiS5a {
    EPI_NOPRE
    static constexpr bool PERM = false;
    unsigned char* ws;
    __device__ __forceinline__ void operator()(const acc_t& acc, const ge::GUnit& u, int wr, int wc, int fr, int fq, const Pre& pre) const {
        const int g = u.aux, row0 = wr * 64 + fr, col0 = wc * 32 + 4 * fq; const bool isc = u.pm == 4;
        float* base = isc ? (float*)(ws + WS_BIG + BG_SLOCC) + (size_t)g * 32 * 256 : (float*)(ws + WS_BIG + BG_SLOCL) + ((size_t)g * 1024 + u.pm * 256) * 256;
        EPI_LOOP_AM { const int rt = row0 + ai * 128 + m * 16;
            if (!isc || rt < 32) { float* rp = base + (size_t)rt * 256 + col0;
                EPI_LOOP_BN *(f32x4*)(rp + bj * 128 + n * 16) = acc[ai][bj][m][n]; } }
    }
};
struct EpiS5b {
    EPI_NOPRE
    static constexpr bool PERM = true;
    unsigned char* ws;
    __device__ __forceinline__ void operator()(const acc_t& acc, const ge::GUnit& u, int wr, int wc, int fr, int fq, const Pre& pre) const {
        const int g = u.aux, row0 = u.pm * 256 + wr * 64 + fr, col0 = u.pn * 256 + wc * 32 + 8 * fq;
        unsigned char* base = ws + WS_BIG + BG_ZS5 + (size_t)g * 1024 * 512;
        EPI_LOOP_AM { unsigned char* rp = base + (size_t)(row0 + ai * 128 + m * 16) * 512 + col0;
#pragma unroll
            for (int bj = 0; bj < 2; ++bj) { const f32x4 v = acc[ai][bj][m][0], v2 = acc[ai][bj][m][1];
                u32x2 w; w.x = pk4_fp8(4.f * gelu_tanh(v.x), 4.f * gelu_tanh(v.y), 4.f * gelu_tanh(v.z), 4.f * gelu_tanh(v.w));
                w.y = pk4_fp8(4.f * gelu_tanh(v2.x), 4.f * gelu_tanh(v2.y), 4.f * gelu_tanh(v2.z), 4.f * gelu_tanh(v2.w)); *(u32x2*)(rp + bj * 128) = w; } }
    }
};
struct EpiGlu {
    EPI_NOPRE
    static constexpr bool PERM = false;
    Frame F;
    __device__ __forceinline__ void operator()(const acc_t& acc, const ge::GUnit& u, int wr, int wc, int fr, int fq, const Pre& pre) const {
        const int row0 = u.pm * 256 + wr * 64 + fr, col0 = u.pn * 128 + wc * 32 + 4 * fq; const int mi = u.pm >> 5;
        const float* g1 = modv(F, 1, mi, 2) + col0; const float* gb = F.in[I_GLUB] + col0;
        float* ssq = (float*)(F.ws + WS_BIG + BG_SSQ);
        f32x4 gg[2], bv[2], bg[2];
#pragma unroll
        for (int n = 0; n < 2; ++n) { gg[n] = *(const f32x4*)(g1 + n * 16); bv[n] = *(const f32x4*)(gb + n * 16); bg[n] = *(const f32x4*)(gb + 1024 + n * 16); }
        u32x2 xin[2][4][2];
        EPI_LOOP_AM { const bf16_t* xi = xb0_ptr(F, NCTX + row0 + ai * 128 + m * 16) + col0;
#pragma unroll
            for (int n = 0; n < 2; ++n) xin[ai][m][n] = *(const u32x2*)(xi + n * 16); }
        __builtin_amdgcn_sched_barrier(0);
        EPI_LOOP_AM { const int row = row0 + ai * 128 + m * 16; bf16_t* xo = xb1_ptr(F, row) + col0; float ss = 0.f;
#pragma unroll
            for (int n = 0; n < 2; ++n) { const f32x4 val = acc[ai][0][m][n] + bv[n], gt = acc[ai][1][m][n] + bg[n];
                f32x4 o; o.x = val.x * sigmoidf_(gt.x); o.y = val.y * sigmoidf_(gt.y); o.z = val.z * sigmoidf_(gt.z); o.w = val.w * sigmoidf_(gt.w);
                const f32x4 xn = bf4_to_f32(xin[ai][m][n]) + gg[n] * o; *(u32x2*)(xo + n * 16) = f32_to_bf4(xn); ss += (xn.x * xn.x + xn.y * xn.y) + (xn.z * xn.z + xn.w * xn.w); }
            ss += __shfl_xor(ss, 16); ss += __shfl_xor(ss, 32);
            if (fq == 0) ssq[(size_t)row * 32 + u.pn * 4 + wc] = ss; }
    }
};
constexpr int XCS = 520;
__device__ __forceinline__ void lru_consts(Frame& F) {
    LAS float* cst = (LAS float*)(F.lds + MISC_OFF + F.wave * 1536); const float* sp = (const float*)(F.ws + WS_LRUSP);
#pragma unroll
    for (int d = 0; d < 2; ++d) { const int ch = d * 512 + 64 * F.wave + F.lane; cst[(0 * 2 + d) * 64 + F.lane] = F.in[I_LRB][ch]; cst[(1 * 2 + d) * 64 + F.lane] = F.in[I_LIB][ch]; cst[(2 * 2 + d) * 64 + F.lane] = sp[ch]; }
    __syncthreads();
}
template <int CTRL, int RMASK> __device__ __forceinline__ float dpp_f(float old, float src) {
    return __int_as_float(__builtin_amdgcn_update_dpp(__float_as_int(old), __float_as_int(src), CTRL, RMASK, 0xf, false));
}
#define LRU_SCAN_STEP(CTRL, RM) do { _Pragma("unroll") for (int r = 0; r < 16; ++r) { const float a2 = dpp_f<CTRL, RM>(1.0f, av[r]), b2 = dpp_f<CTRL, RM>(0.0f, bv[r]); bv[r] = av[r] * b2 + bv[r]; av[r] = av[r] * a2; } } while (0)
template <bool FINAL>
__device__ __forceinline__ void lru_unit(Frame& F, int b, int cc) {
    const bool isctx = cc < 8;
    const int seg0 = isctx ? b * 256 : NCTX + b * 8192, segn = isctx ? 256 : 8192, t0 = isctx ? cc * 32 : (cc - 8) * 32;
    LAS bf16_t* xcl = (LAS bf16_t*)F.lds;
    {
        int tq = F.tid; asm volatile("" : "+v"(tq));
        const int tg = tq >> 6, c8 = (tq & 63) * 8; const float* cw = F.in[I_CONVW] + c8;
        const bf16_t* xa = (const bf16_t*)(F.ws + WS_BIG + BG_XA) + (size_t)seg0 * 512 + c8;
        u32x4 xin[7];
#pragma unroll
        for (int k = 0; k < 7; ++k) { const int tp = t0 + 4 * tg - 2 + k; xin[k] = (tp >= 0 && tp < segn) ? *(const u32x4*)(xa + (size_t)tp * 512) : (u32x4){0u, 0u, 0u, 0u}; }
        f32x4 w[4][2]; f32x4 cb[2];
#pragma unroll
        for (int k = 0; k < 4; ++k) { w[k][0] = *(const f32x4*)(cw + k * 512); w[k][1] = *(const f32x4*)(cw + k * 512 + 4); }
        cb[0] = *(const f32x4*)(F.in[I_CONVB] + c8); cb[1] = *(const f32x4*)(F.in[I_CONVB] + c8 + 4);
#pragma unroll
        for (int i = 0; i < 4; ++i) {
            f32x4 o0 = cb[0], o1 = cb[1];
#pragma unroll
            for (int k = 0; k < 4; ++k) { const u32x4 x = xin[i + k];
                o0 += w[k][0] * (f32x4){bflo(x.x), bfhi(x.x), bflo(x.y), bfhi(x.y)}; o1 += w[k][1] * (f32x4){bflo(x.z), bfhi(x.z), bflo(x.w), bfhi(x.w)}; }
            u32x4 ov; ov.x = cvt_pk_bf16(o0.x, o0.y); ov.y = cvt_pk_bf16(o0.z, o0.w); ov.z = cvt_pk_bf16(o1.x, o1.y); ov.w = cvt_pk_bf16(o1.z, o1.w);
            *(LAS u32x4*)(xcl + (4 * tg + i) * XCS + c8) = ov;
        }
    }
    __syncthreads();
    const int n = F.wave, r32 = F.lane & 31, hi = F.lane >> 5;
    const bf16_t* lw = (const bf16_t*)(F.ws + WS_LRUW);
    const LAS float* cst = (const LAS float*)(F.lds + MISC_OFF + n * 1536);
    const int row = seg0 + t0 + r32;
    const float* hin = (const float*)(F.ws + WS_BIG + BG_LHIN) + (size_t)(b * LRU_NCH + cc) * 2 * 512;
    f32x2* sm = (f32x2*)(F.ws + WS_BIG + BG_LSUM) + (size_t)(b * LRU_NCH + cc) * 2 * 512;
#pragma unroll
    for (int eb = 0; eb < 2; ++eb) {
        f32x16 ysum = {};
#pragma unroll
        for (int dd = 0; dd < 2; ++dd) {
            const int d = 1 - dd;
            const int tl = d ? 31 - r32 : r32;
            f32x16 av = {}, bv = {};
#pragma unroll
            for (int ks = 0; ks < 4; ++ks) {
                const bf16x8 xb = *(const LAS bf16x8*)(xcl + tl * XCS + 64 * n + 16 * ks + 8 * hi);
                const bf16x8 wr_ = *(const bf16x8*)(lw + ((size_t)((0 * 2 + d) * 8 + n) * 64 + 32 * eb + r32) * 64 + 16 * ks + 8 * hi);
                const bf16x8 wi_ = *(const bf16x8*)(lw + ((size_t)((1 * 2 + d) * 8 + n) * 64 + 32 * eb + r32) * 64 + 16 * ks + 8 * hi);
                av = __builtin_amdgcn_mfma_f32_32x32x16_bf16(wr_, xb, av, 0, 0, 0);
                bv = __builtin_amdgcn_mfma_f32_32x32x16_bf16(wi_, xb, bv, 0, 0, 0);
            }
#pragma unroll
            for (int r = 0; r < 16; ++r) {
                const int cl = 32 * eb + crow(r, hi);
                const float rg = sigmoidf_(av[r] + cst[(0 * 2 + d) * 64 + cl]), ig = sigmoidf_(bv[r] + cst[(1 * 2 + d) * 64 + cl]);
                const float la = -rg * cst[(2 * 2 + d) * 64 + cl]; const float a = __expf(la);
                const float x = bf2f(xcl[tl * XCS + 64 * n + cl]);
                av[r] = a; bv[r] = __builtin_amdgcn_sqrtf(fmaxf(fmaf(-a, a, 1.0f), 0.f)) * ig * x;
            }
            LRU_SCAN_STEP(0x111, 0xf); LRU_SCAN_STEP(0x112, 0xf); LRU_SCAN_STEP(0x114, 0xf); LRU_SCAN_STEP(0x118, 0xf); LRU_SCAN_STEP(0x142, 0xa);
            if constexpr (!FINAL) {
                if (r32 == 31) {
#pragma unroll
                    for (int r = 0; r < 16; ++r) sm[d * 512 + 64 * n + 32 * eb + crow(r, hi)] = (f32x2){av[r], bv[r]};
                }
            } else {
#pragma unroll
                for (int q = 0; q < 4; ++q) { const f32x4 hv = *(const f32x4*)(hin + d * 512 + 64 * n + 32 * eb + 8 * q + 4 * hi);
#pragma unroll
                    for (int i = 0; i < 4; ++i) { const float h = bv[4 * q + i] + av[4 * q + i] * hv[i];
                        if (d) ysum[4 * q + i] = __int_as_float(__builtin_amdgcn_ds_swizzle(__float_as_int(h), 0x7C1F));
                        else ysum[4 * q + i] += h; } }
            }
        }
        if constexpr (FINAL) {
            const bf16_t* gp = (const bf16_t*)(F.ws + WS_BIG + BG_GATE) + (size_t)row * 512; bf16_t* yo = (bf16_t*)(F.ws + WS_ACT) + (size_t)row * DM;
#pragma unroll
            for (int q = 0; q < 4; ++q) { const int ch0 = 64 * n + 32 * eb + 8 * q + 4 * hi; const u32x2 gw = *(const u32x2*)(gp + ch0);
                u32x2 w; w.x = cvt_pk_bf16(ysum[4 * q] * bflo(gw.x), ysum[4 * q + 1] * bfhi(gw.x)); w.y = cvt_pk_bf16(ysum[4 * q + 2] * bflo(gw.y), ysum[4 * q + 3] * bfhi(gw.y)); *(u32x2*)(yo + ch0) = w; }
        }
    }
    __syncthreads();
}
#undef LRU_SCAN_STEP
__device__ __forceinline__ void lru_carry(Frame& F) {
    for (int i = F.bid; i < 8; i += F.G) {
        const int b = i >> 1, d = i & 1, ch = F.tid;
        const f32x2* __restrict__ sm = (const f32x2*)(F.ws + WS_BIG + BG_LSUM) + (size_t)b * LRU_NCH * 1024 + d * 512 + ch;
        float* __restrict__ hin = (float*)(F.ws + WS_BIG + BG_LHIN) + (size_t)b * LRU_NCH * 1024 + d * 512 + ch;
        float h = 0.f;
#pragma unroll 1
        for (int k0 = 0; k0 < LRU_NCH; k0 += 24) {
            f32x2 st[24]; int cidx[24];
#pragma unroll
            for (int j = 0; j < 24; ++j) { const int k = k0 + j; const int cc = d == 0 ? k : (k < 8 ? 7 - k : LRU_NCH + 7 - k); cidx[j] = cc; st[j] = sm[(size_t)cc * 1024]; }
#pragma unroll
            for (int j = 0; j < 24; ++j) { hin[(size_t)cidx[j] * 1024] = h; h = st[j].x * h + st[j].y; }
        }
    }
}
namespace at {

#define AT_SBAR() __builtin_amdgcn_sched_barrier(0)
typedef __fp16 h16x2 __attribute__((ext_vector_type(2)));
__device__ __forceinline__ int pk4raw(float a, float b, float c, float d) {
    const h16x2 lo = __builtin_amdgcn_cvt_pkrtz(a, b), hi = __builtin_amdgcn_cvt_pkrtz(c, d);
    return (int)__builtin_amdgcn_perm(*reinterpret_cast<const unsigned*>(&hi), *reinterpret_cast<const unsigned*>(&lo), 0x07050301u);
}
__device__ __forceinline__ void exp_lo(f32x16& p0) {
#pragma unroll
    for (int r = 0; r < 16; ++r) p0[r] = __builtin_amdgcn_exp2f(p0[r]);
}
template <int ABL> __device__ __forceinline__ void finishSM(f32x16& p0, f32x16& p1, i32x8& pw) {
#pragma unroll
    for (int r = 0; r < 16; ++r) p1[r] = __builtin_amdgcn_exp2f(p1[r]);
#pragma unroll
    for (int a = 0; a < 4; ++a) { if (ABL == 4) { pw[a] = __float_as_int(p0[4 * a]) | __float_as_int(p0[4 * a + 2]); pw[4 + a] = __float_as_int(p1[4 * a + 1]) | __float_as_int(p1[4 * a + 3]); continue; }
        pw[a] = pk4raw(p0[4 * a], p0[4 * a + 1], p0[4 * a + 2], p0[4 * a + 3]); pw[4 + a] = pk4raw(p1[4 * a], p1[4 * a + 1], p1[4 * a + 2], p1[4 * a + 3]); }
}
__device__ __forceinline__ void qkt(f32x16& p0, f32x16& p1, const LAS char* Ks, const i32x8& qf, int o0, int o1) {
    const i32x4 a0 = *(const LAS i32x4*)(Ks + o0), a1 = *(const LAS i32x4*)(Ks + o1), b0 = *(const LAS i32x4*)(Ks + 2048 + o0), b1 = *(const LAS i32x4*)(Ks + 2048 + o1);
    const i32x8 k0 = {a0[0], a0[1], a0[2], a0[3], a1[0], a1[1], a1[2], a1[3]}, k1 = {b0[0], b0[1], b0[2], b0[3], b1[0], b1[1], b1[2], b1[3]};
    const f32x16 c = {};
    p0 = __builtin_amdgcn_mfma_scale_f32_32x32x64_f8f6f4(k0, qf, c, 0, 0, 0, 0x78787878, 0, 0x7f7f7f7f);
    p1 = __builtin_amdgcn_mfma_scale_f32_32x32x64_f8f6f4(k1, qf, c, 0, 0, 0, 0x78787878, 0, 0x7f7f7f7f);
}
__device__ __forceinline__ void pv_d0(f32x16* o, f32x16& la, const LAS char* Vs, const i32x8& pw, const i32x8& ones, int o0, int o1) {
#pragma unroll
    for (int d0 = 0; d0 < 4; ++d0) {
        const i32x4 a0 = *(const LAS i32x4*)(Vs + d0 * 2048 + o0), a1 = *(const LAS i32x4*)(Vs + d0 * 2048 + o1);
        const i32x8 vf = {a0[0], a0[1], a0[2], a0[3], a1[0], a1[1], a1[2], a1[3]};
        o[d0] = __builtin_amdgcn_mfma_scale_f32_32x32x64_f8f6f4(pw, vf, o[d0], 1, 0, 0, 0, 0, 0);
    }
    la = __builtin_amdgcn_mfma_scale_f32_32x32x64_f8f6f4(pw, ones, la, 1, 0, 0, 0, 0, 0);
}
__device__ __forceinline__ int krow(int b, int j) { return j < 4 ? b * 256 + 64 * j : NCTX + b * 8192 + 64 * (j - 4); }

constexpr int TILE_B = 12288, KOFF_B = 8192, NRING = 5, LI_OFF = NRING * TILE_B;
template <int ABL> __device__ __forceinline__ void attn_unit(Frame& F, int b, int h, int qrow0, int NT, float lam) {
    const int tid = F.tid, wid = F.wave, lane = F.lane, r32 = lane & 31, hi = lane >> 5;
    LAS char* lds = (LAS char*)F.lds;
    const char* Q = (const char*)(F.ws + WS_BIG + BG_Q); const char* K = (const char*)(F.ws + WS_BIG + BG_K); const char* V = (const char*)(F.ws + WS_BIG + BG_V);
    const int irow = wid * 16 + (lane >> 2), lch = ((lane & 3) ^ ((irow >> 2) & 3)) << 4;
    const unsigned voff = (unsigned)h * 8192u + (unsigned)irow * 64u + (unsigned)lch;
    unsigned koff;
    { const int rho = irow & 31, t = (irow >> 5) & 1, key = 16 * (rho & 3) + 8 * ((rho >> 2) & 1) + (rho >> 3) + 4 * t; koff = (unsigned)key * 512u + (unsigned)h * 128u + (unsigned)lch; }
    const int xo = (r32 >> 2) & 3, o0 = r32 * 64 + (((2 * hi) ^ xo) << 4), o1 = r32 * 64 + (((2 * hi + 1) ^ xo) << 4);
#define AT_WAITBAR(N) asm volatile("s_waitcnt vmcnt(" #N ")\n\ts_barrier" ::: "memory")
#define AT_ISSUE(j, LEAD) do { const int _k0 = krow(b, (j)); LAS char* _bf = lds + ((j) % NRING) * TILE_B; \
        __builtin_amdgcn_global_load_lds((const unsigned*)(V + (size_t)(_k0 >> 6) * 32768 + voff), (LAS unsigned*)(_bf + wid * 1024), 16, 0, 0); \
        if (LEAD) __builtin_amdgcn_global_load_lds((const unsigned*)(K + (size_t)_k0 * 512 + m * 64 + koff), (LAS unsigned*)(_bf + KOFF_B + wid * 1024), 16, 0, 0); } while (0)
#define AT_KB(j) (lds + ((j) % NRING) * TILE_B + KOFF_B)
#define AT_VB(j) (lds + ((j) % NRING) * TILE_B)
    i32x8 ones;
#pragma unroll
    for (int i = 0; i < 8; ++i) ones[i] = 0x38383838;
#pragma unroll 1
    for (int m = 0; m < 2; ++m) {
        f32x16 la = {}; f32x16 o[4] = {}; i32x8 qf;
        { const char* Qw = Q + (size_t)(qrow0 + wid * 32 + r32) * 512 + h * 128 + m * 64 + hi * 32;
          const i32x4 q0 = *(const i32x4*)Qw, q1 = *(const i32x4*)(Qw + 16); qf = (i32x8){q0[0], q0[1], q0[2], q0[3], q1[0], q1[1], q1[2], q1[3]}; }
        asm volatile("s_waitcnt vmcnt(0)" ::: "memory");
        f32x16 pA0, pA1, pB0, pB1; i32x8 pw;
        __syncthreads();
        if (wid < 4) {
            AT_ISSUE(0, true); AT_ISSUE(1, true);
            AT_WAITBAR(2); AT_ISSUE(2, true);
            qkt(pA0, pA1, AT_KB(0), qf, o0, o1); exp_lo(pA0);
            for (int j = 1; j + 1 < NT; j += 2) {
                AT_WAITBAR(2); AT_ISSUE(j + 2, true);
                AT_SBAR(); qkt(pB0, pB1, AT_KB(j), qf, o0, o1);
                finishSM<ABL>(pA0, pA1, pw); AT_SBAR();
                pv_d0(o, la, AT_VB(j - 1), pw, ones, o0, o1); exp_lo(pB0);
                AT_WAITBAR(2); if (j + 3 < NT) AT_ISSUE(j + 3, true);
                AT_SBAR(); qkt(pA0, pA1, AT_KB(j + 1), qf, o0, o1);
                finishSM<ABL>(pB0, pB1, pw); AT_SBAR();
                pv_d0(o, la, AT_VB(j), pw, ones, o0, o1); exp_lo(pA0);
            }
            AT_WAITBAR(0);
            AT_SBAR(); qkt(pB0, pB1, AT_KB(NT - 1), qf, o0, o1);
            finishSM<ABL>(pA0, pA1, pw); AT_SBAR();
            pv_d0(o, la, AT_VB(NT - 2), pw, ones, o0, o1); exp_lo(pB0);
            finishSM<ABL>(pB0, pB1, pw); AT_SBAR();
            pv_d0(o, la, AT_VB(NT - 1), pw, ones, o0, o1);
        } else {
            AT_ISSUE(0, false); AT_ISSUE(1, false);
            AT_WAITBAR(1); AT_ISSUE(2, false);
            qkt(pA0, pA1, AT_KB(0), qf, o0, o1);
            for (int j = 1; j + 1 < NT; j += 2) {
                AT_WAITBAR(1); AT_ISSUE(j + 2, false);
                AT_SBAR(); if (j >= 2) pv_d0(o, la, AT_VB(j - 2), pw, ones, o0, o1);
                exp_lo(pA0); AT_SBAR();
                qkt(pB0, pB1, AT_KB(j), qf, o0, o1);
                finishSM<ABL>(pA0, pA1, pw);
                AT_WAITBAR(1); if (j + 3 < NT) AT_ISSUE(j + 3, false);
                AT_SBAR(); pv_d0(o, la, AT_VB(j - 1), pw, ones, o0, o1);
                exp_lo(pB0); AT_SBAR();
                qkt(pA0, pA1, AT_KB(j + 1), qf, o0, o1);
                finishSM<ABL>(pB0, pB1, pw);
            }
            AT_WAITBAR(0);
            AT_SBAR(); pv_d0(o, la, AT_VB(NT - 3), pw, ones, o0, o1);
            exp_lo(pA0); AT_SBAR();
            qkt(pB0, pB1, AT_KB(NT - 1), qf, o0, o1);
            finishSM<ABL>(pA0, pA1, pw); AT_SBAR();
            pv_d0(o, la, AT_VB(NT - 2), pw, ones, o0, o1); exp_lo(pB0);
            finishSM<ABL>(pB0, pB1, pw); AT_SBAR();
            pv_d0(o, la, AT_VB(NT - 1), pw, ones, o0, o1);
        }
        int tid2 = tid; asm volatile("" : "+v"(tid2));
        f32x4* stash = (f32x4*)(F.ws + WS_SCR) + ((size_t)F.bid * NTHREADS + tid2) * 16;
        if (m == 0) {
#pragma unroll
            for (int q = 0; q < 4; ++q) {
                const float r0 = 0.125f * __builtin_amdgcn_rcpf(la[4 * q]), r1 = 0.125f * __builtin_amdgcn_rcpf(la[4 * q + 1]), r2 = 0.125f * __builtin_amdgcn_rcpf(la[4 * q + 2]), r3 = 0.125f * __builtin_amdgcn_rcpf(la[4 * q + 3]);
#pragma unroll
                for (int d0 = 0; d0 < 4; ++d0) stash[d0 * 4 + q] = (f32x4){o[d0][4 * q] * r0, o[d0][4 * q + 1] * r1, o[d0][4 * q + 2] * r2, o[d0][4 * q + 3] * r3};
                asm volatile("" ::: "memory");
            }
        } else {
            const float* sg = F.in[I_SUBG];
            float g4[4];
#pragma unroll
            for (int d0 = 0; d0 < 4; ++d0) g4[d0] = sg[d0 * 32 + r32] * 0.8f;
            const int l2 = tid2 & 63;
            bf16_t* rp = (bf16_t*)(F.ws + WS_ACT) + (size_t)(qrow0 + wid * 32 + 4 * (l2 >> 5)) * DM + 512 + h * 128 + (l2 & 31);
#pragma unroll
            for (int q = 0; q < 4; ++q) {
                f32x4 st[4];
#pragma unroll
                for (int d0 = 0; d0 < 4; ++d0) st[d0] = stash[d0 * 4 + q];
#pragma unroll
                for (int i = 0; i < 4; ++i) { const int r = 4 * q + i; const float rl = 0.125f * __builtin_amdgcn_rcpf(la[r]);
                    float v[4], ss = 0.f;
#pragma unroll
                    for (int d0 = 0; d0 < 4; ++d0) { v[d0] = st[d0][i] - lam * (o[d0][r] * rl); ss += v[d0] * v[d0]; }
                    ss += __shfl_xor(ss, 1); ss += __shfl_xor(ss, 2); ss += __shfl_xor(ss, 4); ss += __shfl_xor(ss, 8); ss += __shfl_xor(ss, 16);
                    const float rstd = rsqrtf(ss * (1.f / 128.f) + EPS);
#pragma unroll
                    for (int d0 = 0; d0 < 4; ++d0) rp[(size_t)i * DM + d0 * 32] = f2bf(v[d0] * rstd * g4[d0]); }
                rp += 8 * DM;
                asm volatile("" : "+v"(rp) :: "memory");
            }
        }
    }
#undef AT_WAITBAR
#undef AT_LWAIT
#undef AT_ISSUE
#undef AT_KB
#undef AT_VB
#undef AT_SBAR
}
}
struct MoeGeo { int layer, NR, HR, UR; };
__device__ __forceinline__ MoeGeo moe_geo(int layer) { MoeGeo g; g.layer = layer; g.NR = layer ? NLAT : NROW; g.HR = g.NR; g.UR = g.NR / 256; return g; }
__device__ __forceinline__ bf16_t* moe_xrow(const Frame& F, int layer, int mrow) { return layer ? xb1_ptr(F, mrow) : xb0_ptr(F, mrow); }
__device__ __forceinline__ int moe_mi(int layer, int mrow) { return layer ? (mrow >> 13) : row_mi(mrow); }

__device__ __forceinline__ void router_phase(Frame& F, int layer) {
    const MoeGeo G = moe_geo(layer);
    LAS float* rs = (LAS float*)F.lds;
    LAS float* lgt = (LAS float*)(F.lds + 1024) + F.wave * 1024;
    LAS int* selE = (LAS int*)(F.lds + 65536);
    LAS float* selG = (LAS float*)(F.lds + 65536 + 4096);
    LAS int* selP = (LAS int*)(F.lds + 65536 + 8192);
    LAS int* hist = (LAS int*)(F.lds + 65536 + 12288);
    LAS int* basev = hist + 64;
    unsigned char* H2 = F.ws + WS_ACT;
    const bf16_t* wh = (const bf16_t*)(F.ws + WS_WRT) + (size_t)(layer * 2) * 65536; const bf16_t* wl = wh + 65536;
    const float* rb = F.in[I_RB] + layer * 64;
    const float* gn = F.in[I_N2G] + layer * DM;
    int* cnt = (int*)(F.ws + WS_CTL) + layer * 128;
    i32x2* list = (i32x2*)(F.ws + WS_LIST);
    const int w = F.wave, e = F.lane, fr = F.lane & 15, kq = F.lane >> 4;
    for (int unit = F.bid; unit < 256; unit += F.G) {
        const int half = 0, mrow0 = unit * G.UR;
        if (F.tid < 64) hist[F.tid] = 0;
        { const float* ssq = (const float*)(F.ws + WS_BIG + BG_SSQ); const int np = layer ? 32 : 16;
          for (int lr = w; lr < G.UR; lr += NWAVES) { const int mrow = mrow0 + lr; float s = F.lane < np ? ssq[(size_t)mrow * 32 + F.lane] : 0.f;
              s = wave_sum(s); if (F.lane == 0) rs[lr] = rsqrtf(s * (1.f / DM) + EPS); } }
        const int miA = moe_mi(layer, mrow0), miB = moe_mi(layer, mrow0 + G.UR - 1);
        LAS float* tab = (LAS float*)(F.lds + 36864);
        for (int i = F.tid; i < 2048; i += NTHREADS) { const int sl = i >> 10, k = i & 1023, mi = sl ? miB : miA;
            tab[sl * 2048 + k] = gn[k] * (modv(F, layer, mi, 4)[k] + 1.0f); tab[sl * 2048 + 1024 + k] = modv(F, layer, mi, 3)[k]; }
        __syncthreads();
        for (int g0 = 16 * w; g0 < G.UR; g0 += 16 * NWAVES) {
            const int nrow = (G.UR - g0) < 16 ? (G.UR - g0) : 16; const bool rok = fr < nrow;
            const int lrow = g0 + (rok ? fr : nrow - 1), mrow = mrow0 + lrow, mi = moe_mi(layer, mrow);
            const bf16_t* xp = moe_xrow(F, layer, mrow) + 8 * kq; const float rstd = rs[lrow];
            const LAS float* tp = tab + (mi == miA ? 0 : 2048) + 8 * kq;
            unsigned char* hp = H2 + (size_t)mrow * DM + 8 * kq;
            const bf16_t* whp = wh + (size_t)fr * 1024 + 8 * kq;
            f32x4 acc[4];
#pragma unroll
            for (int i = 0; i < 4; ++i) acc[i] = (f32x4){0.f, 0.f, 0.f, 0.f};
            u32x4 xring[8];
#pragma unroll
            for (int i = 0; i < 8; ++i) xring[i] = *(const u32x4*)(xp + 32 * i);
#pragma unroll 1
            for (int ks8 = 0; ks8 < 32; ks8 += 8) {
#pragma unroll
                for (int ki = 0; ki < 8; ++ki) {
                    const int k0 = 32 * (ks8 + ki);
                    const u32x4 xw = xring[ki]; if (ks8 + 8 < 32) xring[ki] = *(const u32x4*)(xp + k0 + 256);
                    const f32x4 x0 = bf4_to_f32((u32x2){xw.x, xw.y}), x1 = bf4_to_f32((u32x2){xw.z, xw.w});
                    const f32x4 a0 = *(const LAS f32x4*)(tp + k0), a1 = *(const LAS f32x4*)(tp + k0 + 4), b0 = *(const LAS f32x4*)(tp + 1024 + k0), b1 = *(const LAS f32x4*)(tp + 1024 + k0 + 4);
                    const f32x4 y0 = (x0 * rstd) * a0 + b0, y1 = (x1 * rstd) * a1 + b1;
                    u32x4 hv; hv.x = cvt_pk_bf16(y0.x, y0.y); hv.y = cvt_pk_bf16(y0.z, y0.w); hv.z = cvt_pk_bf16(y1.x, y1.y); hv.w = cvt_pk_bf16(y1.z, y1.w);
                    if (rok) { u32x2 h8; h8.x = pk4_fp8(y0.x, y0.y, y0.z, y0.w); h8.y = pk4_fp8(y1.x, y1.y, y1.z, y1.w); *(u32x2*)(hp + k0) = h8; }
                    const bf16x8 ah = *reinterpret_cast<const bf16x8*>(&hv);
#pragma unroll
                    for (int blk = 0; blk < 4; ++blk) { const bf16x8 bh = *(const bf16x8*)(whp + (size_t)blk * 16 * 1024 + k0);
                        acc[blk] = __builtin_amdgcn_mfma_f32_16x16x32_bf16(ah, bh, acc[blk], 0, 0, 0); }
                }
            }
#pragma unroll
            for (int blk = 0; blk < 4; ++blk)
#pragma unroll
                for (int r = 0; r < 4; ++r) lgt[(4 * kq + r) * 64 + 16 * blk + fr] = acc[blk][r];
            asm volatile("s_waitcnt lgkmcnt(0)" ::: "memory");
            const float bias = rb[e];
            for (int rr = 0; rr < nrow; ++rr) {
                const float lg = lgt[rr * 64 + e];
                const float aff = 1.0f / (1.0f + expf(-lg)); const float scv = aff + bias;
                int rank = 0;
#pragma unroll 8
                for (int j = 0; j < 64; ++j) { const float sj = __shfl(scv, j); rank += (sj > scv || (sj == scv && j < e)) ? 1 : 0; }
                const bool sel = rank < 6; const float ssum = wave_sum(sel ? aff : 0.f);
                if (sel) { const int idx = (g0 + rr) * 6 + rank; selE[idx] = e; selG[idx] = aff / ssum * 2.5f; selP[idx] = atomicAdd((int*)&hist[e], 1); }
            }
            asm volatile("s_waitcnt lgkmcnt(0)" ::: "memory");
        }
        __syncthreads();
        if (F.tid < 64) basev[F.tid] = atomicAdd(&cnt[half * 64 + F.tid], hist[F.tid]);
        __syncthreads();
        for (int idx = F.tid; idx < G.UR * 6; idx += NTHREADS) { const int ee = selE[idx], lrow = idx / 6, slot = idx - lrow * 6, mrow = mrow0 + lrow;
            list[(size_t)(half * 64 + ee) * CAPH + basev[ee] + selP[idx]] = (i32x2){mrow * 8 + slot, __float_as_int(selG[idx])};
            ((float*)(F.ws + WS_GATE))[(size_t)mrow * 8 + slot] = selG[idx]; }
        __syncthreads();
    }
}

__device__ __forceinline__ void moe_table(Frame& F, const int* cnt) {
    LAS int* tstart = (LAS int*)(F.lds + MISC_OFF); LAS int* tcnt = tstart + 64;
    if (F.wave == 0) { const int c = cnt[F.lane]; const int nt = (c + 255) >> 8; int incl = nt;
#pragma unroll
        for (int o = 1; o < 64; o <<= 1) { const int v = __shfl_up(incl, o); if (F.lane >= o) incl += v; }
        tstart[F.lane] = incl - nt; tcnt[F.lane] = c; }
    __syncthreads();
}
struct SchedMoe { int G, c, nsh, npn, half_base; const LAS int* tstart; const i32x2* list; const char* A0; const char* W0; size_t wofs, tstepB, astep;
    __device__ __forceinline__ const i32x2* dummy() const { return list; }
    __device__ __forceinline__ bool next(int k, ge::GUnit& u) const {
        const int T = (k / npn) * G + c, pn = k % npn;
        int e = 64, j = T, nv = 256;
        if (T >= nsh) { const int rem = T - nsh, l = lane_id() & 63; const int st = tstart[l], cn_l = tstart[64 + l];
            const unsigned long long m = __ballot(rem >= st && rem < st + ((cn_l + 255) >> 8));
            if (m == 0ull) return false;
            e = __builtin_ctzll(m); j = rem - tstart[e]; const int cn = tstart[64 + e]; nv = (cn - j * 256) < 256 ? (cn - j * 256) : 256; }
        u.pm = T; u.pn = pn; u.nvalid = nv; u.rows = e == 64 ? nullptr : list + (size_t)e * CAPH + j * 256; u.aux = e == 64 ? half_base + j * 256 : 0;
        u.A = A0 + (size_t)T * astep; u.B = W0 + (size_t)e * EXP_STRIDE + wofs + (size_t)pn * tstepB; return true; }
};
__device__ __forceinline__ void moe_up(Frame& F, int layer, int half) {
    const MoeGeo G = moe_geo(layer);
    moe_table(F, (const int*)(F.ws + WS_CTL) + layer * 128 + half * 64);
    const int cs = (F.G % 8 == 0) ? (F.bid % 8) * (F.G / 8) + F.bid / 8 : F.bid;
    SchedMoe S{F.G, cs, G.HR / 256, 2, half * G.HR, (const LAS int*)(F.lds + MISC_OFF), (const i32x2*)(F.ws + WS_LIST) + (size_t)half * 64 * CAPH,
               (const char*)(F.ws + WS_ACT), (const char*)(F.ws + WS_EXP), (size_t)0, (size_t)256 * 1024, (size_t)0};
    EpiUp E{F.ws + WS_SCR};
    ge::gemm_run<EpiUp, SchedMoe, ge::AMapPlain, 2, true>(F.lds, nullptr, 8, 1024u, 0u, (size_t)128, ge::AMapPlain{1024u}, 1024u, S, E, 0x79797979, 0x7f7f7f7f);
}
__device__ __forceinline__ void moe_down(Frame& F, int layer, int half) {
    const MoeGeo G = moe_geo(layer);
    moe_table(F, (const int*)(F.ws + WS_CTL) + layer * 128 + half * 64);
    const int cs = (F.G % 8 == 0) ? (F.bid % 8) * (F.G / 8) + F.bid / 8 : F.bid;
    SchedMoe S{F.G, cs, G.HR / 256, 4, half * G.HR, (const LAS int*)(F.lds + MISC_OFF), (const i32x2*)(F.ws + WS_LIST) + (size_t)half * 64 * CAPH,
               (const char*)(F.ws + WS_SCR), (const char*)(F.ws + WS_EXP), (size_t)EXP_WD, (size_t)256 * 256, (size_t)256 * 256};
    EpiDown E{F.ws + WS_BIG, half * G.HR};
    ge::gemm_run<EpiDown, SchedMoe, ge::AMapPlain, 0, true>(F.lds, nullptr, 2, 256u, 128u * 256u, (size_t)128, ge::AMapPlain{256u}, 0u, S, E, 0x7a7a7a7a, 0x7b7b7b7b);
}

struct DTile { int e, nv, valid, aux, j; };
__device__ __forceinline__ DTile down_tile(int T, int nsh, const LAS int* tstart) {
    DTile t; t.e = 64; t.nv = 256; t.valid = 1; t.j = T;
    if (T >= nsh) { const int rem = T - nsh, l = lane_id() & 63; const int st = tstart[l], cn_l = tstart[64 + l];
        const unsigned long long m = __ballot(rem >= st && rem < st + ((cn_l + 255) >> 8));
        if (m == 0ull) { t.valid = 0; t.aux = 0; return t; }
        t.e = __builtin_ctzll(m); t.j = __builtin_amdgcn_readfirstlane(rem - tstart[t.e]); const int cn = __builtin_amdgcn_readfirstlane(tstart[64 + t.e]); t.nv = (cn - t.j * 256) < 256 ? (cn - t.j * 256) : 256; }
    t.aux = t.e == 64 ? t.j * 256 : 0;
    return t;
}
#ifndef D2_LOCKSTEP
#define D2_LOCKSTEP 0
#endif
template <int ABL> __device__ __forceinline__ void moe_down2(Frame& F, int layer) {
    const MoeGeo G = moe_geo(layer);
    moe_table(F, (const int*)(F.ws + WS_CTL) + layer * 128);
    const int cs = (F.G % 8 == 0) ? (F.bid % 8) * (F.G / 8) + F.bid / 8 : F.bid;
    const LAS int* tstart = (const LAS int*)(F.lds + MISC_OFF);
    const i32x2* list = (const i32x2*)(F.ws + WS_LIST);
    const int nsh = G.HR / 256;
    int tid_ = threadIdx.x; asm volatile("" : "+v"(tid_));
    const int tid = tid_, wid = __builtin_amdgcn_readfirstlane(tid >> 6), lane = tid & 63, grp = wid >> 2, w4 = wid & 3, fr = lane & 15, fq = lane >> 4;
    int ntl = 0; while (down_tile(ntl * F.G + cs, nsh, tstart).valid) ++ntl;
    const int Q = 8 * ntl;
    if (Q == 0) return;
    LAS char* hbuf = (LAS char*)F.lds; LAS char* bbuf = (LAS char*)F.lds + 65536 + grp * 32768; LAS char* ebuf = (LAS char*)F.lds + MISC_OFF + 1024 + wid * 512;
    const unsigned char* HID = F.ws + WS_SCR; const unsigned char* W0 = F.ws + WS_EXP + EXP_WD; unsigned char* Y = F.ws + WS_BIG;
    unsigned xsrc[4];
#pragma unroll
    for (int i = 0; i < 4; ++i) xsrc[i] = (unsigned)fq * 256u + 16u * (unsigned)((lane & 15) ^ (4 * i + fq));
    int wof[2][2];
#pragma unroll
    for (int ks = 0; ks < 2; ++ks)
#pragma unroll
        for (int j = 0; j < 2; ++j) wof[ks][j] = fr * 256 + 16 * ((8 * ks + 2 * fq + j) ^ fr);
    const int sw = 0x7d7d7d7d, sa = 0x7b7b7b7b;
    f32x4 acc[4][4];
    i32x8 hf[4][2];
    i32x2 ent[4];
    DTile cur = down_tile(cs, nsh, tstart), nx = cur;
    u32x4 pw[4]; int ph = -1;
#define D2_DMAH(TI, K) do { const unsigned char* _hp = HID + (size_t)((K) * F.G + cs) * 65536 + (size_t)(32 * wid) * 256; \
        _Pragma("unroll") for (int _i = 0; _i < 8; ++_i) \
            __builtin_amdgcn_global_load_lds((const unsigned*)(_hp + _i * 1024 + xsrc[_i & 3]), (LAS unsigned*)(hbuf + wid * 8192 + _i * 1024), 16, 0, 0); \
        if ((TI).e != 64 && lane < 32) __builtin_amdgcn_global_load_lds((const unsigned*)((const char*)(list + (size_t)(TI).e * CAPH + (TI).j * 256 + 64 * w4) + lane * 16), (LAS unsigned*)ebuf, 16, 0, 0); } while (0)
#define D2_DMA(QQ, TI) do { const unsigned char* _wb = W0 + (size_t)(TI).e * EXP_STRIDE + (size_t)((((QQ) & 7) * 2 + grp) * 64 + 4 * w4) * 256; LAS char* _lb = bbuf + ((QQ) & 1) * 16384 + w4 * 4096; \
        _Pragma("unroll") for (int _i = 0; _i < 4; ++_i) \
            __builtin_amdgcn_global_load_lds((const unsigned*)(_wb + _i * 4096 + xsrc[_i]), (LAS unsigned*)(_lb + _i * 1024), 16, 0, 0); } while (0)
    D2_DMAH(cur, 0);
    D2_DMA(0, cur); D2_DMA(1, cur);
#pragma unroll 1
    for (int s = 0; s <= 2 * Q; ++s) {
        const int u = D2_LOCKSTEP ? s : s - grp; const bool act = u >= 0 && u < 2 * Q; const int q = u >> 1; const bool mf = act && !(u & 1), ep = act && (u & 1);
        if (ABL == 5) asm volatile("s_waitcnt vmcnt(30)" ::: "memory"); else
        if (act && q + 1 < Q) asm volatile("s_waitcnt vmcnt(4)" ::: "memory"); else asm volatile("s_waitcnt vmcnt(0)" ::: "memory");
        if (ABL != 6) __builtin_amdgcn_s_barrier();
#define D2_FLUSH() do { if (ABL == 4) { _Pragma("unroll") for (int _m = 0; _m < 4; ++_m) asm volatile("" :: "v"(pw[_m])); ph = -1; } if (ph >= 0 && ABL != 1) { _Pragma("unroll") for (int _m = 0; _m < 4; ++_m) { const int _rt = 64 * w4 + 16 * _m + fr; \
            if (_rt < cur.nv) { const int _pk = ent[_m].x; *(u32x4*)(Y + ((size_t)(_pk >> 3) * 7 + (_pk & 7)) * 1024 + ph * 64 + 16 * fq) = pw[_m]; } } ph = -1; } } while (0)
        if (mf) {
            D2_FLUSH();
            if ((q & 7) == 0) {
                if (q) cur = nx;
                nx = down_tile(((q >> 3) + 1) * F.G + cs, nsh, tstart);
#pragma unroll
                for (int m = 0; m < 4; ++m) {
#pragma unroll
                    for (int ks = 0; ks < 2; ++ks) { const LAS char* hp = hbuf + (64 * w4 + 16 * m) * 256; const i32x4 a0 = *(const LAS i32x4*)(hp + wof[ks][0]), a1 = *(const LAS i32x4*)(hp + wof[ks][1]);
                        hf[m][ks] = (i32x8){a0[0], a0[1], a0[2], a0[3], a1[0], a1[1], a1[2], a1[3]}; }
                    const int rt = 64 * w4 + 16 * m + fr;
                    if (cur.e != 64) ent[m] = *(const LAS i32x2*)(ebuf + (16 * m + fr) * 8); else ent[m] = (i32x2){((cur.aux + rt) << 3) | 6, 0x3f800000};
                }
            }
            const LAS char* wb = bbuf + (q & 1) * 16384;
            i32x8 wf[2];
#define D2_RD(IDX, DST) do { const i32x4 _a = *(const LAS i32x4*)(wb + ((IDX) & 3) * 4096 + wof[(IDX) >> 2][0]), _b = *(const LAS i32x4*)(wb + ((IDX) & 3) * 4096 + wof[(IDX) >> 2][1]); \
                DST = (i32x8){_a[0], _a[1], _a[2], _a[3], _b[0], _b[1], _b[2], _b[3]}; } while (0)
            D2_RD(0, wf[0]);
#pragma unroll
            for (int idx = 0; idx < 8; ++idx) {
                if (idx + 1 < 8) D2_RD(idx + 1, wf[(idx + 1) & 1]);
                const int nt = idx & 3, ks = idx >> 2;
#pragma unroll
                for (int m = 0; m < 4; ++m) {
                    if (ABL == 2) { if (ks == 0) acc[m][nt] = (f32x4){(float)wf[idx & 1][0], (float)wf[idx & 1][3], 0.f, 0.f}; } else
                    if (ks == 0) asm volatile("v_mfma_scale_f32_16x16x128_f8f6f4 %0, %1, %2, 0, %3, %4 op_sel_hi:[0,0,0]" : "=&v"(acc[m][nt]) : "v"(wf[idx & 1]), "v"(hf[m][0]), "v"(sw), "v"(sa));
                    else asm volatile("v_mfma_scale_f32_16x16x128_f8f6f4 %0, %1, %2, %0, %3, %4 op_sel_hi:[0,0,0]" : "+v"(acc[m][nt]) : "v"(wf[idx & 1]), "v"(hf[m][1]), "v"(sw), "v"(sa));
                }
            }
#undef D2_RD
            asm volatile("s_nop 15\n\ts_nop 15" ::: "memory");
        } else if (ep) {
            ph = (q & 7) * 2 + grp;
            if (ABL != 1)
#pragma unroll
            for (int m = 0; m < 4; ++m) {
                int lo[4];
#pragma unroll
                for (int nt = 0; nt < 4; ++nt) { const float cx = __builtin_amdgcn_fmed3f(acc[m][nt].x, -448.f, 448.f); lo[nt] = __builtin_amdgcn_cvt_pk_fp8_f32(cx, __builtin_amdgcn_fmed3f(acc[m][nt].y, -448.f, 448.f), __float_as_int(cx), false); }
#pragma unroll
                for (int nt = 0; nt < 4; ++nt) lo[nt] = __builtin_amdgcn_cvt_pk_fp8_f32(__builtin_amdgcn_fmed3f(acc[m][nt].z, -448.f, 448.f), __builtin_amdgcn_fmed3f(acc[m][nt].w, -448.f, 448.f), lo[nt], true);
                pw[m] = (u32x4){(unsigned)lo[0], (unsigned)lo[1], (unsigned)lo[2], (unsigned)lo[3]};
            }
            if ((q & 7) == 2 && nx.valid) D2_DMAH(nx, (q >> 3) + 1);
            if (q + 2 < Q && ABL != 3) { if (((q + 2) >> 3) == (q >> 3)) D2_DMA(q + 2, cur); else D2_DMA(q + 2, nx); }
        }
    }
    D2_FLUSH();
#undef D2_FLUSH
#undef D2_DMAH
#undef D2_DMA
    asm volatile("s_waitcnt vmcnt(0)" ::: "memory");
    __syncthreads();
}

__device__ __forceinline__ void combine_phase(Frame& F, int layer, int half) {
    const MoeGeo G = moe_geo(layer);
    const int gw = F.bid * NWAVES + F.wave, NGW = F.G * NWAVES;
    const unsigned char* Y = F.ws + WS_BIG;
    const float* gts = (const float*)(F.ws + WS_GATE);
    const f32x4* gn1 = (const f32x4*)(F.in[I_N1G] + DM) + F.lane;
    for (int lr = gw; lr < G.HR; lr += NGW) {
        const int mrow = half * G.HR + lr, mi = moe_mi(layer, mrow);
        f32x4 a[4];
#pragma unroll
        for (int j = 0; j < 4; ++j) a[j] = (f32x4){0.f, 0.f, 0.f, 0.f};
#pragma unroll
        for (int k = 0; k < 7; ++k) { const unsigned* yp = (const unsigned*)(Y + ((size_t)lr * 7 + k) * 1024) + F.lane;
            const float gk = k < 6 ? gts[(size_t)mrow * 8 + k] : 1.0f;
#pragma unroll
            for (int j = 0; j < 4; ++j) a[j] += unpk4_fp8(yp[64 * j]) * gk; }
#pragma unroll
        for (int j = 0; j < 4; ++j) a[j] = a[j] * (1.0f / 8.0f);
        u32x2* xr = (u32x2*)moe_xrow(F, layer, mrow) + F.lane; const f32x4* g2 = (const f32x4*)modv(F, layer, mi, 5) + F.lane;
        f32x4 v[4]; float s = 0.f;
#pragma unroll
        for (int j = 0; j < 4; ++j) { v[j] = bf4_to_f32(xr[64 * j]) + g2[64 * j] * a[j]; s += (v[j].x * v[j].x + v[j].y * v[j].y) + (v[j].z * v[j].z + v[j].w * v[j].w); }
        if (layer) { f32x4* xo = (f32x4*)(F.out + (size_t)mrow * DM) + F.lane;
#pragma unroll
            for (int j = 0; j < 4; ++j) xo[64 * j] = v[j]; }
        else {
#pragma unroll
            for (int j = 0; j < 4; ++j) xr[64 * j] = f32_to_bf4(v[j]); }
        if (layer == 0) {
            const float rstd = rsqrtf(wave_sum(s) * (1.f / DM) + EPS);
            const f32x4* sh = (const f32x4*)modv(F, 1, mi, 0) + F.lane; const f32x4* sc = (const f32x4*)modv(F, 1, mi, 1) + F.lane;
            bf16_t* base; int tau;
            if (mrow < NCTX) { const int bb = mrow >> 8, t = mrow & 255; tau = t & 31; base = (bf16_t*)(F.ws + WS_HS5C) + (size_t)(bb * 8 + (t >> 5)) * 768; }
            else { const int q = mrow - NCTX, bb = q >> 13, t = q & 8191; tau = t & 31; base = (bf16_t*)(F.ws + WS_HS5L) + (size_t)(bb * 256 + (t >> 5)) * 768; }
            const size_t gstride = mrow < NCTX ? (size_t)32 * 768 : (size_t)1024 * 768;
#pragma unroll
            for (int j = 0; j < 4; ++j) { const f32x4 y = (v[j] * rstd) * gn1[64 * j] * (sc[64 * j] + 1.0f) + sh[64 * j];
                const int c = 4 * F.lane + 256 * j; u32x2 wv; wv.x = cvt_pk_bf16(y.x, y.y); wv.y = cvt_pk_bf16(y.z, y.w);
                *(u32x2*)(base + (size_t)(c >> 4) * gstride + tau * 16 + (c & 15)) = wv; }
        }
    }
}
struct S5P { float dre, dim, cre, cim; };
__device__ __forceinline__ S5P s5_param(const Frame& F, int di, int g, int p) {
    const int idx = (di * 64 + g) * 64 + p;
    const float are = fminf(F.in[I_SARE][idx], -1e-4f), aim = F.in[I_SAIM][idx], dl = expf(F.in[I_SLOG][idx]);
    S5P r; r.dre = are * dl; r.dim = aim * dl;
    float s, c; sincosf(r.dim, &s, &c); const float m = expf(r.dre); const float lr = m * c - 1.0f, li = m * s;
    const float den = 1.0f / (are * are + aim * aim);
    r.cre = (lr * are + li * aim) * den; r.cim = (li * are - lr * aim) * den; return r;
}
__device__ __forceinline__ void cpow(const S5P& q, float k, float& wr, float& wi) { float s, c; sincosf(k * q.dim, &s, &c); const float m = expf(k * q.dre); wr = m * c; wi = m * s; }

__device__ __forceinline__ void s5_tables(Frame& F) {
    bf16_t* TA = (bf16_t*)(F.ws + WS_ACT + AC_S5A);
    bf16_t* TB = (bf16_t*)(F.ws + WS_ACT + AC_S5B);
    LAS float* wl = (LAS float*)(F.lds + MISC_OFF) + F.wave * 256;
    const int gw = F.bid * NWAVES + F.wave, NGW = F.G * NWAVES, p = F.lane;
    constexpr int NA = 64 * 63, NB_ = 64 * 32, NC = 64 * 32;
    const float* bre = F.in[I_SBRE]; const float* bim = F.in[I_SBIM]; const float* cre = F.in[I_SCRE]; const float* cim = F.in[I_SCIM];
    for (int it = gw; it < NA + NB_ + NC; it += NGW) {
        if (it < NA) {
            const int g = it / 63, dlt = it % 63 - 31, ad = dlt < 0 ? -dlt : dlt;
            { const S5P qf = s5_param(F, 0, g, p), qb = s5_param(F, 1, g, p); float wr, wi;
              cpow(qf, (float)ad, wr, wi); wl[p] = wr * qf.cre - wi * qf.cim; wl[64 + p] = wr * qf.cim + wi * qf.cre;
              cpow(qb, (float)ad, wr, wi); wl[128 + p] = wr * qb.cre - wi * qb.cim; wl[192 + p] = wr * qb.cim + wi * qb.cre; }
            asm volatile("s_waitcnt lgkmcnt(0)" ::: "memory");
            const int i = F.lane >> 2, j0 = 4 * (F.lane & 3);
            float acc[4] = {0.f, 0.f, 0.f, 0.f};
            LAS float* st = (LAS float*)F.lds + F.wave * 4096;
#pragma unroll 1
            for (int di = 0; di < 2; ++di) {
                if ((di == 0 && dlt < 0) || (di == 1 && dlt > 0)) continue;
                { const float* src[4] = {cre + (size_t)(di * 64 + g) * 1024, cim + (size_t)(di * 64 + g) * 1024, bre + (size_t)(di * 64 + g) * 1024, bim + (size_t)(di * 64 + g) * 1024};
                  f32x4 v[4][4];
#pragma unroll
                  for (int a = 0; a < 4; ++a)
#pragma unroll
                      for (int q = 0; q < 4; ++q) v[a][q] = *(const f32x4*)(src[a] + 256 * q + 4 * F.lane);
#pragma unroll
                  for (int a = 0; a < 4; ++a)
#pragma unroll
                      for (int q = 0; q < 4; ++q) { const int e = 256 * q + 4 * F.lane; const int idx = a < 2 ? ((e & ~63) | ((e & 63) ^ ((e >> 6) << 2))) : e; *(LAS f32x4*)(st + a * 1024 + idx) = v[a][q]; } }
                asm volatile("s_waitcnt lgkmcnt(0)" ::: "memory");
                const LAS float* cr = st + i * 64, * ci = st + 1024 + i * 64, * br = st + 2048 + j0, * bi = st + 3072 + j0;
#pragma unroll 8
                for (int pp = 0; pp < 64; ++pp) { const float wr = wl[di * 128 + pp], wi = wl[di * 128 + 64 + pp]; const float c_r = cr[pp ^ (i << 2)], c_i = ci[pp ^ (i << 2)];
                    const float xr = c_r * wr - c_i * wi, xi = c_r * wi + c_i * wr; const f32x4 b_r = *(const LAS f32x4*)(br + pp * 16), b_i = *(const LAS f32x4*)(bi + pp * 16);
                    acc[0] += xr * b_r.x - xi * b_i.x; acc[1] += xr * b_r.y - xi * b_i.y; acc[2] += xr * b_r.z - xi * b_i.z; acc[3] += xr * b_r.w - xi * b_i.w; }
                asm volatile("s_waitcnt lgkmcnt(0)" ::: "memory");
            }
            if (dlt == 0) { const int jj = i - j0; if (jj >= 0 && jj < 4) { const float dv = F.in[I_SD][g * 16 + i]; if (jj == 0) acc[0] += dv; else if (jj == 1) acc[1] += dv; else if (jj == 2) acc[2] += dv; else acc[3] += dv; } }
            u32x2 wv; wv.x = cvt_pk_bf16(acc[0], acc[1]); wv.y = cvt_pk_bf16(acc[2], acc[3]);
            for (int sg = 0; sg < 32; ++sg) { const int tau = sg + dlt; if (tau >= 0 && tau < 32) *(u32x2*)(TB + ((size_t)g * 512 + tau * 16 + i) * 768 + sg * 16 + j0) = wv; }
            asm volatile("s_waitcnt lgkmcnt(0)" ::: "memory");
        } else if (it < NA + NB_) {
            const int r = it - NA, g = r >> 5, tau = r & 31;
            const S5P qf = s5_param(F, 0, g, p), qb = s5_param(F, 1, g, p); float fr_, fi_, br_, bi_;
            cpow(qf, (float)(tau + 1), fr_, fi_); cpow(qb, (float)(32 - tau), br_, bi_);
            for (int i = 0; i < 16; ++i) {
                const float c0r = cre[((size_t)(0 * 64 + g) * 16 + i) * 64 + p], c0i = cim[((size_t)(0 * 64 + g) * 16 + i) * 64 + p];
                const float c1r = cre[((size_t)(1 * 64 + g) * 16 + i) * 64 + p], c1i = cim[((size_t)(1 * 64 + g) * 16 + i) * 64 + p];
                bf16_t* row = TB + ((size_t)g * 512 + tau * 16 + i) * 768 + 512;
                row[p] = f2bf(c0r * fr_ - c0i * fi_); row[64 + p] = f2bf(-(c0r * fi_ + c0i * fr_));
                row[128 + p] = f2bf(c1r * br_ - c1i * bi_); row[192 + p] = f2bf(-(c1r * bi_ + c1i * br_)); }
        } else {
            const int r = it - NA - NB_, g = r >> 5, sg = r & 31;
            const S5P qf = s5_param(F, 0, g, p), qb = s5_param(F, 1, g, p); float wr, wi;
            cpow(qf, (float)(31 - sg), wr, wi); const float fr_ = wr * qf.cre - wi * qf.cim, fi_ = wr * qf.cim + wi * qf.cre;
            cpow(qb, (float)sg, wr, wi); const float br_ = wr * qb.cre - wi * qb.cim, bi_ = wr * qb.cim + wi * qb.cre;
            const float* b0r = bre + ((size_t)(0 * 64 + g) * 64 + p) * 16; const float* b0i = bim + ((size_t)(0 * 64 + g) * 64 + p) * 16;
            const float* b1r = bre + ((size_t)(1 * 64 + g) * 64 + p) * 16; const float* b1i = bim + ((size_t)(1 * 64 + g) * 64 + p) * 16;
            bf16_t* r0 = TA + ((size_t)g * 256 + p) * 512 + sg * 16;
#pragma unroll
            for (int q4 = 0; q4 < 4; ++q4) { const f32x4 xr = *(const f32x4*)(b0r + 4 * q4), xi = *(const f32x4*)(b0i + 4 * q4), yr = *(const f32x4*)(b1r + 4 * q4), yi = *(const f32x4*)(b1i + 4 * q4);
                const f32x4 are_ = xr * fr_ - xi * fi_, aim_ = xr * fi_ + xi * fr_, bre_ = yr * br_ - yi * bi_, bim_ = yr * bi_ + yi * br_;
                u32x2 w0, w1, w2, w3; w0.x = cvt_pk_bf16(are_.x, are_.y); w0.y = cvt_pk_bf16(are_.z, are_.w); w1.x = cvt_pk_bf16(aim_.x, aim_.y); w1.y = cvt_pk_bf16(aim_.z, aim_.w);
                w2.x = cvt_pk_bf16(bre_.x, bre_.y); w2.y = cvt_pk_bf16(bre_.z, bre_.w); w3.x = cvt_pk_bf16(bim_.x, bim_.y); w3.y = cvt_pk_bf16(bim_.z, bim_.w);
                *(u32x2*)(r0 + 4 * q4) = w0; *(u32x2*)(r0 + (size_t)64 * 512 + 4 * q4) = w1; *(u32x2*)(r0 + (size_t)128 * 512 + 4 * q4) = w2; *(u32x2*)(r0 + (size_t)192 * 512 + 4 * q4) = w3; }
        }
    }
}

struct SchedS5a { __device__ __forceinline__ const i32x2* dummy() const { return nullptr; } int G, c; const char* HL; const char* HC; const char* TA;
    __device__ __forceinline__ bool next(int i, ge::GUnit& u) const { const int L = i * G + c; if (L >= 320) return false; const int g = L / 5, k = L % 5;
        u.aux = g; u.pm = k; u.pn = 0; u.nvalid = 256; u.A = k < 4 ? HL + ((size_t)g * 1024 + k * 256) * 1536 : HC + (size_t)g * 32 * 1536; u.B = TA + (size_t)g * 256 * 1024; return true; } };
struct SchedS5b { __device__ __forceinline__ const i32x2* dummy() const { return nullptr; } int G, c; const char* HL; const char* TB;
    __device__ __forceinline__ bool next(int i, ge::GUnit& u) const { const int L = i * G + c; if (L >= 512) return false; const int g = L >> 3, k = (L >> 1) & 3, pn = L & 1;
        u.aux = g; u.pm = k; u.pn = pn; u.nvalid = 256; u.A = HL + ((size_t)g * 1024 + k * 256) * 1536; u.B = TB + ((size_t)g * 512 + pn * 256) * 1536; return true; } };

__device__ __forceinline__ void s5_carry(Frame& F) {
    LAS float* ex = (LAS float*)F.lds;
    for (int u = F.bid; u < 512; u += F.G) {
        const int di = u & 1, b = (u >> 1) & 3, g = u >> 3, p = F.lane, w = F.wave;
        const S5P q = s5_param(F, di, g, p); float lr, li, gr, gi; cpow(q, 32.0f, lr, li); cpow(q, 1024.0f, gr, gi);
        const float* __restrict__ sl = (const float*)(F.ws + WS_BIG + BG_SLOCL) + ((size_t)g * 1024 + b * 256) * 256 + di * 128 + p;
        const float* __restrict__ sc = (const float*)(F.ws + WS_BIG + BG_SLOCC) + ((size_t)g * 32 + b * 8) * 256 + di * 128 + p;
        bf16_t* __restrict__ ho = (bf16_t*)(F.ws + WS_HS5L) + ((size_t)g * 1024 + b * 256) * 768 + 512 + di * 128 + p;
        float sr[32], si[32];
#pragma unroll
        for (int k = 0; k < 32; ++k) { const int c = di == 0 ? 32 * w + k : 255 - 32 * w - k; sr[k] = sl[(size_t)c * 256]; si[k] = sl[(size_t)c * 256 + 64]; }
        float hr = 0.f, hi_ = 0.f;
        { float cr[8], ci[8];
#pragma unroll
          for (int k = 0; k < 8; ++k) { const int cc = di == 0 ? k : 7 - k; cr[k] = sc[cc * 256]; ci[k] = sc[cc * 256 + 64]; }
#pragma unroll
          for (int k = 0; k < 8; ++k) { const float nr = lr * hr - li * hi_ + cr[k], ni = lr * hi_ + li * hr + ci[k]; hr = nr; hi_ = ni; } }
        float qr = 0.f, qi = 0.f;
#pragma unroll
        for (int k = 0; k < 32; ++k) { const float nr = lr * qr - li * qi + sr[k], ni = lr * qi + li * qr + si[k]; qr = nr; qi = ni; }
        ex[(w * 2 + 0) * 64 + p] = qr; ex[(w * 2 + 1) * 64 + p] = qi;
        __syncthreads();
        for (int v = 0; v < w; ++v) { const float tr = ex[(v * 2 + 0) * 64 + p], ti = ex[(v * 2 + 1) * 64 + p]; const float nr = gr * hr - gi * hi_ + tr, ni = gr * hi_ + gi * hr + ti; hr = nr; hi_ = ni; }
#pragma unroll
        for (int k = 0; k < 32; ++k) { const int c = di == 0 ? 32 * w + k : 255 - 32 * w - k; ho[(size_t)c * 768] = f2bf(hr); ho[(size_t)c * 768 + 64] = f2bf(hi_);
            const float nr = lr * hr - li * hi_ + sr[k], ni = lr * hi_ + li * hr + si[k]; hr = nr; hi_ = ni; }
        __syncthreads();
    }
}

struct AMapGlu { __device__ __forceinline__ unsigned operator()(int R, int C) const { const int c = 2 * C; return (unsigned)((R >> 5) * 512 + (R & 31) * 16) + (unsigned)(c >> 4) * (1024u * 512u) + (unsigned)(c & 15); } };
#ifndef MK_PER_PHASE
#define MK_PER_PHASE 0
#endif
constexpr int NPH = 17;

constexpr size_t CTL_BAR_BYTE = 16384;
#define XB_TMO      128
#define XB_XCNT(j)  (256  + 64 * (j))
#define XB_XSUB(j)  (1280 + 64 * (j))
#define XB_XGEN(j)  (2304 + 64 * (j))
#define XB_TOP      3328
#define XB_TOPGEN   3392
#define XCD_BAR_WORDS 3456
#define XB_SPIN_CAP (1u << 22)
__device__ __forceinline__ unsigned xb_ld(unsigned* p)              { return __hip_atomic_load(p, __ATOMIC_RELAXED, __HIP_MEMORY_SCOPE_AGENT); }
__device__ __forceinline__ unsigned xb_add(unsigned* p, unsigned v) { return __hip_atomic_fetch_add(p, v, __ATOMIC_RELAXED, __HIP_MEMORY_SCOPE_AGENT); }
__device__ __forceinline__ unsigned xb_xcc_id() { return (unsigned)__builtin_amdgcn_s_getreg((3 << 11) | 20) & 0xFu; }
#define XB_SPIN(cond, bar) do { unsigned _sp = 0; while (cond) { __builtin_amdgcn_s_sleep(1); \
    if ((++_sp & 255u) == 0u) { if (xb_ld(&(bar)[XB_TMO])) break; if (_sp > XB_SPIN_CAP) { atomicAdd(&(bar)[XB_TMO], 1u); break; } } } } while (0)
struct XcdBarrier { unsigned* bar; unsigned x; volatile LAS unsigned* st; };
__device__ __forceinline__ XcdBarrier xcd_barrier_post(unsigned* bar, volatile LAS unsigned* st) {
    XcdBarrier b; b.bar = bar; b.x = xb_xcc_id(); b.st = st;
    if (threadIdx.x == 0) (void)xb_add(&bar[XB_XCNT(b.x)], 1u);
    return b;
}
__device__ __forceinline__ void xcd_barrier_complete(unsigned* bar, unsigned x, unsigned& nloc, unsigned& nx) {
    const unsigned G = gridDim.x;
    unsigned sum, cnt, mine, sp = 0u;
    for (;;) {
        sum = 0u; cnt = 0u; mine = 0u;
#pragma unroll
        for (unsigned j = 0; j < 16; ++j) { const unsigned c = xb_ld(&bar[XB_XCNT(j)]); sum += c; cnt += (c > 0u) ? 1u : 0u; mine = (j == x) ? c : mine; }
        if (sum == G) break;
        __builtin_amdgcn_s_sleep(1);
        if ((++sp & 255u) == 0u) { if (xb_ld(&bar[XB_TMO])) break; if (sp > XB_SPIN_CAP) { atomicAdd(&bar[XB_TMO], 1u); break; } }
    }
    nloc = mine > 0u ? mine : 1u; nx = cnt > 0u ? cnt : 1u;
}
__device__ __forceinline__ void xcd_barrier(const XcdBarrier& b) {
    asm volatile("s_waitcnt vmcnt(0)" ::: "memory");
    __syncthreads();
    if (threadIdx.x == 0) {
        unsigned* bar = b.bar;
        __builtin_amdgcn_s_waitcnt(0);
        unsigned nloc = b.st[0], nx = b.st[1];
        if (nloc == 0u) { xcd_barrier_complete(bar, b.x, nloc, nx); b.st[0] = nloc; b.st[1] = nx; }
        const unsigned old = xb_add(&bar[XB_XSUB(b.x)], 1u);
        const unsigned gen = old / nloc;
        if (old + 1u == (gen + 1u) * nloc) {
            __builtin_amdgcn_fence(__ATOMIC_RELEASE, "agent");
            asm volatile("s_waitcnt vmcnt(0)" ::: "memory");
            const unsigned og = xb_add(&bar[XB_TOP], 1u);
            const unsigned tg = og / nx;
            if (og + 1u == (tg + 1u) * nx) xb_add(&bar[XB_TOPGEN], 1u);
            else XB_SPIN(xb_ld(&bar[XB_TOPGEN]) == tg, bar);
            __builtin_amdgcn_fence(__ATOMIC_ACQUIRE, "agent");
            xb_add(&bar[XB_XGEN(b.x)], 1u);
            asm volatile("s_waitcnt vmcnt(0)" ::: "memory");
        } else {
            XB_SPIN(xb_ld(&bar[XB_XGEN(b.x)]) == gen, bar);
            __builtin_amdgcn_fence(__ATOMIC_ACQUIRE, "agent");
            asm volatile("s_waitcnt vmcnt(0)" ::: "memory");
        }
    }
    __syncthreads();
}

__global__ void __launch_bounds__(NTHREADS, 2) mega_fwd(Args args) {
    extern __shared__ __attribute__((aligned(16))) unsigned char lds_raw[];
    Frame F;
    F.lds = (LAS unsigned char*)lds_raw; F.in = args.in; F.out = args.out; F.ws = args.ws;
    F.tid = threadIdx.x; F.lane = F.tid & 63; F.wave = __builtin_amdgcn_readfirstlane(F.tid >> 6); F.G = gridDim.x; F.bid = blockIdx.x;
    const int lo = args.ph_lo, hi = args.ph_hi;
    volatile LAS unsigned* bst = (volatile LAS unsigned*)(F.lds + LDS_BYTES - 16);
    XcdBarrier bar; bar.bar = (unsigned*)(F.ws + WS_CTL + CTL_BAR_BYTE); bar.x = 0; bar.st = bst;
    if (hi - lo > 1) { if (F.tid == 0) { bst[0] = 0u; bst[1] = 0u; } __syncthreads(); bar = xcd_barrier_post((unsigned*)(F.ws + WS_CTL + CTL_BAR_BYTE), bst); }
#ifdef PH_ONLY
#define IN(k) ((k) == PH_ONLY && lo <= (k) && (k) < hi)
#else
#define IN(k) (lo <= (k) && (k) < hi)
#endif
#define SEAM(k) do { if (IN(k) && IN((k) + 1)) { if ((k) == 0) cg::this_grid().sync(); else xcd_barrier(bar); } } while (0)

#ifndef PROBE_REP
#define PROBE_REP -1
#endif
#ifndef DOWN_ABL
#define DOWN_ABL 0
#endif
#ifndef PROBE_N
#define PROBE_N 2
#endif
#define NREP(k) ((PROBE_REP == (k)) ? PROBE_N : 1)
#define REPSYNC(k, rep) do { if ((rep) + 1 < NREP(k)) xcd_barrier(bar); } while (0)
    if (IN(0)) { for (int rep = 0; rep < NREP(0); ++rep) { p0_prologue(F); __syncthreads(); REPSYNC(0, rep); } } SEAM(0);
    if (IN(1)) for (int rep = 0; rep < NREP(1); ++rep) { p1_norm1(F); REPSYNC(1, rep); } SEAM(1);
    if (IN(2)) {
        { ge::StaticOrder S; S.init(NROW / 256, 4, F.G, F.bid, F.ws + WS_ACT, (size_t)256 * 2048, F.ws + WS_WIN, (size_t)256 * 2048);
          EpiG1 E{F.ws, F.in[I_QG], F.in[I_KG], 0};
          ge::gemm_run<EpiG1, ge::StaticOrder, ge::AMapPlain, 0>(F.lds, nullptr, 16, 2048u, 128u * 2048u, (size_t)128, ge::AMapPlain{2048u}, 0u, S, E); }
        {
          ge::StaticOrder S; S.init(NROW / 256, 6, F.G, F.bid, F.ws + WS_SCR, (size_t)256 * 1024, F.ws + WS_WIN8, (size_t)256 * 1024);
          if (F.G == 256) { if (F.bid < 16) { S.G = 16; S.lim = 32; } else { S.G = 240; S.c = F.bid - 16; S.base = 32; } }
          EpiG1 E{F.ws, F.in[I_QG], F.in[I_KG], 4};
          ge::gemm_run<EpiG1, ge::StaticOrder, ge::AMapPlain, 0, true>(F.lds, nullptr, 8, 1024u, 128u * 1024u, (size_t)128, ge::AMapPlain{1024u}, 0u, S, E, 0x79797979, 0x7c7c7c7c); }
    }
#if PROBE_REP == 2
    xcd_barrier(bar);
    {
        ge::StaticOrder S; S.init(NROW / 256, 10, F.G, F.bid, F.ws + WS_ACT, (size_t)256 * 2048, F.ws + WS_WIN, (size_t)256 * 2048);
        EpiG1 E{F.ws, F.in[I_QG], F.in[I_KG], 0};
        ge::gemm_run<EpiG1, ge::StaticOrder, ge::AMapPlain, 0>(F.lds, nullptr, 16, 2048u, 128u * 2048u, (size_t)128, ge::AMapPlain{2048u}, 0u, S, E);
    }
#endif
    SEAM(2);
    if (IN(3)) { lru_consts(F); for (int u = F.bid; u < NBATCH * LRU_NCH; u += F.G) lru_unit<false>(F, u / LRU_NCH, u % LRU_NCH); }
#if PROBE_REP == 3
    xcd_barrier(bar);
    { lru_consts(F); for (int u = F.bid; u < NBATCH * LRU_NCH; u += F.G) lru_unit<false>(F, u / LRU_NCH, u % LRU_NCH); }
#endif
    SEAM(3);
    if (IN(4)) for (int rep = 0; rep < NREP(4); ++rep) { lru_carry(F); REPSYNC(4, rep); } SEAM(4);
    if (IN(5)) {
        lru_consts(F);
        for (int rep = 0; rep < NREP(51); ++rep) { for (int u = F.bid; u < NBATCH * LRU_NCH; u += F.G) lru_unit<true>(F, u / LRU_NCH, u % LRU_NCH); REPSYNC(51, rep); }
        const float s1 = wave_sum(F.in[I_LQ1][F.lane] * F.in[I_LK1][F.lane]), s2 = wave_sum(F.in[I_LQ2][F.lane] * F.in[I_LK2][F.lane]);
        const float lam = expf(s1) - expf(s2) + 0.2f;
        const int ca = (F.G % 8 == 0) ? (F.bid % 8) * (F.G / 8) + F.bid / 8 : F.bid;
        for (int rep = 0; rep < NREP(50); ++rep)
        for (int u = ca; u < 528; u += F.G) {
            const bool isl = u < 512; const int b = isl ? (u >> 7) : ((u - 512) >> 2), h = isl ? ((u >> 5) & 3) : ((u - 512) & 3);
#ifdef PROBE_ABL
            if (rep == 0) at::attn_unit<PROBE_ABL>(F, b, h, isl ? NCTX + b * SEQ + (u & 31) * 256 : b * 256, isl ? 132 : 4, lam); else
#endif
            at::attn_unit<0>(F, b, h, isl ? NCTX + b * SEQ + (u & 31) * 256 : b * 256, isl ? 132 : 4, lam);
            __syncthreads();
        }
    } SEAM(5);
    if (IN(6)) {
        ge::StaticOrder S; S.init(NROW / 256, 4, F.G, F.bid, F.ws + WS_ACT, (size_t)256 * 2048, F.ws + WS_WOUT, (size_t)256 * 2048);
        EpiG2 E{F};
        ge::gemm_run<EpiG2, ge::StaticOrder, ge::AMapPlain, 0>(F.lds, nullptr, 16, 2048u, 128u * 2048u, (size_t)128, ge::AMapPlain{2048u}, 0u, S, E);
    }
#if PROBE_REP == 6
    xcd_barrier(bar);
    {
        ge::StaticOrder S; S.init(NROW / 256, 4, F.G, F.bid, F.ws + WS_ACT, (size_t)256 * 2048, F.ws + WS_WOUT, (size_t)256 * 2048);
        EpiG2 E{F};
        ge::gemm_run<EpiG2, ge::StaticOrder, ge::AMapPlain, 0>(F.lds, nullptr, 16, 2048u, 128u * 2048u, (size_t)128, ge::AMapPlain{2048u}, 0u, S, E);
    }
#endif
    SEAM(6);
    if (IN(7)) { router_phase(F, 0); } SEAM(7);
#if PROBE_REP == 80
    if (IN(8)) { moe_up(F, 0, 0); xcd_barrier(bar); }
#endif
    if (IN(8)) { moe_up(F, 0, 0); asm volatile("s_waitcnt vmcnt(0)" ::: "memory"); __syncthreads(); moe_down2<DOWN_ABL>(F, 0); }
#if PROBE_REP == 81
    if (IN(8)) { xcd_barrier(bar); moe_down2<0>(F, 0); }
#endif
    SEAM(8);
    if (IN(9)) {
        combine_phase(F, 0, 0);
        for (int rep = 0; rep < NREP(91); ++rep) { s5_tables(F); __syncthreads(); }
        LAS float* scr = (LAS float*)(F.lds + 32768 + F.wave * 8704);
        for (int rep = 0; rep < NREP(92); ++rep)
        for (int it = F.bid * NWAVES + F.wave; it < 65 * 384; it += F.G * NWAVES) conv_expert_item(F, 1, it, scr);
    } SEAM(9);
    if (IN(10)) for (int rep = 0; rep < NREP(10); ++rep) {
        const int cs = (F.G % 8 == 0) ? (F.bid % 8) * (F.G / 8) + F.bid / 8 : F.bid;
        SchedS5a S{F.G, cs, (const char*)(F.ws + WS_HS5L), (const char*)(F.ws + WS_HS5C), (const char*)(F.ws + WS_ACT + AC_S5A)};
        EpiS5a E{F.ws};
        ge::gemm_run<EpiS5a, SchedS5a, ge::AMapPlain, 0>(F.lds, nullptr, 8, 1024u, 128u * 1536u, (size_t)128, ge::AMapPlain{1536u}, 0u, S, E);
        REPSYNC(10, rep);
    } SEAM(10);
    if (IN(11)) { s5_carry(F); } SEAM(11);
    if (IN(12)) for (int rep = 0; rep < NREP(12); ++rep) {
        const int cs = (F.G % 8 == 0) ? (F.bid % 8) * (F.G / 8) + F.bid / 8 : F.bid;
        SchedS5b S{F.G, cs, (const char*)(F.ws + WS_HS5L), (const char*)(F.ws + WS_ACT + AC_S5B)};
        EpiS5b E{F.ws};
        ge::gemm_run<EpiS5b, SchedS5b, ge::AMapPlain, 0>(F.lds, nullptr, 12, 1536u, 128u * 1536u, (size_t)128, ge::AMapPlain{1536u}, 0u, S, E);
        REPSYNC(12, rep);
    } SEAM(12);
    if (IN(13)) for (int rep = 0; rep < NREP(13); ++rep) {
#if PROBE_REP == 13 && defined(PROBE_HOT)
        ge::StaticOrder S; S.init(NLAT / 256, 8, F.G, F.bid, F.ws + WS_BIG + BG_ZS5, rep == 0 ? (size_t)0 : (size_t)8 * 512, F.ws + WS_GLU, rep == 0 ? (size_t)0 : (size_t)256 * 1024);
#else
        ge::StaticOrder S; S.init(NLAT / 256, 8, F.G, F.bid, F.ws + WS_BIG + BG_ZS5, (size_t)8 * 512, F.ws + WS_GLU, (size_t)256 * 1024);
#endif
        EpiGlu E{F};
        ge::gemm_run<EpiGlu, ge::StaticOrder, AMapGlu, 0, true>(F.lds, nullptr, 8, 1024u, 2048u, (size_t)8 * 1024 * 512, AMapGlu{}, 0u, S, E, 0x7a7a7a7a, 0x7d7d7d7d);
        REPSYNC(13, rep);
    } SEAM(13);
    if (IN(14)) { router_phase(F, 1); } SEAM(14);
    if (IN(15)) { moe_up(F, 1, 0); asm volatile("s_waitcnt vmcnt(0)" ::: "memory"); __syncthreads(); moe_down2<0>(F, 1); } SEAM(15);
    if (IN(16)) for (int rep = 0; rep < NREP(16); ++rep) { combine_phase(F, 1, 0); REPSYNC(16, rep); }
#undef IN
#undef SEAM
}

extern "C" void kernel_launch(void* const* d_in, const int* in_sizes, int n_in, void* d_out, int out_size, void* d_ws, size_t ws_size, hipStream_t stream) {
    static int grid = 0;
    if (grid == 0) {
        if (n_in != 42 || out_size != NLAT * DM || ws_size < WS_END) { fprintf(stderr, "kernel_launch: unexpected problem: n_in %d out %d ws %zu (need %zu)\n", n_in, out_size, ws_size, (size_t)WS_END); grid = -1; return; }
        int dev = 0, cus = 0, per_cu = 0;
        if (hipGetDevice(&dev) != hipSuccess || hipDeviceGetAttribute(&cus, hipDeviceAttributeMultiprocessorCount, dev) != hipSuccess) { grid = -1; return; }
        if (hipFuncSetAttribute((const void*)mega_fwd, hipFuncAttributeMaxDynamicSharedMemorySize, LDS_BYTES) != hipSuccess) { fprintf(stderr, "kernel_launch: hipFuncSetAttribute failed\n"); grid = -1; return; }
        if (hipOccupancyMaxActiveBlocksPerMultiprocessor(&per_cu, (const void*)mega_fwd, NTHREADS, LDS_BYTES) != hipSuccess || per_cu < 1) { fprintf(stderr, "kernel_launch: occupancy query failed (%d)\n", per_cu); grid = -1; return; }
        grid = cus * per_cu; if (grid > 256) grid = 256;
        fprintf(stderr, "kernel_launch: cus %d per_cu %d grid %d ws %zu\n", cus, per_cu, grid, ws_size);
    }
    if (grid < 0) return;
    (void)hipMemsetAsync((char*)d_ws + WS_CTL, 0, 65536, stream);
    Args a{};
    for (int i = 0; i < 42; ++i) a.in[i] = (const float*)d_in[i];
    a.out = (float*)d_out; a.ws = (unsigned char*)d_ws;
#if MK_PER_PHASE
    for (int p = 0; p < NPH; ++p) { a.ph_lo = p; a.ph_hi = p + 1; hipLaunchKernelGGL(mega_fwd, dim3(grid), dim3(NTHREADS), LDS_BYTES, stream, a); }
#else
    a.ph_lo = 0; a.ph_hi = NPH;
    void* kargs[] = {&a};
    const hipError_t e = hipLaunchCooperativeKernel((const void*)mega_fwd, dim3(grid), dim3(NTHREADS), kargs, LDS_BYTES, stream);
    if (e != hipSuccess) fprintf(stderr, "kernel_launch: cooperative launch failed: %s (grid %d)\n", hipGetErrorString(e), grid);
#endif
}
```
